# Optimizing an MI355X kernel written in HIP

```python
import jax, jax.numpy as jnp
from jax import lax
import numpy as np

D_MODEL = 4096
BATCH = 2
SEQ = 8192
DEPTH = 1

HEAD_DIM = 128
N_RET_HEADS = D_MODEL // (2 * HEAD_DIM)
N_SB_HEADS = D_MODEL // (2 * HEAD_DIM)
RET_WIDTH = N_RET_HEADS * HEAD_DIM
SB_WIDTH = N_SB_HEADS * HEAD_DIM
MIX_WIDTH = RET_WIDTH + SB_WIDTH
IN_SPLITS = [RET_WIDTH] * 4 + [SB_WIDTH] * 3
IN_WIDTH = sum(IN_SPLITS)
RET_CHUNK = 128
SB_BLOCK = 128
N_MEM = 256
N_CROSS_HEADS = 4
CROSS_WIDTH = N_CROSS_HEADS * HEAD_DIM
D_FF = 11008
CONV_WIDTH = 3
ROPE_BASE = 10000.0
EPS = 1e-6

kernel_name = "hybrid_retention_stickbreaking_layer"


def rmsnorm(x, g):
    xf = x.astype(jnp.float32)
    y = xf * lax.rsqrt(jnp.mean(xf * xf, axis=-1, keepdims=True) + EPS)
    return (y * g.astype(jnp.float32)).astype(x.dtype)


def rope_tables(S):
    inv_freq = ROPE_BASE ** (-jnp.linspace(0.0, 1.0, HEAD_DIM // 2, dtype=jnp.float32))
    ang = jnp.arange(S, dtype=jnp.float32)[:, None] * inv_freq[None, :]
    return jnp.cos(ang), jnp.sin(ang)


def apply_rope(x, cos, sin):
    c = cos[None, :, None, :].astype(x.dtype)
    s = sin[None, :, None, :].astype(x.dtype)
    x1, x2 = jnp.split(x, 2, axis=-1)
    return jnp.concatenate([x1 * c - x2 * s, x2 * c + x1 * s], axis=-1)


def retention_chunkwise(q, k, v):
    B, H, S, d = q.shape
    C = RET_CHUNK
    N = S // C
    dt = q.dtype
    log_g = jnp.log1p(-jnp.exp2(-5.0 - jnp.arange(H, dtype=jnp.float32)))
    idx = jnp.arange(C, dtype=jnp.float32)
    diff = idx[:, None] - idx[None, :]
    intra_decay = jnp.where(diff >= 0, jnp.exp(jnp.maximum(diff, 0.0)[None] * log_g[:, None, None]), 0.0)
    qc = q.reshape(B, H, N, C, d)
    kc = k.reshape(B, H, N, C, d)
    vc = v.reshape(B, H, N, C, d)
    scores = jnp.einsum('bhncd,bhnmd->bhncm', qc, kc) * intra_decay[:, None].astype(dt)
    intra = jnp.einsum('bhncm,bhnmd->bhncd', scores, vc)
    k_decay = jnp.exp((C - 1 - idx)[None, :] * log_g[:, None])[:, None, :, None].astype(dt)
    chunk_kv = jnp.einsum('bhncd,bhnce->nbhde', kc * k_decay, vc)
    chunk_decay = jnp.exp(C * log_g)[None, :, None, None].astype(dt)

    def step(state, kv):
        return state * chunk_decay + kv, state

    _, prev_state = lax.scan(step, jnp.zeros((B, H, d, d), dt), chunk_kv)
    q_decay = jnp.exp((idx + 1.0)[None, :] * log_g[:, None])[:, None, :, None].astype(dt)
    cross = jnp.einsum('bhncd,nbhde->bhnce', qc * q_decay, prev_state)
    return (intra + cross).reshape(B, H, S, d)


def stick_breaking_attention(q, k, v):
    B, H, S, d = q.shape
    Q = SB_BLOCK
    N = S // Q
    scale = HEAD_DIM ** -0.5
    q_blocks = q.reshape(B, H, N, Q, d).transpose(2, 0, 1, 3, 4)
    starts = jnp.arange(N, dtype=jnp.int32) * Q
    key_pos = jnp.arange(S, dtype=jnp.int32)

    def block(args):
        qb, t0 = args
        z = jnp.einsum('bhqd,bhkd->bhqk', qb, k).astype(jnp.float32) * scale
        q_pos = t0 + jnp.arange(Q, dtype=jnp.int32)
        mask = key_pos[None, :] < q_pos[:, None]
        log_stay = jnp.where(mask, jax.nn.log_sigmoid(-z), 0.0)
        log_a = jax.nn.log_sigmoid(z) + lax.cumsum(log_stay, axis=3, reverse=True) - log_stay
        a = jnp.where(mask, jnp.exp(log_a), 0.0).astype(v.dtype)
        return jnp.einsum('bhqk,bhkd->bhqd', a, v)

    out = lax.map(block, (q_blocks, starts))
    return out.transpose(1, 2, 0, 3, 4).reshape(B, H, S, d)


def hybrid_mixer(xn, w_in, ret_norm, sb_q_norm, sb_k_norm, sb_out_norm, w_out):
    B, S, _ = xn.shape
    proj = xn @ w_in
    offsets = [int(o) for o in np.cumsum(IN_SPLITS)[:-1]]
    rq, rk, rv, rg, sq, sk, sv = jnp.split(proj, offsets, axis=-1)

    def heads(t, h):
        return t.reshape(B, S, h, HEAD_DIM)

    cos, sin = rope_tables(S)
    rq = apply_rope(heads(rq, N_RET_HEADS), cos, sin) * (HEAD_DIM ** -0.5)
    rk = apply_rope(heads(rk, N_RET_HEADS), cos, sin)
    rv = heads(rv, N_RET_HEADS)
    ret = retention_chunkwise(rq.transpose(0, 2, 1, 3), rk.transpose(0, 2, 1, 3), rv.transpose(0, 2, 1, 3))
    ret = rmsnorm(ret.transpose(0, 2, 1, 3), ret_norm).reshape(B, S, RET_WIDTH)
    ret = ret * jax.nn.silu(rg)

    sq = rmsnorm(heads(sq, N_SB_HEADS), sb_q_norm)
    sk = rmsnorm(heads(sk, N_SB_HEADS), sb_k_norm)
    sv = heads(sv, N_SB_HEADS)
    sb = stick_breaking_attention(sq.transpose(0, 2, 1, 3), sk.transpose(0, 2, 1, 3), sv.transpose(0, 2, 1, 3))
    sb = rmsnorm(sb.transpose(0, 2, 1, 3), sb_out_norm).reshape(B, S, SB_WIDTH)

    return jnp.concatenate([ret, sb], axis=-1) @ w_out


def memory_cross_attention(xn, memn, w_q, w_kv, q_norm, k_norm, w_o):
    B, S, _ = xn.shape
    M = memn.shape[1]
    q = rmsnorm((xn @ w_q).reshape(B, S, N_CROSS_HEADS, HEAD_DIM), q_norm)
    k, v = jnp.split(memn @ w_kv, 2, axis=-1)
    k = rmsnorm(k.reshape(B, M, N_CROSS_HEADS, HEAD_DIM), k_norm)
    v = v.reshape(B, M, N_CROSS_HEADS, HEAD_DIM)
    s = jnp.einsum('bshd,bmhd->bhsm', q, k).astype(jnp.float32) * (HEAD_DIM ** -0.5)
    p = jax.nn.softmax(s, axis=-1).astype(v.dtype)
    o = jnp.einsum('bhsm,bmhd->bshd', p, v).reshape(B, S, CROSS_WIDTH)
    return o @ w_o


def conv_ffn(xn, w_up, conv_w, conv_b, w_down):
    S = xn.shape[1]
    u = xn @ w_up
    up = jnp.pad(u, ((0, 0), (CONV_WIDTH - 1, 0), (0, 0)))
    c = conv_b
    for j in range(CONV_WIDTH):
        c = c + up[:, j:j + S] * conv_w[j]
    g, val = jnp.split(c, 2, axis=-1)
    return (jax.nn.silu(g) * val) @ w_down


def setup_inputs(seed: int = 0) -> dict:
    key = jax.random.key(seed)
    ks = jax.random.split(key, 21)
    f32 = jnp.float32

    def nrm(k, shape, scale):
        return jax.random.normal(k, shape, f32) * scale

    def gain(k, n):
        return 1.0 + 0.02 * jax.random.normal(k, (DEPTH, n), f32)

    return {
        "x": nrm(ks[0], (BATCH, SEQ, D_MODEL), 1.0),
        "mem": nrm(ks[1], (BATCH, N_MEM, D_MODEL), 1.0),
        "attn_norm": gain(ks[2], D_MODEL),
        "w_in": nrm(ks[3], (DEPTH, D_MODEL, IN_WIDTH), D_MODEL ** -0.5),
        "ret_norm": gain(ks[4], HEAD_DIM),
        "sb_q_norm": gain(ks[5], HEAD_DIM),
        "sb_k_norm": gain(ks[6], HEAD_DIM),
        "sb_out_norm": gain(ks[7], HEAD_DIM),
        "w_out": nrm(ks[8], (DEPTH, MIX_WIDTH, D_MODEL), MIX_WIDTH ** -0.5),
        "cross_norm": gain(ks[9], D_MODEL),
        "mem_norm": gain(ks[10], D_MODEL),
        "cross_w_q": nrm(ks[11], (DEPTH, D_MODEL, CROSS_WIDTH), D_MODEL ** -0.5),
        "cross_w_kv": nrm(ks[12], (DEPTH, D_MODEL, 2 * CROSS_WIDTH), D_MODEL ** -0.5),
        "cross_q_norm": gain(ks[13], HEAD_DIM),
        "cross_k_norm": gain(ks[14], HEAD_DIM),
        "cross_w_o": nrm(ks[15], (DEPTH, CROSS_WIDTH, D_MODEL), CROSS_WIDTH ** -0.5),
        "ffn_norm": gain(ks[16], D_MODEL),
        "ffn_w_up": nrm(ks[17], (DEPTH, D_MODEL, 2 * D_FF), D_MODEL ** -0.5),
        "ffn_conv_w": nrm(ks[18], (DEPTH, CONV_WIDTH, 2 * D_FF), CONV_WIDTH ** -0.5),
        "ffn_conv_b": nrm(ks[19], (DEPTH, 2 * D_FF), 0.01),
        "ffn_w_down": nrm(ks[20], (DEPTH, D_FF, D_MODEL), D_FF ** -0.5),
    }


def reference(x, mem, attn_norm, w_in, ret_norm, sb_q_norm, sb_k_norm, sb_out_norm, w_out,
              cross_norm, mem_norm, cross_w_q, cross_w_kv, cross_q_norm, cross_k_norm, cross_w_o,
              ffn_norm, ffn_w_up, ffn_conv_w, ffn_conv_b, ffn_w_down):
    h = x
    for l in range(DEPTH):
        h = h + hybrid_mixer(rmsnorm(h, attn_norm[l]), w_in[l], ret_norm[l], sb_q_norm[l],
                             sb_k_norm[l], sb_out_norm[l], w_out[l])
        h = h + memory_cross_attention(rmsnorm(h, cross_norm[l]), rmsnorm(mem, mem_norm[l]),
                                       cross_w_q[l], cross_w_kv[l], cross_q_norm[l],
                                       cross_k_norm[l], cross_w_o[l])
        h = h + conv_ffn(rmsnorm(h, ffn_norm[l]), ffn_w_up[l], ffn_conv_w[l], ffn_conv_b[l],
                         ffn_w_down[l])
    return h
```

```cpp
#include <hip/hip_runtime.h>
#include <cstdio>
#include <cstdint>
namespace pg8 {
#define PG8_LAS __attribute__((address_space(3)))
typedef unsigned short bf16_t;
typedef short bf16x8 __attribute__((ext_vector_type(8)));
typedef float f32x4 __attribute__((ext_vector_type(4)));
typedef unsigned u32x4 __attribute__((ext_vector_type(4)));
typedef unsigned u32x2 __attribute__((ext_vector_type(2)));
constexpr int BM = 256, BK = 64, HALF = 128, HTB = HALF * BK * 2  , STAGE_BYTES = 8 * HTB, NXCD = 8, WGM = 8;

__host__ __device__ __forceinline__ int lds_byte(int r, int c) { const int st = (r >> 4) * 2 + (c >> 5), rr = r & 15, cc = c & 31, ob = rr * 64 + cc * 2; return st * 1024 + (ob ^ (((ob >> 9) & 1) << 5)); }
__host__ __device__ __forceinline__ void stage_rc(int b, int& R, int& C) { const int st = b / 1024, sb = b % 1024, swz = sb ^ (((sb >> 9) & 1) << 5); R = (st >> 1) * 16 + swz / 64; C = (st & 1) * 32 + (swz % 64) / 2; }
__host__ __device__ __forceinline__ int perm32(int rho) { const int n = rho >> 4, i = rho & 15; return 8 * (i >> 2) + 4 * n + (i & 3); }
template <int PERM> __host__ __device__ __forceinline__ int permrow(int R) {
    if (PERM == 1) return (R & ~31) + perm32(R & 31);
    if (PERM == 2) return 64 * ((R >> 4) & 1) + 16 * (R >> 5) + (R & 15);
    return R;
}

struct Unit { int pm, pn; };
struct Gemm { const bf16_t* A; const bf16_t* Bt; int M, N, K, lda; };

struct StaticOrder {
    int nM, nN, nwg, G, c, pm0;
    __host__ __device__ void init(int M, int N, int G_, int c_, int pm0_ = 0) { nM = M / BM; nN = N / BM; nwg = nM * nN; G = G_; c = c_; pm0 = pm0_; }
    __host__ __device__ bool next(int i, Unit& u) const {
        const long L = (long)i * G + c; if (L >= nwg) return false;
        int wgid = (int)L; { const int q = nwg / NXCD, r = nwg % NXCD, xcd = wgid % NXCD, off = wgid / NXCD; wgid = (xcd < r ? xcd * (q + 1) : r * (q + 1) + (xcd - r) * q) + off; }
        const int nig = WGM * nN, gid = wgid / nig, fm = gid * WGM, gsz = (nM - fm) < WGM ? (nM - fm) : WGM;
        u.pm = pm0 + fm + ((wgid % nig) % gsz); u.pn = (wgid % nig) / gsz; return true;
    }
    __device__ __forceinline__ void a_ready(const Unit&) const {}
    __device__ __forceinline__ void done(const Unit&) const {}
};

typedef float f32x2 __attribute__((ext_vector_type(2)));
typedef __bf16 bf16v2 __attribute__((ext_vector_type(2)));
__device__ __forceinline__ unsigned pk_bf16(float lo, float hi) { const f32x2 f = {lo, hi}; const bf16v2 r = __builtin_convertvector(f, bf16v2); return __builtin_bit_cast(unsigned, r); }
constexpr float EPSN = 1e-6f;
__constant__ float LOGG[16] = { -3.174869716e-02f, -1.574835740e-02f, -7.843177766e-03f, -3.913899418e-03f, -1.955034910e-03f, -9.770396864e-04f, -4.884005175e-04f, -2.441704273e-04f,
                                -1.220777631e-04f, -6.103701890e-05f, -3.051804379e-05f, -1.525890548e-05f, -7.629423635e-06f, -3.814704542e-06f, -1.907350452e-06f, -9.536747712e-07f };
__device__ __forceinline__ float hsum4(const f32x4 v) { return (v[0] + v[1]) + (v[2] + v[3]); }
__device__ __forceinline__ float dot4(const f32x4 a, const f32x4 b) { return (a[0] * b[0] + a[1] * b[1]) + (a[2] * b[2] + a[3] * b[3]); }
__device__ __forceinline__ float row_rstd64(const float* part, int row, int fq, float invn) {
    const f32x4* p = (const f32x4*)(part + (size_t)row * 64 + fq * 16);
    float s = (hsum4(p[0]) + hsum4(p[1])) + (hsum4(p[2]) + hsum4(p[3]));
    s += __shfl_xor(s, 16); s += __shfl_xor(s, 32);
    return rsqrtf(s * invn + EPSN);
}

struct EpiProj {
    static constexpr int PERM = 2; static constexpr bool AFTER_DRAIN = false;
    bf16_t* P; const float* ssq0; const float* cosT; const float* sinT; const float* gq; const float* gk; float* ssqsb;
    template <int REG> __device__ __forceinline__ void body(const f32x4 (&acc)[2][2][4][2], const Unit& u, int wr, int wc, int fr, int fq) const {
        const int pnr = u.pn & 7, d0 = 16 * wc + 4 * fq;
        float lg[2] = {0.f, 0.f}; f32x4 g0 = {1.f, 1.f, 1.f, 1.f}, g1 = g0;
        if (REG == 0 || REG == 2) { lg[0] = LOGG[2 * pnr]; lg[1] = LOGG[2 * pnr + 1]; }
        if (REG == 1 || REG == 5) { const float* g = (REG == 1) ? gq : gk; g0 = *(const f32x4*)(g + d0); g1 = *(const f32x4*)(g + 64 + d0); }
#pragma unroll
        for (int ai = 0; ai < 2; ++ai)
#pragma unroll
            for (int m = 0; m < 4; ++m) {
                const int row = u.pm * BM + ai * HALF + wr * 64 + m * 16 + fr;
                const float rs = rsqrtf(ssq0[row] * (1.0f / 4096.0f) + EPSN);
                const int t = row & 8191; const float cpos = (float)(t & 127);
                f32x4 cs = {0.f, 0.f, 0.f, 0.f}, sn = cs;
                if (REG == 0 || REG == 2) { cs = *(const f32x4*)(cosT + (size_t)t * 64 + d0); sn = *(const f32x4*)(sinT + (size_t)t * 64 + d0); }
                bf16_t* rowp = P + (size_t)row * 14336 + u.pn * BM + d0;
#pragma unroll
                for (int bj = 0; bj < 2; ++bj) {
                    const f32x4 v0 = acc[ai][bj][m][0] * rs, v1 = acc[ai][bj][m][1] * rs;
                    f32x4 o0 = v0, o1 = v1;
                    if (REG == 0) { const float sc = 0.08838834764831845f * __expf(cpos * lg[bj]); o0 = (v0 * cs - v1 * sn) * sc; o1 = (v1 * cs + v0 * sn) * sc; }
                    if (REG == 2) { const float sc = __expf(-cpos * lg[bj]); o0 = (v0 * cs - v1 * sn) * sc; o1 = (v1 * cs + v0 * sn) * sc; }
                    if (REG == 4) {
#pragma unroll
                        for (int j = 0; j < 4; ++j) { o0[j] = v0[j] * __builtin_amdgcn_rcpf(1.0f + __expf(-v0[j])); o1[j] = v1[j] * __builtin_amdgcn_rcpf(1.0f + __expf(-v1[j])); } }
                    if (REG == 1 || REG == 5) {
                        float s = dot4(v0, v0) + dot4(v1, v1); s += __shfl_xor(s, 16); s += __shfl_xor(s, 32);
                        if (fq == 0) ssqsb[((size_t)row * 32 + (REG == 1 ? 0 : 16) + 2 * pnr + bj) * 4 + wc] = s;
                        o0 = v0 * g0; o1 = v1 * g1; }
                    u32x2 w0, w1; w0.x = pk_bf16(o0[0], o0[1]); w0.y = pk_bf16(o0[2], o0[3]); w1.x = pk_bf16(o1[0], o1[1]); w1.y = pk_bf16(o1[2], o1[3]);
                    *(u32x2*)(rowp + bj * HALF) = w0; *(u32x2*)(rowp + bj * HALF + 64) = w1;
                }
            }
    }
    __device__ __forceinline__ void operator()(const f32x4 (&acc)[2][2][4][2], const Unit& u, int wr, int wc, int fr, int fq) const {
        const int reg = u.pn >> 3;
        if (reg == 0) body<0>(acc, u, wr, wc, fr, fq); else if (reg == 1) body<1>(acc, u, wr, wc, fr, fq); else if (reg == 2) body<2>(acc, u, wr, wc, fr, fq);
        else if (reg == 4) body<4>(acc, u, wr, wc, fr, fq); else if (reg == 5) body<5>(acc, u, wr, wc, fr, fq); else body<3>(acc, u, wr, wc, fr, fq);
    }
};

template <bool WITH_HB> struct EpiRes {
    static constexpr int PERM = 1; static constexpr bool AFTER_DRAIN = false;
    const float* base; float* out; bf16_t* hb; float* part;
    __device__ __forceinline__ void operator()(const f32x4 (&acc)[2][2][4][2], const Unit& u, int wr, int wc, int fr, int fq) const {
        const int col0 = u.pn * BM + wc * 32 + 8 * fq;
#pragma unroll
        for (int ai = 0; ai < 2; ++ai)
#pragma unroll
            for (int m = 0; m < 4; ++m) {
                const int row = u.pm * BM + ai * HALF + wr * 64 + m * 16 + fr; float s = 0.f;
#pragma unroll
                for (int bj = 0; bj < 2; ++bj) {
                    const size_t off = (size_t)row * 4096 + col0 + bj * HALF;
                    const f32x4 o0 = *(const f32x4*)(base + off) + acc[ai][bj][m][0], o1 = *(const f32x4*)(base + off + 4) + acc[ai][bj][m][1];
                    *(f32x4*)(out + off) = o0; *(f32x4*)(out + off + 4) = o1;
                    if (WITH_HB) { u32x4 w; w.x = pk_bf16(o0[0], o0[1]); w.y = pk_bf16(o0[2], o0[3]); w.z = pk_bf16(o1[0], o1[1]); w.w = pk_bf16(o1[2], o1[3]); *(u32x4*)(hb + off) = w; s += dot4(o0, o0) + dot4(o1, o1); }
                }
                if (WITH_HB) { s += __shfl_xor(s, 16); s += __shfl_xor(s, 32); if (fq == 0) part[(size_t)row * 64 + u.pn * 4 + wc] = s; }
            }
    }
};

template <int NP> struct EpiScaleF32 {
    static constexpr int PERM = 1; static constexpr bool AFTER_DRAIN = false;
    float* C; int ldc; const float* ssq;
    __device__ __forceinline__ void operator()(const f32x4 (&acc)[2][2][4][2], const Unit& u, int wr, int wc, int fr, int fq) const {
        const int col0 = u.pn * BM + wc * 32 + 8 * fq;
#pragma unroll
        for (int ai = 0; ai < 2; ++ai)
#pragma unroll
            for (int m = 0; m < 4; ++m) {
                const int row = u.pm * BM + ai * HALF + wr * 64 + m * 16 + fr;
                const float rs = (NP == 1) ? rsqrtf(ssq[row] * (1.0f / 4096.0f) + EPSN) : row_rstd64(ssq, row, fq, 1.0f / 4096.0f);
#pragma unroll
                for (int bj = 0; bj < 2; ++bj) { float* p = C + (size_t)row * ldc + col0 + bj * HALF; *(f32x4*)p = acc[ai][bj][m][0] * rs; *(f32x4*)(p + 4) = acc[ai][bj][m][1] * rs; }
            }
    }
};
struct EpiScaleBf16 {
    static constexpr int PERM = 1; static constexpr bool AFTER_DRAIN = false;
    bf16_t* O; int ldc; const float* ssq;
    __device__ __forceinline__ void operator()(const f32x4 (&acc)[2][2][4][2], const Unit& u, int wr, int wc, int fr, int fq) const {
        const int col0 = u.pn * BM + wc * 32 + 8 * fq;
#pragma unroll
        for (int ai = 0; ai < 2; ++ai)
#pragma unroll
            for (int m = 0; m < 4; ++m) {
                const int row = u.pm * BM + ai * HALF + wr * 64 + m * 16 + fr;
                const float rs = row_rstd64(ssq, row, fq, 1.0f / 4096.0f);
#pragma unroll
                for (int bj = 0; bj < 2; ++bj) { const f32x4 v0 = acc[ai][bj][m][0] * rs, v1 = acc[ai][bj][m][1] * rs;
                    u32x4 w; w.x = pk_bf16(v0[0], v0[1]); w.y = pk_bf16(v0[2], v0[3]); w.z = pk_bf16(v1[0], v1[1]); w.w = pk_bf16(v1[2], v1[3]);
                    *(u32x4*)(O + (size_t)row * ldc + col0 + bj * HALF) = w; }
            }
    }
};

template <class Epi, class Sched, bool ALIGN_EPI = false, bool SP2 = false>
__device__ __forceinline__ void gemm_phase(PG8_LAS unsigned char* lds, const Gemm g, const Sched& S, const Epi& E) {
    const int tid = threadIdx.x, wid = __builtin_amdgcn_readfirstlane(tid >> 6), lane = tid & 63, wr = wid >> 2, wc = wid & 3, fr = lane & 15, fq = lane >> 4;
    const int K = g.K, nt = K / BK;
    unsigned voffA[2], voffB[2];
#pragma unroll
    for (int i = 0; i < 2; ++i) { int R, C; stage_rc(tid * 16 + i * 8192, R, C); const int Rb = permrow<Epi::PERM>(R);
        voffA[i] = (unsigned)(R * g.lda + C) * 2u; voffB[i] = (unsigned)(Rb * K + C) * 2u; }
    const size_t kstep = (size_t)(BK * 2);
    const size_t hstep = (size_t)HALF * K * 2;
    const size_t tstep = 2 * hstep;
    const size_t hstepA = (size_t)HALF * g.lda * 2, tstepA = 2 * hstepA;
    const unsigned ldsw = (unsigned)wid * 1024u;
    const int aoff = lds_byte(wr * 64 + fr, fq * 8), boff = lds_byte(wc * 32 + fr, fq * 8);
#define PG8_SA(b, h) (((b) * 2 + (h)) * HTB)
#define PG8_SB(b, h) ((4 + (b) * 2 + (h)) * HTB)
#define PG8_STAGE(bufoff, gbase, voff) do { _Pragma("unroll") for (int _i = 0; _i < 2; ++_i) \
        __builtin_amdgcn_global_load_lds((const unsigned*)((const char*)(gbase) + (voff)[_i]), (PG8_LAS unsigned*)(lds + (bufoff) + ldsw + _i * 8192), 16, 0, 0); } while (0)
#define PG8_LDA(dst, b, h) do { _Pragma("unroll") for (int m = 0; m < 4; ++m) _Pragma("unroll") for (int k = 0; k < 2; ++k) dst[m][k] = *(const PG8_LAS bf16x8*)(lds + PG8_SA(b, h) + aoff + m * 2048 + k * 1024); } while (0)
#define PG8_LDB(dst, b, h) do { _Pragma("unroll") for (int n = 0; n < 2; ++n) _Pragma("unroll") for (int k = 0; k < 2; ++k) dst[n][k] = *(const PG8_LAS bf16x8*)(lds + PG8_SB(b, h) + boff + n * 2048 + k * 1024); } while (0)
#define PG8_MMA(ai, bj, At, Bt) do { __builtin_amdgcn_s_setprio(1); _Pragma("unroll") for (int m = 0; m < 4; ++m) _Pragma("unroll") for (int n = 0; n < 2; ++n) _Pragma("unroll") for (int k = 0; k < 2; ++k) \
        acc[ai][bj][m][n] = __builtin_amdgcn_mfma_f32_16x16x32_bf16(Bt[n][k], At[m][k], acc[ai][bj][m][n], 0, 0, 0); __builtin_amdgcn_s_setprio(0); } while (0)
#define PG8_WAIT_V(n) asm volatile("s_waitcnt vmcnt(" #n ")" ::: "memory")
#define PG8_WAIT_L(n) asm volatile("s_waitcnt lgkmcnt(" #n ")" ::: "memory")
#define PG8_BAR __builtin_amdgcn_s_barrier()
#define PG8_SCHED __builtin_amdgcn_sched_barrier(0)
    Unit cur, nxt; int ui = 0;
    if (!S.next(0, cur)) return;
    f32x4 acc[2][2][4][2];
#pragma unroll
    for (int a = 0; a < 2; ++a)
#pragma unroll
        for (int b = 0; b < 2; ++b)
#pragma unroll
            for (int m = 0; m < 4; ++m)
#pragma unroll
                for (int n = 0; n < 2; ++n) acc[a][b][m][n] = (f32x4){0.f, 0.f, 0.f, 0.f};
    bf16x8 At[4][2], B0[2][2], B1[2][2];
    const char* cA = (const char*)g.A + (size_t)cur.pm * tstepA; const char* cB = (const char*)g.Bt + (size_t)cur.pn * tstep;
    S.a_ready(cur);
    if constexpr (SP2) {
        PG8_STAGE(PG8_SB(0, 0), cB, voffB); PG8_STAGE(PG8_SB(0, 1), cB + hstep, voffB); PG8_STAGE(PG8_SA(0, 0), cA, voffA); PG8_STAGE(PG8_SA(0, 1), cA + hstepA, voffA);
        if (wr == 1) PG8_BAR;
        PG8_WAIT_V(2); PG8_BAR;
        PG8_STAGE(PG8_SB(1, 0), cB + kstep, voffB); PG8_STAGE(PG8_SA(1, 0), cA + kstep, voffA); PG8_STAGE(PG8_SB(1, 1), cB + hstep + kstep, voffB);
        PG8_WAIT_V(6); PG8_BAR;
    } else {
        PG8_STAGE(PG8_SB(0, 0), cB, voffB); PG8_STAGE(PG8_SA(0, 0), cA, voffA); PG8_STAGE(PG8_SB(0, 1), cB + hstep, voffB); PG8_STAGE(PG8_SA(0, 1), cA + hstepA, voffA);
        if (wr == 1) PG8_BAR;
        PG8_WAIT_V(4); PG8_BAR;
        PG8_STAGE(PG8_SB(1, 0), cB + kstep, voffB); PG8_STAGE(PG8_SA(1, 0), cA + kstep, voffA); PG8_STAGE(PG8_SB(1, 1), cB + hstep + kstep, voffB);
        PG8_WAIT_V(6); PG8_BAR;
    }
    for (;;) {
        const bool has_next = S.next(ui + 1, nxt);
        const char* nA = has_next ? (const char*)g.A + (size_t)nxt.pm * tstepA : cA; const char* nB = has_next ? (const char*)g.Bt + (size_t)nxt.pn * tstep : cB;
        for (int t = 0; t < nt; t += 2) {
            const bool last = (t == nt - 2);
            const char* a1 = cA + (size_t)(t + 1) * kstep;
            const char* a2 = last ? nA : cA + (size_t)(t + 2) * kstep; const char* b2 = last ? nB : cB + (size_t)(t + 2) * kstep;
            const char* a3 = a2 + kstep; const char* b3 = b2 + kstep;
            if (last && has_next) S.a_ready(nxt);
            if constexpr (SP2) {
            PG8_LDB(B0, 0, 0); PG8_LDB(B1, 0, 1); PG8_SCHED; PG8_LDA(At, 0, 0); PG8_STAGE(PG8_SA(1, 1), a1 + hstepA, voffA);
            PG8_WAIT_V(8); PG8_WAIT_L(0); PG8_BAR; PG8_MMA(0, 0, At, B0); PG8_MMA(0, 1, At, B1); PG8_BAR; PG8_SCHED;
            PG8_LDA(At, 0, 1); PG8_STAGE(PG8_SB(0, 0), b2, voffB); PG8_STAGE(PG8_SB(0, 1), b2 + hstep, voffB); PG8_STAGE(PG8_SA(0, 0), a2, voffA);
            PG8_WAIT_V(8); PG8_WAIT_L(0); PG8_BAR; PG8_MMA(1, 0, At, B0); PG8_MMA(1, 1, At, B1); PG8_BAR; PG8_SCHED;
            PG8_LDB(B0, 1, 0); PG8_LDB(B1, 1, 1); PG8_SCHED; PG8_LDA(At, 1, 0); PG8_STAGE(PG8_SA(0, 1), a2 + hstepA, voffA);
            PG8_WAIT_V(8); PG8_WAIT_L(0); PG8_BAR; PG8_MMA(0, 0, At, B0); PG8_MMA(0, 1, At, B1); PG8_BAR; PG8_SCHED;
            PG8_LDA(At, 1, 1); PG8_STAGE(PG8_SB(1, 0), b3, voffB); PG8_STAGE(PG8_SB(1, 1), b3 + hstep, voffB); PG8_STAGE(PG8_SA(1, 0), a3, voffA);
            PG8_WAIT_V(8); PG8_WAIT_L(0); PG8_BAR; PG8_MMA(1, 0, At, B0); PG8_MMA(1, 1, At, B1); PG8_BAR; PG8_SCHED;
            } else {
            PG8_LDB(B0, 0, 0); PG8_SCHED; PG8_LDA(At, 0, 0); PG8_STAGE(PG8_SA(1, 1), a1 + hstepA, voffA);
            PG8_WAIT_L(8); PG8_BAR; PG8_WAIT_L(0); PG8_MMA(0, 0, At, B0); PG8_BAR; PG8_SCHED;
            PG8_LDB(B1, 0, 1); PG8_STAGE(PG8_SB(0, 0), b2, voffB);
            PG8_BAR; PG8_WAIT_L(0); PG8_MMA(0, 1, At, B1); PG8_BAR;
            PG8_LDA(At, 0, 1); PG8_STAGE(PG8_SA(0, 0), a2, voffA);
            PG8_BAR; PG8_WAIT_L(0); PG8_MMA(1, 0, At, B0); PG8_BAR; PG8_SCHED;
            PG8_STAGE(PG8_SB(0, 1), b2 + hstep, voffB);
            PG8_WAIT_V(6); PG8_BAR; PG8_MMA(1, 1, At, B1); PG8_BAR;
            PG8_LDB(B0, 1, 0); PG8_SCHED; PG8_LDA(At, 1, 0); PG8_STAGE(PG8_SA(0, 1), a2 + hstepA, voffA);
            PG8_WAIT_L(8); PG8_BAR; PG8_WAIT_L(0); PG8_MMA(0, 0, At, B0); PG8_BAR; PG8_SCHED;
            PG8_LDB(B1, 1, 1); PG8_STAGE(PG8_SB(1, 0), b3, voffB);
            PG8_BAR; PG8_WAIT_L(0); PG8_MMA(0, 1, At, B1); PG8_BAR;
            PG8_LDA(At, 1, 1); PG8_STAGE(PG8_SA(1, 0), a3, voffA);
            PG8_BAR; PG8_WAIT_L(0); PG8_MMA(1, 0, At, B0); PG8_BAR; PG8_SCHED;
            PG8_STAGE(PG8_SB(1, 1), b3 + hstep, voffB);
            PG8_WAIT_V(6); PG8_BAR; PG8_MMA(1, 1, At, B1); PG8_BAR;
            }
        }
        if constexpr (ALIGN_EPI) { if (wr == 0) PG8_BAR; }
        if constexpr (!Epi::AFTER_DRAIN) { E(acc, cur, wr, wc, fr, fq); S.done(cur); }
        if (!has_next) break;
#pragma unroll
        for (int a = 0; a < 2; ++a)
#pragma unroll
            for (int b = 0; b < 2; ++b)
#pragma unroll
                for (int m = 0; m < 4; ++m)
#pragma unroll
                    for (int n = 0; n < 2; ++n) acc[a][b][m][n] = (f32x4){0.f, 0.f, 0.f, 0.f};
        cur = nxt; cA = nA; cB = nB; ++ui;
        if constexpr (ALIGN_EPI) { if (wr == 1) PG8_BAR; }
    }
    PG8_WAIT_V(0);
    if constexpr (!ALIGN_EPI) { if (wr == 0) PG8_BAR; }
    PG8_BAR;
    if constexpr (Epi::AFTER_DRAIN) { E.fused(acc, cur, wr, wc, fr, fq, lds, wid, lane); S.done(cur); }
#undef PG8_SA
#undef PG8_SB
#undef PG8_STAGE
#undef PG8_LDA
#undef PG8_LDB
#undef PG8_MMA
#undef PG8_WAIT_V
#undef PG8_WAIT_L
#undef PG8_BAR
#undef PG8_SCHED
}
}
#define LAS __attribute__((address_space(3)))
#define XB_TMO      128
#define XB_XCNT(j)  (256  + 64 * (j))
#define XB_XSUB(j)  (1280 + 64 * (j))
#define XB_XGEN(j)  (2304 + 64 * (j))
#define XB_TOP      3328
#define XB_TOPGEN   3392
#define XCD_BAR_WORDS 3456
#define XB_SPIN_CAP (1u << 18)

__device__ __forceinline__ unsigned xb_ld(unsigned* p)              { return __hip_atomic_load(p, __ATOMIC_RELAXED, __HIP_MEMORY_SCOPE_AGENT); }
__device__ __forceinline__ unsigned xb_add(unsigned* p, unsigned v) { return __hip_atomic_fetch_add(p, v, __ATOMIC_RELAXED, __HIP_MEMORY_SCOPE_AGENT); }
__device__ __forceinline__ unsigned xb_xcc_id() { return (unsigned)__builtin_amdgcn_s_getreg((3 << 11) | 20) & 0xFu; }
#define XB_SPIN(cond, bar) do { unsigned _sp = 0; while (cond) { __builtin_amdgcn_s_sleep(1); \
    if ((++_sp & 255u) == 0u) { if (xb_ld(&(bar)[XB_TMO])) break; if (_sp > XB_SPIN_CAP) { atomicAdd(&(bar)[XB_TMO], 1u); break; } } } } while (0)

struct XcdBarrier {
    unsigned* bar; unsigned x;
    volatile LAS unsigned* st;
};

__device__ __forceinline__ XcdBarrier xcd_barrier_post(unsigned* bar, volatile LAS unsigned* st) {
    XcdBarrier b; b.bar = bar; b.x = xb_xcc_id(); b.st = st;
    if (threadIdx.x == 0) (void)xb_add(&bar[XB_XCNT(b.x)], 1u);
    return b;
}
__device__ __forceinline__ void xcd_barrier_complete(unsigned* bar, unsigned x, unsigned& nloc, unsigned& nx) {
    const unsigned G = gridDim.x * gridDim.y * gridDim.z;
    unsigned sum, cnt, mine, sp = 0u;
    for (;;) {
        sum = 0u; cnt = 0u; mine = 0u;
#pragma unroll
        for (unsigned j = 0; j < 16; ++j) { const unsigned c = xb_ld(&bar[XB_XCNT(j)]); sum += c; cnt += (c > 0u) ? 1u : 0u; mine = (j == x) ? c : mine; }
        if (sum == G) break;
        __builtin_amdgcn_s_sleep(1);
        if ((++sp & 255u) == 0u) { if (xb_ld(&bar[XB_TMO])) break; if (sp > XB_SPIN_CAP) { atomicAdd(&bar[XB_TMO], 1u); break; } }
    }
    nloc = mine > 0u ? mine : 1u; nx = cnt > 0u ? cnt : 1u;
}

__device__ __forceinline__ void xcd_barrier(const XcdBarrier& b) {
    asm volatile("s_waitcnt vmcnt(0)" ::: "memory");
    __syncthreads();
    if (threadIdx.x == 0) {
        unsigned* bar = b.bar;
        __builtin_amdgcn_s_waitcnt(0);
        unsigned nloc = b.st[0], nx = b.st[1];
        if (nloc == 0u) { xcd_barrier_complete(bar, b.x, nloc, nx); b.st[0] = nloc; b.st[1] = nx; }
        const unsigned old = xb_add(&bar[XB_XSUB(b.x)], 1u);
        const unsigned gen = old / nloc;
        if (old + 1u == (gen + 1u) * nloc) {
            __builtin_amdgcn_fence(__ATOMIC_RELEASE, "agent");
            asm volatile("s_waitcnt vmcnt(0)" ::: "memory");
            const unsigned og = xb_add(&bar[XB_TOP], 1u);
            const unsigned tg = og / nx;
            if (og + 1u == (tg + 1u) * nx) xb_add(&bar[XB_TOPGEN], 1u);
            else XB_SPIN(xb_ld(&bar[XB_TOPGEN]) == tg, bar);
            __builtin_amdgcn_fence(__ATOMIC_ACQUIRE, "agent");
            xb_add(&bar[XB_XGEN(b.x)], 1u);
            asm volatile("s_waitcnt vmcnt(0)" ::: "memory");
        } else {
            XB_SPIN(xb_ld(&bar[XB_XGEN(b.x)]) == gen, bar);
            __builtin_amdgcn_fence(__ATOMIC_ACQUIRE, "agent");
            asm volatile("s_waitcnt vmcnt(0)" ::: "memory");
        }
    }
    __syncthreads();
}
constexpr int NWAVES = 8;
constexpr int SEQ = 8192, BATCH = 2, M = BATCH * SEQ, DM = 4096, HD = 128, NH = 16, INW = 14336, NMEM = 256, CW = 512, DFF = 11008, DFF2 = 2 * DFF;
constexpr int C_RQ = 0, C_SQ = 2048, C_RK = 4096, C_RV = 6144, C_RG = 8192, C_SK = 10240, C_SV = 12288;
constexpr float SB_EXIT = 110.0f;
constexpr size_t MiB = 1u << 20;
constexpr size_t WS_CTL = 0, CTL_ZERO_BYTES = 1 * MiB;
constexpr size_t WS_COS = 1 * MiB, WS_SIN = 3 * MiB, WS_SSQ0 = 5 * MiB, WS_SSQM = 5 * MiB + 256 * 1024, WS_SSQ1 = 6 * MiB, WS_SSQ2 = 10 * MiB, WS_SSQSB = 14 * MiB;
constexpr size_t WS_MB = 22 * MiB, WS_CQ = 26 * MiB, WS_CKV = 58 * MiB, WS_CO = 60 * MiB;
constexpr size_t WS_WQKV = 76 * MiB, WS_WO = 88 * MiB, WS_WUP = 92 * MiB, WS_WDOWN = 264 * MiB, WS_HB = 350 * MiB;
constexpr size_t WS_WIN = 478 * MiB, WS_WOUT = 590 * MiB, WS_PROJ = 622 * MiB, WS_KV = 1070 * MiB, WS_ST = 1198 * MiB, WS_END = 1262 * MiB;
constexpr size_t WS_U = 478 * MiB, WS_ACT = 822 * MiB;
static_assert(WS_U + (size_t)SEQ * DFF2 * 2 <= WS_ACT && WS_ACT + (size_t)M * DFF * 2 <= WS_END, "ffn overlays");
static_assert(WS_PROJ + (size_t)M * INW * 2 <= WS_KV && WS_KV + (size_t)2048 * 16384 * 4 <= WS_ST && WS_ST + (size_t)2048 * 16384 * 2 <= WS_END, "mixer map");
static_assert(WS_WIN + (size_t)INW * DM * 2 <= WS_WOUT && WS_WOUT + (size_t)DM * DM * 2 <= WS_PROJ && WS_WUP + (size_t)DFF2 * DM * 2 <= WS_WDOWN && WS_WDOWN + (size_t)DM * DFF * 2 <= WS_HB && WS_HB + (size_t)M * DM * 2 <= WS_WIN, "weights map");
constexpr int CW_BAR = 4096;
constexpr int RING_BYTES = 131072, LDSCTL_OFF = RING_BYTES, MISC_OFF = LDSCTL_OFF + 320, LDS_BYTES = 147456;
constexpr int L_KT = 0, L_VT = 40960, L_RK = 81920, L_FL = 82944, L_RED = 83200;
constexpr int KSTR = 272, VSTR = 320;

#define GAS __attribute__((address_space(1)))
#define LAS __attribute__((address_space(3)))
#define DI __device__ __forceinline__
typedef unsigned short bf16;
typedef unsigned v4u __attribute__((ext_vector_type(4)));
typedef unsigned v2u __attribute__((ext_vector_type(2)));
typedef float f32x4 __attribute__((ext_vector_type(4)));
typedef float f32x16 __attribute__((ext_vector_type(16)));
typedef short bf16x8 __attribute__((ext_vector_type(8)));
typedef short s16x4 __attribute__((ext_vector_type(4)));
typedef GAS unsigned gu32;
#define RLX_AGENT __ATOMIC_RELAXED, __HIP_MEMORY_SCOPE_AGENT
#define LDS_WAIT() asm volatile("s_waitcnt lgkmcnt(0)" ::: "memory")
using pg8::pk_bf16; using pg8::EPSN; using pg8::LOGG; using pg8::hsum4;
#define MFMA32(a, b, c) __builtin_amdgcn_mfma_f32_32x32x16_bf16((a), (b), (c), 0, 0, 0)
DI int crow(int i, int h) { return (i & 3) + 8 * (i >> 2) + 4 * h; }
DI bf16x8 pack8(float a0, float a1, float a2, float a3, float a4, float a5, float a6, float a7) { v4u p; p.x = pk_bf16(a0, a1); p.y = pk_bf16(a2, a3); p.z = pk_bf16(a4, a5); p.w = pk_bf16(a6, a7); return __builtin_bit_cast(bf16x8, p); }
DI float bf2f(unsigned short b) { return __builtin_bit_cast(float, (unsigned)b << 16); }
DI float wave_sum(float v) {
#pragma unroll
    for (int o = 1; o < 64; o <<= 1) v += __shfl_xor(v, o);
    return v;
}
__constant__ float INVF[64] = { 1.000000000e+00f, 8.639884591e-01f, 7.464760542e-01f, 6.449466348e-01f, 5.572264791e-01f, 4.814372361e-01f, 4.159561992e-01f, 3.593813479e-01f, 3.105013072e-01f, 2.682695389e-01f, 2.317818105e-01f, 2.002568096e-01f, 1.730195731e-01f, 1.494868994e-01f, 1.291549653e-01f, 1.115883961e-01f,
    9.641107172e-02f, 8.329805732e-02f, 7.196855545e-02f, 6.218000501e-02f, 5.372280627e-02f, 4.641588405e-02f, 4.010278732e-02f, 3.464834765e-02f, 2.993577160e-02f, 2.586415969e-02f, 2.234633639e-02f, 1.930697635e-02f, 1.668100432e-02f, 1.441219542e-02f, 1.245197095e-02f, 1.075835899e-02f,
    9.295094758e-03f, 8.030855097e-03f, 6.938565988e-03f, 5.994841456e-03f, 5.179473665e-03f, 4.475004971e-03f, 3.866352839e-03f, 3.340484342e-03f, 2.886140021e-03f, 2.493591513e-03f, 2.154434333e-03f, 1.861406374e-03f, 1.608233550e-03f, 1.389495214e-03f, 1.200507861e-03f, 1.037224894e-03f,
    8.961503627e-04f, 7.742635789e-04f, 6.689548027e-04f, 5.779691855e-04f, 4.993587499e-04f, 4.314401885e-04f, 3.727593576e-04f, 3.220597864e-04f, 2.782559022e-04f, 2.404099068e-04f, 2.077113895e-04f, 1.794602285e-04f, 1.550515735e-04f, 1.339627779e-04f, 1.157422885e-04f, 9.999999747e-05f };
DI void transpose_item(const float* W, int N, const float* gain, bf16* WT, int Kd, int dst_row0, int src_col0, int k0, LAS float* scr, int lane) {
#pragma unroll 8
    for (int i = 0; i < 32; ++i) { const int kk = 2 * i + (lane >> 5); const float g = gain ? gain[k0 + kk] : 1.0f; scr[kk * 33 + (lane & 31)] = W[(size_t)(k0 + kk) * N + src_col0 + (lane & 31)] * g; }
    LDS_WAIT(); asm volatile("" ::: "memory");
    const int c = lane & 7;
#pragma unroll
    for (int j = 0; j < 4; ++j) { const int n = (lane >> 3) + 8 * j; const LAS float* s = scr + (8 * c) * 33 + n;
        v4u o; o.x = pk_bf16(s[0 * 33], s[1 * 33]); o.y = pk_bf16(s[2 * 33], s[3 * 33]); o.z = pk_bf16(s[4 * 33], s[5 * 33]); o.w = pk_bf16(s[6 * 33], s[7 * 33]);
        *(GAS v4u*)(WT + (size_t)(dst_row0 + n) * Kd + k0 + 8 * c) = o; }
    LDS_WAIT(); asm volatile("" ::: "memory");
}
DI void row_to_bf16(const float* xrow, bf16* orow, float* ssq, int lane) {
    const GAS f32x4* xr = (const GAS f32x4*)xrow + lane; GAS v2u* o8 = (GAS v2u*)orow + lane; float s = 0.f;
#pragma unroll
    for (int j = 0; j < 16; ++j) { const f32x4 v = xr[64 * j]; s += (v.x * v.x + v.y * v.y) + (v.z * v.z + v.w * v.w); v2u w; w.x = pk_bf16(v.x, v.y); w.y = pk_bf16(v.z, v.w); o8[64 * j] = w; }
    s = wave_sum(s); if (lane == 0) *ssq = s;
}
struct Ptrs {
    const float *x, *mem, *attn_norm, *w_in, *ret_norm, *sbq_norm, *sbk_norm, *sbo_norm, *w_out, *cross_norm, *mem_norm, *wq, *wkv, *cq_norm, *ck_norm, *wo, *ffn_norm, *w_up, *conv_w, *conv_b, *w_down;
    float* out; unsigned char* ws;
};
DI void p0_prologue(const Ptrs& P, LAS unsigned char* lds, int gw, int NGW, int wave, int lane) {
    unsigned char* ws = P.ws;
    LAS float* scr = (LAS float*)(lds + wave * 16384);
    constexpr int KB = DM / 64;
    constexpr int I_IN = KB * (INW / 32), I_OUT = KB * (DM / 32), I_Q = KB * (CW / 32), I_KV = KB * (2 * CW / 32), I_O = (CW / 64) * (DM / 32), I_UP = KB * (DFF2 / 32), I_DN = (DFF / 64) * (DM / 32);
    constexpr int NITEMS = I_IN + I_OUT + I_Q + I_KV + I_O + I_UP + I_DN;
    for (int it = gw; it < NITEMS; it += NGW) {
        int r = it;
        if (r < I_IN) { const int nb = r % (INW / 32), kb = r / (INW / 32), n0 = 32 * nb, reg = n0 >> 11;
            const int src = (reg == 0 ? 0 : reg == 1 ? 8192 : reg == 2 ? 2048 : reg == 3 ? 4096 : reg == 4 ? 6144 : reg == 5 ? 10240 : 12288) + (n0 & 2047);
            transpose_item(P.w_in, INW, P.attn_norm, (bf16*)(ws + WS_WIN), DM, n0, src, 64 * kb, scr, lane); continue; } r -= I_IN;
        if (r < I_OUT) { const int nb = r % (DM / 32), kb = r / (DM / 32); transpose_item(P.w_out, DM, nullptr, (bf16*)(ws + WS_WOUT), DM, 32 * nb, 32 * nb, 64 * kb, scr, lane); continue; } r -= I_OUT;
        if (r < I_Q) { const int nb = r % (CW / 32), kb = r / (CW / 32); transpose_item(P.wq, CW, P.cross_norm, (bf16*)(ws + WS_WQKV), DM, 32 * nb, 32 * nb, 64 * kb, scr, lane); continue; } r -= I_Q;
        if (r < I_KV) { const int nb = r % (2 * CW / 32), kb = r / (2 * CW / 32); transpose_item(P.wkv, 2 * CW, P.mem_norm, (bf16*)(ws + WS_WQKV), DM, CW + 32 * nb, 32 * nb, 64 * kb, scr, lane); continue; } r -= I_KV;
        if (r < I_O) { const int nb = r % (DM / 32), kb = r / (DM / 32); transpose_item(P.wo, DM, nullptr, (bf16*)(ws + WS_WO), CW, 32 * nb, 32 * nb, 64 * kb, scr, lane); continue; } r -= I_O;
        if (r < I_UP) { const int nb = r % (DFF2 / 32), kb = r / (DFF2 / 32); transpose_item(P.w_up, DFF2, P.ffn_norm, (bf16*)(ws + WS_WUP), DM, 32 * nb, 32 * nb, 64 * kb, scr, lane); continue; } r -= I_UP;
        { const int nb = r % (DM / 32), kb = r / (DM / 32); transpose_item(P.w_down, DM, nullptr, (bf16*)(ws + WS_WDOWN), DFF, 32 * nb, 32 * nb, 64 * kb, scr, lane); }
    }
    for (int m = gw; m < M; m += NGW) row_to_bf16(P.x + (size_t)m * DM, (bf16*)(ws + WS_HB) + (size_t)m * DM, (float*)(ws + WS_SSQ0) + m, lane);
    for (int m = gw; m < BATCH * NMEM; m += NGW) row_to_bf16(P.mem + (size_t)m * DM, (bf16*)(ws + WS_MB) + (size_t)m * DM, (float*)(ws + WS_SSQM) + m, lane);
    for (int idx = gw * 64 + lane; idx < SEQ * 64; idx += NGW * 64) {
        const int t = idx >> 6, i = idx & 63; const float angf = (float)t * INVF[i]; const double ang = (double)angf;
        const double kq = __builtin_rint(ang * 0.15915494309189535); const double rr = __builtin_fma(-kq, 6.283185307179586, ang) - kq * 2.4492935982947064e-16;
        const double r2 = rr * rr; double sn = 0.0, cs = 0.0;
#pragma unroll
        for (int k = 13; k >= 0; --k) { cs = cs * (-r2 / (double)((2 * k + 1) * (2 * k + 2))) + 1.0; sn = sn * (-r2 / (double)((2 * k + 2) * (2 * k + 3))) + 1.0; }
        ((float*)(ws + WS_COS))[idx] = (float)cs; ((float*)(ws + WS_SIN))[idx] = (float)(sn * rr);
    }
}
DI void stage_tile(LAS unsigned char* dst, int stride, const bf16* src, size_t ld, int rows, int tid) {
    for (int ch = tid; ch < rows * 16; ch += NWAVES * 64) { const int r = ch >> 4, c = ch & 15; const v4u v = *(const GAS v4u*)(src + (size_t)r * ld + c * 8); *(LAS v4u*)(dst + r * stride + c * 16) = v; }
}
DI bf16x8 tr_frag(LAS unsigned char* tile, int stride, int row0, int col0, int lane) {
    const int g = lane >> 4, i16 = lane & 15, q = i16 >> 2, p = i16 & 3, h = lane >> 5;
    LAS unsigned char* a = tile + (row0 + 4 * h + q) * stride + (col0 + 16 * (g & 1) + 4 * p) * 2;
    const s16x4 lo = __builtin_amdgcn_ds_read_tr16_b64_v4i16((LAS s16x4*)a);
    const s16x4 hi = __builtin_amdgcn_ds_read_tr16_b64_v4i16((LAS s16x4*)(a + 8 * stride));
    return __builtin_shufflevector(lo, hi, 0, 1, 2, 3, 4, 5, 6, 7);
}
DI f32x16 st_tile(LAS unsigned char* KT, int krow0, const bf16x8 (&qf)[8], int r, int h) {
    f32x16 acc;
#pragma unroll
    for (int i = 0; i < 16; ++i) acc[i] = 0.f;
#pragma unroll
    for (int ks = 0; ks < 8; ++ks) { const bf16x8 a = *(const LAS bf16x8*)(KT + (krow0 + r) * KSTR + (16 * ks + 8 * h) * 2); acc = MFMA32(a, qf[ks], acc); }
    return acc;
}
DI void load_qf(bf16x8 (&qf)[8], const bf16* qrowp, int h) {
#pragma unroll
    for (int ks = 0; ks < 8; ++ks) qf[ks] = *(const GAS bf16x8*)(qrowp + 16 * ks + 8 * h);
}

DI void ret_kv_unit(LAS unsigned char* lds, const bf16* PROJ, float* KVB, int unit, int tid) {
    const int lane = tid & 63, w = __builtin_amdgcn_readfirstlane(tid >> 6), r = lane & 31, h = lane >> 5;
    const int n = unit & 63, hd = (unit >> 6) & 15, b = unit >> 10;
    LAS unsigned char* KT = lds + L_KT; LAS unsigned char* VT = lds + L_VT;
    const size_t m0 = (size_t)b * SEQ + 128 * n;
    __syncthreads();
    stage_tile(KT, VSTR, PROJ + m0 * INW + C_RK + 128 * hd, INW, 128, tid);
    stage_tile(VT, VSTR, PROJ + m0 * INW + C_RV + 128 * hd, INW, 128, tid);
    __syncthreads();
    const int te = w >> 1, td0 = 2 * (w & 1);
    f32x16 acc[2];
#pragma unroll
    for (int t = 0; t < 2; ++t)
#pragma unroll
        for (int i = 0; i < 16; ++i) acc[t][i] = 0.f;
#pragma unroll
    for (int ks = 0; ks < 8; ++ks) {
        const bf16x8 a = tr_frag(VT, VSTR, 16 * ks, 32 * te, lane);
#pragma unroll
        for (int t = 0; t < 2; ++t) { const bf16x8 bb = tr_frag(KT, VSTR, 16 * ks, 32 * (td0 + t), lane); acc[t] = MFMA32(a, bb, acc[t]); }
    }
    const float sc = __expf(127.0f * LOGG[hd]);
    float* o = KVB + (size_t)unit * 16384;
#pragma unroll
    for (int t = 0; t < 2; ++t)
#pragma unroll
        for (int i = 0; i < 16; ++i) o[(32 * te + crow(i, h)) * 128 + 32 * (td0 + t) + r] = acc[t][i] * sc;
}
DI void ret_scan(const float* KVB, bf16* ST, int gt, int NT) {
    for (int idx = gt; idx < 32 * 4096; idx += NT) {
        const int bh = idx >> 12, e4 = idx & 4095; const float dec = __expf(128.0f * LOGG[bh & 15]);
        f32x4 S = {0.f, 0.f, 0.f, 0.f};
        for (int n = 0; n < 64; ++n) {
            const size_t off = ((size_t)(bh * 64 + n) * 4096 + e4) * 4;
            v2u w; w.x = pk_bf16(S[0], S[1]); w.y = pk_bf16(S[2], S[3]); *(GAS v2u*)(ST + off) = w;
            const f32x4 kv = *(const GAS f32x4*)(KVB + off); S = S * dec + kv;
        }
    }
}
DI void ret_out_unit(LAS unsigned char* lds, bf16* PROJ, const bf16* ST, const float* gret, int unit, int tid) {
    const int lane = tid & 63, w = __builtin_amdgcn_readfirstlane(tid >> 6), r = lane & 31, h = lane >> 5, qg = w & 3, eh = w >> 2;
    const int n = unit & 63, hd = (unit >> 6) & 15, b = unit >> 10;
    LAS unsigned char* KT = lds + L_KT; LAS unsigned char* VT = lds + L_VT; LAS float* RED = (LAS float*)(lds + L_RED);
    const size_t m0 = (size_t)b * SEQ + 128 * n, qrow = m0 + 32 * qg + r;
    __syncthreads();
    stage_tile(KT, KSTR, PROJ + m0 * INW + C_RK + 128 * hd, INW, 128, tid);
    stage_tile(VT, VSTR, PROJ + m0 * INW + C_RV + 128 * hd, INW, 128, tid);
    bf16x8 qf[8]; load_qf(qf, PROJ + qrow * INW + C_RQ + 128 * hd, h);
    const bf16* st = ST + (size_t)unit * 16384;
    f32x16 O[2];
#pragma unroll
    for (int et = 0; et < 2; ++et) {
#pragma unroll
        for (int i = 0; i < 16; ++i) O[et][i] = 0.f;
#pragma unroll
        for (int ks = 0; ks < 8; ++ks) { const bf16x8 a = *(const GAS bf16x8*)(st + (32 * (2 * eh + et) + r) * 128 + 16 * ks + 8 * h); O[et] = MFMA32(a, qf[ks], O[et]); }
    }
    const float g1 = __expf(LOGG[hd]);
#pragma unroll
    for (int et = 0; et < 2; ++et) O[et] = O[et] * g1;
    __syncthreads();
    for (int kt = 0; kt <= qg; ++kt) {
        f32x16 s = st_tile(KT, 32 * kt, qf, r, h);
        if (kt == qg) {
#pragma unroll
            for (int i = 0; i < 16; ++i) s[i] = (crow(i, h) <= r) ? s[i] : 0.f;
        }
        bf16x8 pb[2];
#pragma unroll
        for (int s2 = 0; s2 < 2; ++s2) pb[s2] = pack8(s[8 * s2], s[8 * s2 + 1], s[8 * s2 + 2], s[8 * s2 + 3], s[8 * s2 + 4], s[8 * s2 + 5], s[8 * s2 + 6], s[8 * s2 + 7]);
#pragma unroll
        for (int et = 0; et < 2; ++et)
#pragma unroll
            for (int s2 = 0; s2 < 2; ++s2) O[et] = MFMA32(tr_frag(VT, VSTR, 32 * kt + 16 * s2, 32 * (2 * eh + et), lane), pb[s2], O[et]);
    }
    float ss = 0.f;
#pragma unroll
    for (int et = 0; et < 2; ++et)
#pragma unroll
        for (int i = 0; i < 16; ++i) ss += O[et][i] * O[et][i];
    ss += __shfl_xor(ss, 32);
    if (h == 0) RED[w * 32 + r] = ss;
    __syncthreads();
    const float rstd = rsqrtf((RED[w * 32 + r] + RED[(w ^ 4) * 32 + r]) * (1.0f / 128.0f) + EPSN);
    bf16* orow = PROJ + qrow * INW + 128 * hd;
#pragma unroll
    for (int et = 0; et < 2; ++et)
#pragma unroll
        for (int G = 0; G < 4; ++G) {
            const int e = 32 * (2 * eh + et) + 8 * G + 4 * h;
            const f32x4 g = *(const f32x4*)(gret + e); const v2u gt = *(const GAS v2u*)(orow + C_RG + e);
            const float o0 = O[et][4 * G + 0] * rstd * g[0] * bf2f((unsigned short)(gt.x & 0xffff)), o1 = O[et][4 * G + 1] * rstd * g[1] * bf2f((unsigned short)(gt.x >> 16));
            const float o2 = O[et][4 * G + 2] * rstd * g[2] * bf2f((unsigned short)(gt.y & 0xffff)), o3 = O[et][4 * G + 3] * rstd * g[3] * bf2f((unsigned short)(gt.y >> 16));
            v2u wv; wv.x = pk_bf16(o0, o1); wv.y = pk_bf16(o2, o3); *(GAS v2u*)(orow + C_RQ + e) = wv;
        }
}
DI void sb_unit(LAS unsigned char* lds, bf16* PROJ, const float* ssqsb, const float* gout, int unit, int tid) {
    const int lane = tid & 63, w = __builtin_amdgcn_readfirstlane(tid >> 6), r = lane & 31, h = lane >> 5;
    const int qb = unit & 31, hd = (unit >> 5) & 15, b = unit >> 9;
    LAS unsigned char* KT = lds + L_KT; LAS unsigned char* VT = lds + L_VT; LAS float* RK = (LAS float*)(lds + L_RK); LAS unsigned* FL = (LAS unsigned*)(lds + L_FL);
    const size_t m0 = (size_t)b * SEQ + 256 * qb, qrow = m0 + 32 * w + r;
    const int qlo = 256 * qb + 32 * w, qhi = qlo + 31, tq = qlo + r;
    bf16x8 qf[8]; load_qf(qf, PROJ + qrow * INW + C_SQ + 128 * hd, h);
    const f32x4 pq = *(const GAS f32x4*)(ssqsb + (qrow * 32 + hd) * 4);
    const float qscale = rsqrtf(hsum4(pq) * (1.0f / 128.0f) + EPSN) * 0.08838834764831845f;
    f32x16 O[4];
#pragma unroll
    for (int dt = 0; dt < 4; ++dt)
#pragma unroll
        for (int i = 0; i < 16; ++i) O[dt][i] = 0.f;
    float R = 0.f;
    for (int kb = 2 * qb + 1; kb >= 0; --kb) {
        __syncthreads();
        if (kb != 2 * qb + 1) { const unsigned all = FL[0] & FL[1] & FL[2] & FL[3] & FL[4] & FL[5] & FL[6] & FL[7]; if (all) break; }
        const size_t k0row = (size_t)b * SEQ + 128 * kb;
        stage_tile(KT, KSTR, PROJ + k0row * INW + C_SK + 128 * hd, INW, 128, tid);
        stage_tile(VT, VSTR, PROJ + k0row * INW + C_SV + 128 * hd, INW, 128, tid);
        if (tid < 128) { const f32x4 pk = *(const GAS f32x4*)(ssqsb + ((k0row + tid) * 32 + 16 + hd) * 4); RK[tid] = rsqrtf(hsum4(pk) * (1.0f / 128.0f) + EPSN); }
        __syncthreads();
        const int k0b = 128 * kb;
        if (k0b < qhi) {
            for (int st = 3; st >= 0; --st) {
                const int k0 = k0b + 32 * st;
                if (k0 >= qhi) continue;
                const f32x16 s = st_tile(KT, 32 * st, qf, r, h);
                const bool need_mask = (k0 + 31 >= qlo);
                float a[16];
#pragma unroll
                for (int G = 3; G >= 0; --G) {
                    const f32x4 rk = *(const LAS f32x4*)(RK + 32 * st + 8 * G + 4 * h);
                    float z[4], sp[4]; bool ok[4];
#pragma unroll
                    for (int j = 0; j < 4; ++j) {
                        z[j] = s[4 * G + j] * qscale * rk[j];
                        ok[j] = !need_mask || (k0 + 8 * G + 4 * h + j < tq);
                        const float spv = fmaxf(z[j], 0.f) + __logf(1.0f + __expf(-fabsf(z[j])));
                        sp[j] = ok[j] ? spv : 0.f;
                    }
                    const float l3 = sp[3], l2 = sp[2] + l3, l1 = sp[1] + l2, l0 = sp[0] + l1;
                    const float To = __shfl_xor(l0, 32);
                    const float off = h ? R : R + To;
                    a[4 * G + 0] = ok[0] ? __expf(z[0] - (off + l0)) : 0.f; a[4 * G + 1] = ok[1] ? __expf(z[1] - (off + l1)) : 0.f;
                    a[4 * G + 2] = ok[2] ? __expf(z[2] - (off + l2)) : 0.f; a[4 * G + 3] = ok[3] ? __expf(z[3] - (off + l3)) : 0.f;
                    R = R + (l0 + To);
                }
                bf16x8 pb[2];
#pragma unroll
                for (int s2 = 0; s2 < 2; ++s2) pb[s2] = pack8(a[8 * s2], a[8 * s2 + 1], a[8 * s2 + 2], a[8 * s2 + 3], a[8 * s2 + 4], a[8 * s2 + 5], a[8 * s2 + 6], a[8 * s2 + 7]);
#pragma unroll
                for (int dt = 0; dt < 4; ++dt)
#pragma unroll
                    for (int s2 = 0; s2 < 2; ++s2) O[dt] = MFMA32(tr_frag(VT, VSTR, 32 * st + 16 * s2, 32 * dt, lane), pb[s2], O[dt]);
            }
        }
        const bool done = __all(R > SB_EXIT);
        if (lane == 0) FL[w] = done ? 1u : 0u;
    }
    float ss = 0.f;
#pragma unroll
    for (int dt = 0; dt < 4; ++dt)
#pragma unroll
        for (int i = 0; i < 16; ++i) ss += O[dt][i] * O[dt][i];
    ss += __shfl_xor(ss, 32);
    const float rstd = rsqrtf(ss * (1.0f / 128.0f) + EPSN);
    bf16* orow = PROJ + qrow * INW + C_SQ + 128 * hd;
#pragma unroll
    for (int dt = 0; dt < 4; ++dt)
#pragma unroll
        for (int G = 0; G < 4; ++G) {
            const int d = 32 * dt + 8 * G + 4 * h; const f32x4 g = *(const f32x4*)(gout + d);
            v2u wv; wv.x = pk_bf16(O[dt][4 * G] * rstd * g[0], O[dt][4 * G + 1] * rstd * g[1]); wv.y = pk_bf16(O[dt][4 * G + 2] * rstd * g[2], O[dt][4 * G + 3] * rstd * g[3]);
            *(GAS v2u*)(orow + d) = wv;
        }
}
DI void cross_stage(LAS unsigned char* lds, const float* CKV, const float* gk, LAS float* RKc, int b, int ch, int kh, bool withV, int tid) {
    for (int chn = tid; chn < 128 * 16; chn += NWAVES * 64) {
        const int rr = chn >> 4, c = chn & 15; const float* src = CKV + (size_t)(b * NMEM + 128 * kh + rr) * (2 * CW) + 128 * ch + 8 * c;
        const f32x4 a0 = *(const GAS f32x4*)src, a1 = *(const GAS f32x4*)(src + 4); const f32x4 g0 = *(const f32x4*)(gk + 8 * c), g1 = *(const f32x4*)(gk + 8 * c + 4); const float rs = RKc[128 * kh + rr];
        v4u o; o.x = pk_bf16(a0[0] * rs * g0[0], a0[1] * rs * g0[1]); o.y = pk_bf16(a0[2] * rs * g0[2], a0[3] * rs * g0[3]); o.z = pk_bf16(a1[0] * rs * g1[0], a1[1] * rs * g1[1]); o.w = pk_bf16(a1[2] * rs * g1[2], a1[3] * rs * g1[3]);
        *(LAS v4u*)(lds + L_KT + rr * KSTR + c * 16) = o;
        if (withV) { const f32x4 v0 = *(const GAS f32x4*)(src + CW), v1 = *(const GAS f32x4*)(src + CW + 4);
            v4u ov; ov.x = pk_bf16(v0[0], v0[1]); ov.y = pk_bf16(v0[2], v0[3]); ov.z = pk_bf16(v1[0], v1[1]); ov.w = pk_bf16(v1[2], v1[3]);
            *(LAS v4u*)(lds + L_VT + rr * VSTR + c * 16) = ov; }
    }
}
DI void cross_unit(LAS unsigned char* lds, const float* CQ, const float* CKV, const float* gq, const float* gk, bf16* CO, int unit, int tid) {
    const int lane = tid & 63, w = __builtin_amdgcn_readfirstlane(tid >> 6), r = lane & 31, h = lane >> 5;
    const int qb = unit & 31, ch = (unit >> 5) & 3, b = unit >> 7;
    LAS unsigned char* KT = lds + L_KT; LAS unsigned char* VT = lds + L_VT; LAS float* RKc = (LAS float*)(lds + L_RK);
    const size_t qrow = (size_t)b * SEQ + 256 * qb + 32 * w + r;
    __syncthreads();
    {
        const int key = tid >> 1, half = tid & 1; const float* src = CKV + (size_t)(b * NMEM + key) * (2 * CW) + 128 * ch + 64 * half; float s = 0.f;
#pragma unroll
        for (int j = 0; j < 16; ++j) { const f32x4 v = *(const GAS f32x4*)(src + 4 * j); s += (v.x * v.x + v.y * v.y) + (v.z * v.z + v.w * v.w); }
        s += __shfl_xor(s, 1);
        if (half == 0) RKc[key] = rsqrtf(s * (1.0f / 128.0f) + EPSN);
    }
    bf16x8 qf[8];
    {
        const float* qp = CQ + qrow * CW + 128 * ch; f32x4 qv[8][2]; float s = 0.f;
#pragma unroll
        for (int ks = 0; ks < 8; ++ks) { qv[ks][0] = *(const GAS f32x4*)(qp + 16 * ks + 8 * h); qv[ks][1] = *(const GAS f32x4*)(qp + 16 * ks + 8 * h + 4);
            s += (qv[ks][0].x * qv[ks][0].x + qv[ks][0].y * qv[ks][0].y) + (qv[ks][0].z * qv[ks][0].z + qv[ks][0].w * qv[ks][0].w) + (qv[ks][1].x * qv[ks][1].x + qv[ks][1].y * qv[ks][1].y) + (qv[ks][1].z * qv[ks][1].z + qv[ks][1].w * qv[ks][1].w); }
        s += __shfl_xor(s, 32);
        const float rs = rsqrtf(s * (1.0f / 128.0f) + EPSN) * 0.08838834764831845f;
#pragma unroll
        for (int ks = 0; ks < 8; ++ks) { const f32x4 g0 = *(const f32x4*)(gq + 16 * ks + 8 * h), g1 = *(const f32x4*)(gq + 16 * ks + 8 * h + 4); const f32x4 a0 = qv[ks][0] * g0 * rs, a1 = qv[ks][1] * g1 * rs;
            qf[ks] = pack8(a0[0], a0[1], a0[2], a0[3], a1[0], a1[1], a1[2], a1[3]); }
    }
    __syncthreads();
    float mx = -3.0e38f;
    for (int kh = 0; kh < 2; ++kh) {
        if (kh) __syncthreads();
        cross_stage(lds, CKV, gk, RKc, b, ch, kh, false, tid);
        __syncthreads();
#pragma unroll 1
        for (int st = 0; st < 4; ++st) { const f32x16 s = st_tile(KT, 32 * st, qf, r, h);
#pragma unroll
            for (int i = 0; i < 16; ++i) mx = fmaxf(mx, s[i]); }
    }
    mx = fmaxf(mx, __shfl_xor(mx, 32));
    f32x16 O[4]; float lsum = 0.f;
#pragma unroll
    for (int dt = 0; dt < 4; ++dt)
#pragma unroll
        for (int i = 0; i < 16; ++i) O[dt][i] = 0.f;
    for (int kh = 0; kh < 2; ++kh) {
        __syncthreads();
        cross_stage(lds, CKV, gk, RKc, b, ch, kh, true, tid);
        __syncthreads();
#pragma unroll 1
        for (int st = 0; st < 4; ++st) {
            const f32x16 s = st_tile(KT, 32 * st, qf, r, h); float p[16];
#pragma unroll
            for (int i = 0; i < 16; ++i) { p[i] = __expf(s[i] - mx); lsum += p[i]; }
            bf16x8 pb[2];
#pragma unroll
            for (int s2 = 0; s2 < 2; ++s2) pb[s2] = pack8(p[8 * s2], p[8 * s2 + 1], p[8 * s2 + 2], p[8 * s2 + 3], p[8 * s2 + 4], p[8 * s2 + 5], p[8 * s2 + 6], p[8 * s2 + 7]);
#pragma unroll
            for (int dt = 0; dt < 4; ++dt)
#pragma unroll
                for (int s2 = 0; s2 < 2; ++s2) O[dt] = MFMA32(tr_frag(VT, VSTR, 32 * st + 16 * s2, 32 * dt, lane), pb[s2], O[dt]);
        }
    }
    lsum += __shfl_xor(lsum, 32);
    const float inv = 1.0f / lsum;
    bf16* orow = CO + qrow * CW + 128 * ch;
#pragma unroll
    for (int dt = 0; dt < 4; ++dt)
#pragma unroll
        for (int G = 0; G < 4; ++G) { const int d = 32 * dt + 8 * G + 4 * h;
            v2u wv; wv.x = pk_bf16(O[dt][4 * G] * inv, O[dt][4 * G + 1] * inv); wv.y = pk_bf16(O[dt][4 * G + 2] * inv, O[dt][4 * G + 3] * inv); *(GAS v2u*)(orow + d) = wv; }
}
DI void ffn_act(const bf16* U, bf16* ACT, const float* cw, const float* cb, int half, int gt, int NT) {
    constexpr int NC = DFF / 8, RB = 16, NRB = SEQ / RB;
    for (int it = gt; it < NRB * NC; it += NT) {
        const int cc = it % NC, rb = it / NC, n0 = 8 * cc, t0 = rb * RB;
        float wg[3][8], wv[3][8], bg[8], bv[8];
#pragma unroll
        for (int j = 0; j < 3; ++j)
#pragma unroll
            for (int e = 0; e < 8; ++e) { wg[j][e] = cw[(size_t)j * DFF2 + n0 + e]; wv[j][e] = cw[(size_t)j * DFF2 + DFF + n0 + e]; }
#pragma unroll
        for (int e = 0; e < 8; ++e) { bg[e] = cb[n0 + e]; bv[e] = cb[DFF + n0 + e]; }
        float g1[8], g2[8], v1[8], v2[8];
#pragma unroll
        for (int e = 0; e < 8; ++e) { g1[e] = g2[e] = v1[e] = v2[e] = 0.f; }
        for (int tt = -2; tt < RB; ++tt) {
            const int t = t0 + tt; float gc[8], vc[8];
            if (t >= 0) { const v4u a = *(const GAS v4u*)(U + (size_t)t * DFF2 + n0), bq = *(const GAS v4u*)(U + (size_t)t * DFF2 + DFF + n0);
                const unsigned aw[4] = {a.x, a.y, a.z, a.w}, bw[4] = {bq.x, bq.y, bq.z, bq.w};
#pragma unroll
                for (int e = 0; e < 4; ++e) { gc[2 * e] = bf2f((unsigned short)(aw[e] & 0xffff)); gc[2 * e + 1] = bf2f((unsigned short)(aw[e] >> 16)); vc[2 * e] = bf2f((unsigned short)(bw[e] & 0xffff)); vc[2 * e + 1] = bf2f((unsigned short)(bw[e] >> 16)); }
            } else {
#pragma unroll
                for (int e = 0; e < 8; ++e) { gc[e] = 0.f; vc[e] = 0.f; } }
            if (tt >= 0) {
                float o[8];
#pragma unroll
                for (int e = 0; e < 8; ++e) { const float cg = bg[e] + wg[0][e] * g2[e] + wg[1][e] * g1[e] + wg[2][e] * gc[e], cv = bv[e] + wv[0][e] * v2[e] + wv[1][e] * v1[e] + wv[2][e] * vc[e];
                    o[e] = cg * __builtin_amdgcn_rcpf(1.0f + __expf(-cg)) * cv; }
                v4u ov; ov.x = pk_bf16(o[0], o[1]); ov.y = pk_bf16(o[2], o[3]); ov.z = pk_bf16(o[4], o[5]); ov.w = pk_bf16(o[6], o[7]);
                *(GAS v4u*)(ACT + ((size_t)half * SEQ + t) * DFF + n0) = ov;
            }
#pragma unroll
            for (int e = 0; e < 8; ++e) { g2[e] = g1[e]; g1[e] = gc[e]; v2[e] = v1[e]; v1[e] = vc[e]; }
        }
    }
}
struct Args { Ptrs p; int ph_lo, ph_hi; };
constexpr int N_PHASES = 14;
__global__ void __launch_bounds__(NWAVES * 64, 2) mk_fwd(Args args) {
    extern __shared__ __attribute__((aligned(16))) unsigned char lds_raw[];
    LAS unsigned char* lds = (LAS unsigned char*)lds_raw;
    volatile LAS unsigned* MISC = (volatile LAS unsigned*)(lds + MISC_OFF);
    const int tid = threadIdx.x, lane = tid & 63, wave = __builtin_amdgcn_readfirstlane(tid >> 6);
    const int G = gridDim.x, bx = blockIdx.x;
    const Ptrs& P = args.p; unsigned char* ws = P.ws;
    gu32* ctl = (gu32*)(ws + WS_CTL);
    for (int u = tid; u < (LDS_BYTES - LDSCTL_OFF) / 4; u += NWAVES * 64) ((LAS unsigned*)(lds + LDSCTL_OFF))[u] = 0u;
    __syncthreads();
    XcdBarrier bar = xcd_barrier_post((unsigned*)(ctl + CW_BAR), MISC + 8);
    const int lo = args.ph_lo, hi = args.ph_hi;
#ifndef PHMASK
#define PHMASK 0xffff
#endif
#define IN(k) (((PHMASK >> (k)) & 1) && lo <= (k) && (k) < hi)
#define SEAM(k) do { if (IN(k) && IN((k) + 1)) xcd_barrier(bar); } while (0)
    bf16* HB = (bf16*)(ws + WS_HB); bf16* PROJ = (bf16*)(ws + WS_PROJ);
    const int gw = bx * NWAVES + wave, NGW = G * NWAVES, gt = bx * NWAVES * 64 + tid, NT = G * NWAVES * 64;

    if (IN(0)) { p0_prologue(P, lds, gw, NGW, wave, lane); }
    SEAM(0);
    if (IN(1)) {
        pg8::Gemm g{HB, (const bf16*)(ws + WS_WIN), M, INW, DM, DM}; pg8::StaticOrder S; S.init(M, INW, G, bx);
        pg8::EpiProj E{PROJ, (const float*)(ws + WS_SSQ0), (const float*)(ws + WS_COS), (const float*)(ws + WS_SIN), P.sbq_norm, P.sbk_norm, (float*)(ws + WS_SSQSB)};
        pg8::gemm_phase<pg8::EpiProj, pg8::StaticOrder, true, true>(lds, g, S, E);
    }
    SEAM(1);
    if (IN(2)) { for (int u = bx; u < 2048; u += G) ret_kv_unit(lds, PROJ, (float*)(ws + WS_KV), u, tid); }
    SEAM(2);
    if (IN(3)) { ret_scan((const float*)(ws + WS_KV), (bf16*)(ws + WS_ST), gt, NT); }
    SEAM(3);
    if (IN(4)) {
        for (int u = bx; u < 1024; u += G) sb_unit(lds, PROJ, (const float*)(ws + WS_SSQSB), P.sbo_norm, u, tid);
        for (int u = bx; u < 2048; u += G) ret_out_unit(lds, PROJ, (const bf16*)(ws + WS_ST), P.ret_norm, u, tid);
        __syncthreads();
    }
    SEAM(4);
    if (IN(5)) {
        pg8::Gemm g{PROJ, (const bf16*)(ws + WS_WOUT), M, DM, DM, INW}; pg8::StaticOrder S; S.init(M, DM, G, bx);
        pg8::EpiRes<true> E{P.x, P.out, HB, (float*)(ws + WS_SSQ1)};
        pg8::gemm_phase<pg8::EpiRes<true>, pg8::StaticOrder, true, true>(lds, g, S, E);
    }
    SEAM(5);
    if (IN(6)) {
        { pg8::Gemm g{HB, (const bf16*)(ws + WS_WQKV), M, CW, DM, DM}; pg8::StaticOrder S; S.init(M, CW, G, bx);
          pg8::EpiScaleF32<64> E{(float*)(ws + WS_CQ), CW, (const float*)(ws + WS_SSQ1)};
          pg8::gemm_phase<pg8::EpiScaleF32<64>, pg8::StaticOrder, true, true>(lds, g, S, E); }
        __syncthreads();
        { pg8::Gemm g{(const bf16*)(ws + WS_MB), (const bf16*)(ws + WS_WQKV) + (size_t)CW * DM, BATCH * NMEM, 2 * CW, DM, DM}; pg8::StaticOrder S; S.init(BATCH * NMEM, 2 * CW, G, (bx + G / 2) % G);
          pg8::EpiScaleF32<1> E{(float*)(ws + WS_CKV), 2 * CW, (const float*)(ws + WS_SSQM)};
          pg8::gemm_phase<pg8::EpiScaleF32<1>, pg8::StaticOrder, true, true>(lds, g, S, E); }
    }
    SEAM(6);
    if (IN(7)) { for (int u = bx; u < 256; u += G) cross_unit(lds, (const float*)(ws + WS_CQ), (const float*)(ws + WS_CKV), P.cq_norm, P.ck_norm, (bf16*)(ws + WS_CO), u, tid); __syncthreads(); }
    SEAM(7);
    if (IN(8)) {
        pg8::Gemm g{(const bf16*)(ws + WS_CO), (const bf16*)(ws + WS_WO), M, DM, CW, CW}; pg8::StaticOrder S; S.init(M, DM, G, bx);
        pg8::EpiRes<true> E{P.out, P.out, HB, (float*)(ws + WS_SSQ2)};
        pg8::gemm_phase<pg8::EpiRes<true>, pg8::StaticOrder, true, true>(lds, g, S, E);
    }
    SEAM(8);
    if (IN(9)) {
        pg8::Gemm g{HB, (const bf16*)(ws + WS_WUP), SEQ, DFF2, DM, DM}; pg8::StaticOrder S; S.init(SEQ, DFF2, G, bx, 0);
        pg8::EpiScaleBf16 E{(bf16*)(ws + WS_U), DFF2, (const float*)(ws + WS_SSQ2)};
        pg8::gemm_phase<pg8::EpiScaleBf16, pg8::StaticOrder, true, true>(lds, g, S, E);
    }
    SEAM(9);
    if (IN(10)) { ffn_act((const bf16*)(ws + WS_U), (bf16*)(ws + WS_ACT), P.conv_w, P.conv_b, 0, gt, NT); }
    SEAM(10);
    if (IN(11)) {
        pg8::Gemm g{HB, (const bf16*)(ws + WS_WUP), SEQ, DFF2, DM, DM}; pg8::StaticOrder S; S.init(SEQ, DFF2, G, bx, SEQ / 256);
        pg8::EpiScaleBf16 E{(bf16*)(ws + WS_U) - (size_t)SEQ * DFF2, DFF2, (const float*)(ws + WS_SSQ2)};
        pg8::gemm_phase<pg8::EpiScaleBf16, pg8::StaticOrder, true, true>(lds, g, S, E);
    }
    SEAM(11);
    if (IN(12)) { ffn_act((const bf16*)(ws + WS_U), (bf16*)(ws + WS_ACT), P.conv_w, P.conv_b, 1, gt, NT); }
    SEAM(12);
    if (IN(13)) {
        pg8::Gemm g{(const bf16*)(ws + WS_ACT), (const bf16*)(ws + WS_WDOWN), M, DM, DFF, DFF}; pg8::StaticOrder S; S.init(M, DM, G, bx);
        pg8::EpiRes<false> E{P.out, P.out, nullptr, nullptr};
        pg8::gemm_phase<pg8::EpiRes<false>, pg8::StaticOrder, true, true>(lds, g, S, E);
    }
#undef IN
#undef SEAM
}

#ifndef MK_CUTS
#define MK_CUTS 0
#endif
extern "C" void kernel_launch(void* const* d_in, const int* in_sizes, int n_in, void* d_out, int out_size, void* d_ws, size_t ws_size, hipStream_t stream) {
    static int grid = 0;
    if (grid == 0) {
        if (n_in != 21 || in_sizes[0] != M * DM || out_size != M * DM || ws_size < WS_END) { fprintf(stderr, "kernel_launch: unexpected shapes (n_in %d, in0 %d, out %d, ws %zu < %zu); nothing launched\n", n_in, n_in > 0 ? in_sizes[0] : -1, out_size, ws_size, (size_t)WS_END); grid = -1; return; }
        int dev = 0, cus = 0, per_cu = 0;
        if (hipGetDevice(&dev) != hipSuccess || hipDeviceGetAttribute(&cus, hipDeviceAttributeMultiprocessorCount, dev) != hipSuccess) { grid = -1; return; }
        if (hipFuncSetAttribute((const void*)mk_fwd, hipFuncAttributeMaxDynamicSharedMemorySize, LDS_BYTES) != hipSuccess) { fprintf(stderr, "kernel_launch: hipFuncSetAttribute failed\n"); grid = -1; return; }
        if (hipOccupancyMaxActiveBlocksPerMultiprocessor(&per_cu, (const void*)mk_fwd, NWAVES * 64, LDS_BYTES) != hipSuccess || per_cu < 1) fprintf(stderr, "kernel_launch: note: occupancy query reports %d\n", per_cu);
        (void)hipGetLastError();
        grid = cus;
    }
    if (grid < 0) return;
    if (hipMemsetAsync((char*)d_ws + WS_CTL, 0, CTL_ZERO_BYTES, stream) != hipSuccess) return;
    Args a{};
    const float** pp = (const float**)&a.p;
    for (int i = 0; i < 21; ++i) pp[i] = (const float*)d_in[i];
    a.p.out = (float*)d_out; a.p.ws = (unsigned char*)d_ws;
#if MK_CUTS
    for (int ph = 0; ph < N_PHASES; ++ph) { a.ph_lo = ph; a.ph_hi = ph + 1; hipLaunchKernelGGL(mk_fwd, dim3(grid), dim3(NWAVES * 64), LDS_BYTES, stream, a); }
#else
    a.ph_lo = 0; a.ph_hi = N_PHASES;
    hipLaunchKernelGGL(mk_fwd, dim3(grid), dim3(NWAVES * 64), LDS_BYTES, stream, a);
#endif
    const hipError_t le = hipPeekAtLastError();
    if (le != hipSuccess) fprintf(stderr, "kernel_launch: launch failed: %s\n", hipGetErrorName(le));
}
```

```cpp
#include <hip/hip_runtime.h>
#include <cstdio>
#include <cstdint>
namespace pg8 {
#define PG8_LAS __attribute__((address_space(3)))
typedef unsigned short bf16_t;
typedef short bf16x8 __attribute__((ext_vector_type(8)));
typedef float f32x4 __attribute__((ext_vector_type(4)));
typedef unsigned u32x4 __attribute__((ext_vector_type(4)));
typedef unsigned u32x2 __attribute__((ext_vector_type(2)));
constexpr int BM = 256, BK = 64, HALF = 128, HTB = HALF * BK * 2  , STAGE_BYTES = 8 * HTB, NXCD = 8, WGM = 8;

__host__ __device__ __forceinline__ int lds_byte(int r, int c) { const int st = (r >> 4) * 2 + (c >> 5), rr = r & 15, cc = c & 31, ob = rr * 64 + cc * 2; return st * 1024 + (ob ^ (((ob >> 9) & 1) << 5)); }
__host__ __device__ __forceinline__ void stage_rc(int b, int& R, int& C) { const int st = b / 1024, sb = b % 1024, swz = sb ^ (((sb >> 9) & 1) << 5); R = (st >> 1) * 16 + swz / 64; C = (st & 1) * 32 + (swz % 64) / 2; }
__host__ __device__ __forceinline__ int perm32(int rho) { const int n = rho >> 4, i = rho & 15; return 8 * (i >> 2) + 4 * n + (i & 3); }
template <int PERM> __host__ __device__ __forceinline__ int permrow(int R) {
    if (PERM == 1) return (R & ~31) + perm32(R & 31);
    if (PERM == 2) return 64 * ((R >> 4) & 1) + 16 * (R >> 5) + (R & 15);
    return R;
}

struct Unit { int pm, pn; };
struct Gemm { const bf16_t* A; const bf16_t* Bt; int M, N, K, lda; };

struct StaticOrder {
    int nM, nN, nwg, G, c, pm0;
    __host__ __device__ void init(int M, int N, int G_, int c_, int pm0_ = 0) { nM = M / BM; nN = N / BM; nwg = nM * nN; G = G_; c = c_; pm0 = pm0_; }
    __host__ __device__ bool next(int i, Unit& u) const {
        const long L = (long)i * G + c; if (L >= nwg) return false;
        int wgid = (int)L; { const int q = nwg / NXCD, r = nwg % NXCD, xcd = wgid % NXCD, off = wgid / NXCD; wgid = (xcd < r ? xcd * (q + 1) : r * (q + 1) + (xcd - r) * q) + off; }
        const int nig = WGM * nN, gid = wgid / nig, fm = gid * WGM, gsz = (nM - fm) < WGM ? (nM - fm) : WGM;
        u.pm = pm0 + fm + ((wgid % nig) % gsz); u.pn = (wgid % nig) / gsz; return true;
    }
    __device__ __forceinline__ void a_ready(const Unit&) const {}
    __device__ __forceinline__ void done(const Unit&) const {}
};

typedef float f32x2 __attribute__((ext_vector_type(2)));
typedef __bf16 bf16v2 __attribute__((ext_vector_type(2)));
__device__ __forceinline__ unsigned pk_bf16(float lo, float hi) { const f32x2 f = {lo, hi}; const bf16v2 r = __builtin_convertvector(f, bf16v2); return __builtin_bit_cast(unsigned, r); }
constexpr float EPSN = 1e-6f;
__constant__ float LOGG[16] = { -3.174869716e-02f, -1.574835740e-02f, -7.843177766e-03f, -3.913899418e-03f, -1.955034910e-03f, -9.770396864e-04f, -4.884005175e-04f, -2.441704273e-04f,
                                -1.220777631e-04f, -6.103701890e-05f, -3.051804379e-05f, -1.525890548e-05f, -7.629423635e-06f, -3.814704542e-06f, -1.907350452e-06f, -9.536747712e-07f };
__device__ __forceinline__ float hsum4(const f32x4 v) { return (v[0] + v[1]) + (v[2] + v[3]); }
__device__ __forceinline__ float dot4(const f32x4 a, const f32x4 b) { return (a[0] * b[0] + a[1] * b[1]) + (a[2] * b[2] + a[3] * b[3]); }
__device__ __forceinline__ float row_rstd64(const float* part, int row, int fq, float invn) {
    const f32x4* p = (const f32x4*)(part + (size_t)row * 64 + fq * 16);
    float s = (hsum4(p[0]) + hsum4(p[1])) + (hsum4(p[2]) + hsum4(p[3]));
    s += __shfl_xor(s, 16); s += __shfl_xor(s, 32);
    return rsqrtf(s * invn + EPSN);
}

#define EPI_FENCE() asm volatile("" ::: "memory")
struct EpiProj {
    static constexpr int PERM = 2; static constexpr bool AFTER_DRAIN = false;
    bf16_t* P; const float* ssq0; const float* cosT; const float* sinT; const float* gq; const float* gk; float* ssqsb;
    template <int REG> __device__ __forceinline__ void body(const f32x4 (&acc)[2][2][4][2], const Unit& u, int wr, int wc, int fr, int fq) const {
        constexpr bool ROPE = (REG == 0 || REG == 2);
        const int pnr = u.pn & 7, d0 = 16 * wc + 4 * fq, rowb = u.pm * BM + wr * 64 + fr;
        float lg[2] = {0.f, 0.f}; f32x4 g0 = {1.f, 1.f, 1.f, 1.f}, g1 = g0;
        if (ROPE) { lg[0] = LOGG[2 * pnr]; lg[1] = LOGG[2 * pnr + 1]; }
        if (REG == 1 || REG == 5) { const float* g = (REG == 1) ? gq : gk; g0 = *(const f32x4*)(g + d0); g1 = *(const f32x4*)(g + 64 + d0); }
        float rsv[8];
#pragma unroll
        for (int g = 0; g < 8; ++g) rsv[g] = ssq0[rowb + (g >> 2) * HALF + (g & 3) * 16];
        f32x4 csn = {0.f, 0.f, 0.f, 0.f}, snn = csn;
        if (ROPE) { const int t = rowb & 8191; csn = *(const f32x4*)(cosT + (size_t)t * 64 + d0); snn = *(const f32x4*)(sinT + (size_t)t * 64 + d0); }
        EPI_FENCE();
#pragma unroll
        for (int g = 0; g < 8; ++g) {
            const int ai = g >> 2, m = g & 3;
            const int row = rowb + ai * HALF + m * 16;
            const float rs = rsqrtf(rsv[g] * (1.0f / 4096.0f) + EPSN);
            const int t = row & 8191; const float cpos = (float)(t & 127);
            const f32x4 cs = csn, sn = snn;
            if (ROPE && g < 7) { const int tn = (rowb + ((g + 1) >> 2) * HALF + ((g + 1) & 3) * 16) & 8191; csn = *(const f32x4*)(cosT + (size_t)tn * 64 + d0); snn = *(const f32x4*)(sinT + (size_t)tn * 64 + d0); }
            EPI_FENCE();
            bf16_t* rowp = P + (size_t)row * 14336 + u.pn * BM + d0;
#pragma unroll
            for (int bj = 0; bj < 2; ++bj) {
                const f32x4 v0 = acc[ai][bj][m][0] * rs, v1 = acc[ai][bj][m][1] * rs;
                f32x4 o0 = v0, o1 = v1;
                if (REG == 0) { const float sc = 0.08838834764831845f * __expf(cpos * lg[bj]); o0 = (v0 * cs - v1 * sn) * sc; o1 = (v1 * cs + v0 * sn) * sc; }
                if (REG == 2) { const float sc = __expf(-cpos * lg[bj]); o0 = (v0 * cs - v1 * sn) * sc; o1 = (v1 * cs + v0 * sn) * sc; }
                if (REG == 4) {
#pragma unroll
                    for (int j = 0; j < 4; ++j) { o0[j] = v0[j] * __builtin_amdgcn_rcpf(1.0f + __expf(-v0[j])); o1[j] = v1[j] * __builtin_amdgcn_rcpf(1.0f + __expf(-v1[j])); } }
                if (REG == 1 || REG == 5) {
                    float s = dot4(v0, v0) + dot4(v1, v1); s += __shfl_xor(s, 16); s += __shfl_xor(s, 32);
                    if (fq == 0) ssqsb[((size_t)row * 32 + (REG == 1 ? 0 : 16) + 2 * pnr + bj) * 4 + wc] = s;
                    o0 = v0 * g0; o1 = v1 * g1; }
                u32x2 w0, w1; w0.x = pk_bf16(o0[0], o0[1]); w0.y = pk_bf16(o0[2], o0[3]); w1.x = pk_bf16(o1[0], o1[1]); w1.y = pk_bf16(o1[2], o1[3]);
                *(u32x2*)(rowp + bj * HALF) = w0; *(u32x2*)(rowp + bj * HALF + 64) = w1;
            }
        }
    }
    __device__ __forceinline__ void operator()(const f32x4 (&acc)[2][2][4][2], const Unit& u, int wr, int wc, int fr, int fq) const {
        const int reg = u.pn >> 3;
        if (reg == 0) body<0>(acc, u, wr, wc, fr, fq); else if (reg == 1) body<1>(acc, u, wr, wc, fr, fq); else if (reg == 2) body<2>(acc, u, wr, wc, fr, fq);
        else if (reg == 4) body<4>(acc, u, wr, wc, fr, fq); else if (reg == 5) body<5>(acc, u, wr, wc, fr, fq); else body<3>(acc, u, wr, wc, fr, fq);
    }
};

template <bool WITH_HB> struct EpiRes {
    static constexpr int PERM = 1; static constexpr bool AFTER_DRAIN = false;
    const float* base; float* out; bf16_t* hb; float* ssq;
    __device__ __forceinline__ void operator()(const f32x4 (&acc)[2][2][4][2], const Unit& u, int wr, int wc, int fr, int fq) const {
        const int col0 = u.pn * BM + wc * 32 + 8 * fq, rowb = u.pm * BM + wr * 64 + fr;
        f32x4 bn[2][2];
#pragma unroll
        for (int bj = 0; bj < 2; ++bj) { const size_t off = (size_t)rowb * 4096 + col0 + bj * HALF; bn[bj][0] = *(const f32x4*)(base + off); bn[bj][1] = *(const f32x4*)(base + off + 4); }
#pragma unroll
        for (int g = 0; g < 8; ++g) {
            const int ai = g >> 2, m = g & 3, row = rowb + ai * HALF + m * 16; float s = 0.f;
            f32x4 b[2][2];
#pragma unroll
            for (int bj = 0; bj < 2; ++bj) { b[bj][0] = bn[bj][0]; b[bj][1] = bn[bj][1]; }
            if (g < 7) { const int rown = rowb + ((g + 1) >> 2) * HALF + ((g + 1) & 3) * 16;
#pragma unroll
                for (int bj = 0; bj < 2; ++bj) { const size_t off = (size_t)rown * 4096 + col0 + bj * HALF; bn[bj][0] = *(const f32x4*)(base + off); bn[bj][1] = *(const f32x4*)(base + off + 4); } }
            EPI_FENCE();
#pragma unroll
            for (int bj = 0; bj < 2; ++bj) {
                const size_t off = (size_t)row * 4096 + col0 + bj * HALF;
                const f32x4 o0 = b[bj][0] + acc[ai][bj][m][0], o1 = b[bj][1] + acc[ai][bj][m][1];
                *(f32x4*)(out + off) = o0; *(f32x4*)(out + off + 4) = o1;
                if (WITH_HB) { u32x4 w; w.x = pk_bf16(o0[0], o0[1]); w.y = pk_bf16(o0[2], o0[3]); w.z = pk_bf16(o1[0], o1[1]); w.w = pk_bf16(o1[2], o1[3]); *(u32x4*)(hb + off) = w; s += dot4(o0, o0) + dot4(o1, o1); }
            }
            if (WITH_HB) { s += __shfl_xor(s, 16); s += __shfl_xor(s, 32); if (fq == 0) __hip_atomic_fetch_add(ssq + row, s, __ATOMIC_RELAXED, __HIP_MEMORY_SCOPE_AGENT); }
            EPI_FENCE();
        }
    }
};

struct EpiScaleF32 {
    static constexpr int PERM = 1; static constexpr bool AFTER_DRAIN = false;
    float* C; int ldc; const float* ssq;
    __device__ __forceinline__ void operator()(const f32x4 (&acc)[2][2][4][2], const Unit& u, int wr, int wc, int fr, int fq) const {
        const int col0 = u.pn * BM + wc * 32 + 8 * fq, rowb = u.pm * BM + wr * 64 + fr;
        float rsv[8];
#pragma unroll
        for (int g = 0; g < 8; ++g) rsv[g] = ssq[rowb + (g >> 2) * HALF + (g & 3) * 16];
        EPI_FENCE();
#pragma unroll
        for (int g = 0; g < 8; ++g) {
            const int ai = g >> 2, m = g & 3, row = rowb + ai * HALF + m * 16; const float rs = rsqrtf(rsv[g] * (1.0f / 4096.0f) + EPSN);
#pragma unroll
            for (int bj = 0; bj < 2; ++bj) { float* p = C + (size_t)row * ldc + col0 + bj * HALF; *(f32x4*)p = acc[ai][bj][m][0] * rs; *(f32x4*)(p + 4) = acc[ai][bj][m][1] * rs; }
        }
    }
};
struct EpiScaleBf16 {
    static constexpr int PERM = 1; static constexpr bool AFTER_DRAIN = false;
    bf16_t* O; int ldc; const float* ssq;
    __device__ __forceinline__ void operator()(const f32x4 (&acc)[2][2][4][2], const Unit& u, int wr, int wc, int fr, int fq) const {
        const int col0 = u.pn * BM + wc * 32 + 8 * fq, rowb = u.pm * BM + wr * 64 + fr;
        float rsv[8];
#pragma unroll
        for (int g = 0; g < 8; ++g) rsv[g] = ssq[rowb + (g >> 2) * HALF + (g & 3) * 16];
        EPI_FENCE();
#pragma unroll
        for (int g = 0; g < 8; ++g) {
            const int ai = g >> 2, m = g & 3, row = rowb + ai * HALF + m * 16; const float rs = rsqrtf(rsv[g] * (1.0f / 4096.0f) + EPSN);
#pragma unroll
            for (int bj = 0; bj < 2; ++bj) { const f32x4 v0 = acc[ai][bj][m][0] * rs, v1 = acc[ai][bj][m][1] * rs;
                u32x4 w; w.x = pk_bf16(v0[0], v0[1]); w.y = pk_bf16(v0[2], v0[3]); w.z = pk_bf16(v1[0], v1[1]); w.w = pk_bf16(v1[2], v1[3]);
                *(u32x4*)(O + (size_t)row * ldc + col0 + bj * HALF) = w; }
        }
    }
};

template <class Epi, class Sched, bool ALIGN_EPI = false, bool SP2 = false>
__device__ __forceinline__ void gemm_phase(PG8_LAS unsigned char* lds, const Gemm g, const Sched& S, const Epi& E) {
    const int tid = threadIdx.x, wid = __builtin_amdgcn_readfirstlane(tid >> 6), lane = tid & 63, wr = wid >> 2, wc = wid & 3, fr = lane & 15, fq = lane >> 4;
    const int K = g.K, nt = K / BK;
    unsigned voffA[2], voffB[2];
#pragma unroll
    for (int i = 0; i < 2; ++i) { int R, C; stage_rc(tid * 16 + i * 8192, R, C); const int Rb = permrow<Epi::PERM>(R);
        voffA[i] = (unsigned)(R * g.lda + C) * 2u; voffB[i] = (unsigned)(Rb * K + C) * 2u; }
    const size_t kstep = (size_t)(BK * 2);
    const size_t hstep = (size_t)HALF * K * 2;
    const size_t tstep = 2 * hstep;
    const size_t hstepA = (size_t)HALF * g.lda * 2, tstepA = 2 * hstepA;
    const unsigned ldsw = (unsigned)wid * 1024u;
    const int aoff = lds_byte(wr * 64 + fr, fq * 8), boff = lds_byte(wc * 32 + fr, fq * 8);
#define PG8_SA(b, h) (((b) * 2 + (h)) * HTB)
#define PG8_SB(b, h) ((4 + (b) * 2 + (h)) * HTB)
#define PG8_STAGE(bufoff, gbase, voff) do { _Pragma("unroll") for (int _i = 0; _i < 2; ++_i) \
        __builtin_amdgcn_global_load_lds((const unsigned*)((const char*)(gbase) + (voff)[_i]), (PG8_LAS unsigned*)(lds + (bufoff) + ldsw + _i * 8192), 16, 0, 0); } while (0)
#define PG8_LDA(dst, b, h) do { _Pragma("unroll") for (int m = 0; m < 4; ++m) _Pragma("unroll") for (int k = 0; k < 2; ++k) dst[m][k] = *(const PG8_LAS bf16x8*)(lds + PG8_SA(b, h) + aoff + m * 2048 + k * 1024); } while (0)
#define PG8_LDB(dst, b, h) do { _Pragma("unroll") for (int n = 0; n < 2; ++n) _Pragma("unroll") for (int k = 0; k < 2; ++k) dst[n][k] = *(const PG8_LAS bf16x8*)(lds + PG8_SB(b, h) + boff + n * 2048 + k * 1024); } while (0)
#define PG8_MMA(ai, bj, At, Bt) do { __builtin_amdgcn_s_setprio(1); _Pragma("unroll") for (int m = 0; m < 4; ++m) _Pragma("unroll") for (int n = 0; n < 2; ++n) _Pragma("unroll") for (int k = 0; k < 2; ++k) \
        acc[ai][bj][m][n] = __builtin_amdgcn_mfma_f32_16x16x32_bf16(Bt[n][k], At[m][k], acc[ai][bj][m][n], 0, 0, 0); __builtin_amdgcn_s_setprio(0); } while (0)
#define PG8_WAIT_V(n) asm volatile("s_waitcnt vmcnt(" #n ")" ::: "memory")
#define PG8_WAIT_L(n) asm volatile("s_waitcnt lgkmcnt(" #n ")" ::: "memory")
#define PG8_BAR __builtin_amdgcn_s_barrier()
#define PG8_SCHED __builtin_amdgcn_sched_barrier(0)
    Unit cur, nxt; int ui = 0;
    if (!S.next(0, cur)) return;
    f32x4 acc[2][2][4][2];
#pragma unroll
    for (int a = 0; a < 2; ++a)
#pragma unroll
        for (int b = 0; b < 2; ++b)
#pragma unroll
            for (int m = 0; m < 4; ++m)
#pragma unroll
                for (int n = 0; n < 2; ++n) acc[a][b][m][n] = (f32x4){0.f, 0.f, 0.f, 0.f};
    bf16x8 At[4][2], B0[2][2], B1[2][2];
    const char* cA = (const char*)g.A + (size_t)cur.pm * tstepA; const char* cB = (const char*)g.Bt + (size_t)cur.pn * tstep;
    S.a_ready(cur);
    if constexpr (SP2) {
        PG8_STAGE(PG8_SB(0, 0), cB, voffB); PG8_STAGE(PG8_SB(0, 1), cB + hstep, voffB); PG8_STAGE(PG8_SA(0, 0), cA, voffA); PG8_STAGE(PG8_SA(0, 1), cA + hstepA, voffA);
        if (wr == 1) PG8_BAR;
        PG8_WAIT_V(2); PG8_BAR;
        PG8_STAGE(PG8_SB(1, 0), cB + kstep, voffB); PG8_STAGE(PG8_SA(1, 0), cA + kstep, voffA); PG8_STAGE(PG8_SB(1, 1), cB + hstep + kstep, voffB);
        PG8_WAIT_V(6); PG8_BAR;
    } else {
        PG8_STAGE(PG8_SB(0, 0), cB, voffB); PG8_STAGE(PG8_SA(0, 0), cA, voffA); PG8_STAGE(PG8_SB(0, 1), cB + hstep, voffB); PG8_STAGE(PG8_SA(0, 1), cA + hstepA, voffA);
        if (wr == 1) PG8_BAR;
        PG8_WAIT_V(4); PG8_BAR;
        PG8_STAGE(PG8_SB(1, 0), cB + kstep, voffB); PG8_STAGE(PG8_SA(1, 0), cA + kstep, voffA); PG8_STAGE(PG8_SB(1, 1), cB + hstep + kstep, voffB);
        PG8_WAIT_V(6); PG8_BAR;
    }
    for (;;) {
        const bool has_next = S.next(ui + 1, nxt);
        const char* nA = has_next ? (const char*)g.A + (size_t)nxt.pm * tstepA : cA; const char* nB = has_next ? (const char*)g.Bt + (size_t)nxt.pn * tstep : cB;
        for (int t = 0; t < nt; t += 2) {
            const bool last = (t == nt - 2);
            const char* a1 = cA + (size_t)(t + 1) * kstep;
            const char* a2 = last ? nA : cA + (size_t)(t + 2) * kstep; const char* b2 = last ? nB : cB + (size_t)(t + 2) * kstep;
            const char* a3 = a2 + kstep; const char* b3 = b2 + kstep;
            if (last && has_next) S.a_ready(nxt);
            if constexpr (SP2) {
            PG8_LDB(B0, 0, 0); PG8_LDB(B1, 0, 1); PG8_SCHED; PG8_LDA(At, 0, 0); PG8_STAGE(PG8_SA(1, 1), a1 + hstepA, voffA);
            PG8_WAIT_V(8); PG8_WAIT_L(0); PG8_BAR; PG8_MMA(0, 0, At, B0); PG8_MMA(0, 1, At, B1); PG8_BAR; PG8_SCHED;
            PG8_LDA(At, 0, 1); PG8_STAGE(PG8_SB(0, 0), b2, voffB); PG8_STAGE(PG8_SB(0, 1), b2 + hstep, voffB); PG8_STAGE(PG8_SA(0, 0), a2, voffA);
            PG8_WAIT_V(8); PG8_WAIT_L(0); PG8_BAR; PG8_MMA(1, 0, At, B0); PG8_MMA(1, 1, At, B1); PG8_BAR; PG8_SCHED;
            PG8_LDB(B0, 1, 0); PG8_LDB(B1, 1, 1); PG8_SCHED; PG8_LDA(At, 1, 0); PG8_STAGE(PG8_SA(0, 1), a2 + hstepA, voffA);
            PG8_WAIT_V(8); PG8_WAIT_L(0); PG8_BAR; PG8_MMA(0, 0, At, B0); PG8_MMA(0, 1, At, B1); PG8_BAR; PG8_SCHED;
            PG8_LDA(At, 1, 1); PG8_STAGE(PG8_SB(1, 0), b3, voffB); PG8_STAGE(PG8_SB(1, 1), b3 + hstep, voffB); PG8_STAGE(PG8_SA(1, 0), a3, voffA);
            PG8_WAIT_V(8); PG8_WAIT_L(0); PG8_BAR; PG8_MMA(1, 0, At, B0); PG8_MMA(1, 1, At, B1); PG8_BAR; PG8_SCHED;
            } else {
            PG8_LDB(B0, 0, 0); PG8_SCHED; PG8_LDA(At, 0, 0); PG8_STAGE(PG8_SA(1, 1), a1 + hstepA, voffA);
            PG8_WAIT_L(8); PG8_BAR; PG8_WAIT_L(0); PG8_MMA(0, 0, At, B0); PG8_BAR; PG8_SCHED;
            PG8_LDB(B1, 0, 1); PG8_STAGE(PG8_SB(0, 0), b2, voffB);
            PG8_BAR; PG8_WAIT_L(0); PG8_MMA(0, 1, At, B1); PG8_BAR;
            PG8_LDA(At, 0, 1); PG8_STAGE(PG8_SA(0, 0), a2, voffA);
            PG8_BAR; PG8_WAIT_L(0); PG8_MMA(1, 0, At, B0); PG8_BAR; PG8_SCHED;
            PG8_STAGE(PG8_SB(0, 1), b2 + hstep, voffB);
            PG8_WAIT_V(6); PG8_BAR; PG8_MMA(1, 1, At, B1); PG8_BAR;
            PG8_LDB(B0, 1, 0); PG8_SCHED; PG8_LDA(At, 1, 0); PG8_STAGE(PG8_SA(0, 1), a2 + hstepA, voffA);
            PG8_WAIT_L(8); PG8_BAR; PG8_WAIT_L(0); PG8_MMA(0, 0, At, B0); PG8_BAR; PG8_SCHED;
            PG8_LDB(B1, 1, 1); PG8_STAGE(PG8_SB(1, 0), b3, voffB);
            PG8_BAR; PG8_WAIT_L(0); PG8_MMA(0, 1, At, B1); PG8_BAR;
            PG8_LDA(At, 1, 1); PG8_STAGE(PG8_SA(1, 0), a3, voffA);
            PG8_BAR; PG8_WAIT_L(0); PG8_MMA(1, 0, At, B0); PG8_BAR; PG8_SCHED;
            PG8_STAGE(PG8_SB(1, 1), b3 + hstep, voffB);
            PG8_WAIT_V(6); PG8_BAR; PG8_MMA(1, 1, At, B1); PG8_BAR;
            }
        }
        if constexpr (ALIGN_EPI) { if (wr == 0) PG8_BAR; }
        if constexpr (!Epi::AFTER_DRAIN) { E(acc, cur, wr, wc, fr, fq); S.done(cur); }
        if (!has_next) break;
#pragma unroll
        for (int a = 0; a < 2; ++a)
#pragma unroll
            for (int b = 0; b < 2; ++b)
#pragma unroll
                for (int m = 0; m < 4; ++m)
#pragma unroll
                    for (int n = 0; n < 2; ++n) acc[a][b][m][n] = (f32x4){0.f, 0.f, 0.f, 0.f};
        cur = nxt; cA = nA; cB = nB; ++ui;
        if constexpr (ALIGN_EPI) { if (wr == 1) PG8_BAR; }
    }
    PG8_WAIT_V(0);
    if constexpr (!ALIGN_EPI) { if (wr == 0) PG8_BAR; }
    PG8_BAR;
    if constexpr (Epi::AFTER_DRAIN) { E.fused(acc, cur, wr, wc, fr, fq, lds, wid, lane); S.done(cur); }
#undef PG8_SA
#undef PG8_SB
#undef PG8_STAGE
#undef PG8_LDA
#undef PG8_LDB
#undef PG8_MMA
#undef PG8_WAIT_V
#undef PG8_WAIT_L
#undef PG8_BAR
#undef PG8_SCHED
}
}
#define LAS __attribute__((address_space(3)))
#define XB_TMO      128
#define XB_XCNT(j)  (256  + 64 * (j))
#define XB_XSUB(j)  (1280 + 64 * (j))
#define XB_XGEN(j)  (2304 + 64 * (j))
#define XB_TOP      3328
#define XB_TOPGEN   3392
#define XCD_BAR_WORDS 3456
#define XB_SPIN_CAP (1u << 18)

__device__ __forceinline__ unsigned xb_ld(unsigned* p)              { return __hip_atomic_load(p, __ATOMIC_RELAXED, __HIP_MEMORY_SCOPE_AGENT); }
__device__ __forceinline__ unsigned xb_add(unsigned* p, unsigned v) { return __hip_atomic_fetch_add(p, v, __ATOMIC_RELAXED, __HIP_MEMORY_SCOPE_AGENT); }
__device__ __forceinline__ unsigned xb_xcc_id() { return (unsigned)__builtin_amdgcn_s_getreg((3 << 11) | 20) & 0xFu; }
#define XB_SPIN(cond, bar) do { unsigned _sp = 0; while (cond) { __builtin_amdgcn_s_sleep(1); \
    if ((++_sp & 255u) == 0u) { if (xb_ld(&(bar)[XB_TMO])) break; if (_sp > XB_SPIN_CAP) { atomicAdd(&(bar)[XB_TMO], 1u); break; } } } } while (0)

struct XcdBarrier {
    unsigned* bar; unsigned x;
    volatile LAS unsigned* st;
};

__device__ __forceinline__ XcdBarrier xcd_barrier_post(unsigned* bar, volatile LAS unsigned* st) {
    XcdBarrier b; b.bar = bar; b.x = xb_xcc_id(); b.st = st;
    if (threadIdx.x == 0) (void)xb_add(&bar[XB_XCNT(b.x)], 1u);
    return b;
}
__device__ __forceinline__ void xcd_barrier_complete(unsigned* bar, unsigned x, unsigned& nloc, unsigned& nx) {
    const unsigned G = gridDim.x * gridDim.y * gridDim.z;
    unsigned sum, cnt, mine, sp = 0u;
    for (;;) {
        sum = 0u; cnt = 0u; mine = 0u;
#pragma unroll
        for (unsigned j = 0; j < 16; ++j) { const unsigned c = xb_ld(&bar[XB_XCNT(j)]); sum += c; cnt += (c > 0u) ? 1u : 0u; mine = (j == x) ? c : mine; }
        if (sum == G) break;
        __builtin_amdgcn_s_sleep(1);
        if ((++sp & 255u) == 0u) { if (xb_ld(&bar[XB_TMO])) break; if (sp > XB_SPIN_CAP) { atomicAdd(&bar[XB_TMO], 1u); break; } }
    }
    nloc = mine > 0u ? mine : 1u; nx = cnt > 0u ? cnt : 1u;
}

__device__ __forceinline__ void xcd_barrier(const XcdBarrier& b) {
    asm volatile("s_waitcnt vmcnt(0)" ::: "memory");
    __syncthreads();
    if (threadIdx.x == 0) {
        unsigned* bar = b.bar;
        __builtin_amdgcn_s_waitcnt(0);
        unsigned nloc = b.st[0], nx = b.st[1];
        if (nloc == 0u) { xcd_barrier_complete(bar, b.x, nloc, nx); b.st[0] = nloc; b.st[1] = nx; }
        const unsigned old = xb_add(&bar[XB_XSUB(b.x)], 1u);
        const unsigned gen = old / nloc;
        if (old + 1u == (gen + 1u) * nloc) {
            __builtin_amdgcn_fence(__ATOMIC_RELEASE, "agent");
            asm volatile("s_waitcnt vmcnt(0)" ::: "memory");
            const unsigned og = xb_add(&bar[XB_TOP], 1u);
            const unsigned tg = og / nx;
            if (og + 1u == (tg + 1u) * nx) xb_add(&bar[XB_TOPGEN], 1u);
            else XB_SPIN(xb_ld(&bar[XB_TOPGEN]) == tg, bar);
            __builtin_amdgcn_fence(__ATOMIC_ACQUIRE, "agent");
            xb_add(&bar[XB_XGEN(b.x)], 1u);
            asm volatile("s_waitcnt vmcnt(0)" ::: "memory");
        } else {
            XB_SPIN(xb_ld(&bar[XB_XGEN(b.x)]) == gen, bar);
            __builtin_amdgcn_fence(__ATOMIC_ACQUIRE, "agent");
            asm volatile("s_waitcnt vmcnt(0)" ::: "memory");
        }
    }
    __syncthreads();
}
constexpr int NWAVES = 8;
constexpr int SEQ = 8192, BATCH = 2, M = BATCH * SEQ, DM = 4096, HD = 128, NH = 16, INW = 14336, NMEM = 256, CW = 512, DFF = 11008, DFF2 = 2 * DFF;
constexpr int C_RQ = 0, C_SQ = 2048, C_RK = 4096, C_RV = 6144, C_RG = 8192, C_SK = 10240, C_SV = 12288;
constexpr float SB_EXIT = 110.0f;
constexpr size_t MiB = 1u << 20;
constexpr size_t WS_CTL = 0, CTL_ZERO_BYTES = 1 * MiB;
constexpr size_t WS_COS = 1 * MiB, WS_SIN = 3 * MiB, WS_SSQ0 = 5 * MiB, WS_SSQM = 5 * MiB + 256 * 1024, WS_SSQ1 = 256 * 1024, WS_SSQ2 = 512 * 1024  , WS_SSQSB = 14 * MiB;
constexpr size_t WS_MB = 22 * MiB, WS_CQ = 26 * MiB, WS_CKV = 58 * MiB, WS_CO = 60 * MiB;
constexpr size_t WS_WQKV = 76 * MiB, WS_WO = 88 * MiB, WS_WUP = 92 * MiB, WS_WDOWN = 264 * MiB, WS_HB = 350 * MiB;
constexpr size_t WS_WIN = 478 * MiB, WS_WOUT = 590 * MiB, WS_PROJ = 622 * MiB, WS_KV = 1070 * MiB, WS_ST = 1198 * MiB, WS_END = 1262 * MiB;
constexpr size_t WS_U = 478 * MiB, WS_ACT = 822 * MiB;
static_assert(WS_U + (size_t)SEQ * DFF2 * 2 <= WS_ACT && WS_ACT + (size_t)M * DFF * 2 <= WS_END, "ffn overlays");
static_assert(WS_PROJ + (size_t)M * INW * 2 <= WS_KV && WS_KV + (size_t)2048 * 16384 * 4 <= WS_ST && WS_ST + (size_t)2048 * 16384 * 2 <= WS_END, "mixer map");
static_assert(WS_WIN + (size_t)INW * DM * 2 <= WS_WOUT && WS_WOUT + (size_t)DM * DM * 2 <= WS_PROJ && WS_WUP + (size_t)DFF2 * DM * 2 <= WS_WDOWN && WS_WDOWN + (size_t)DM * DFF * 2 <= WS_HB && WS_HB + (size_t)M * DM * 2 <= WS_WIN, "weights map");
constexpr int CW_BAR = 4096;
constexpr int RING_BYTES = 131072, LDSCTL_OFF = RING_BYTES, MISC_OFF = LDSCTL_OFF + 320, LDS_BYTES = 147456;
constexpr int L_KT = 0, L_VT = 40960, L_RK = 81920, L_FL = 82944, L_RED = 83200;
constexpr int KSTR = 272, VSTR = 320;

#define GAS __attribute__((address_space(1)))
#define LAS __attribute__((address_space(3)))
#define DI __device__ __forceinline__
typedef unsigned short bf16;
typedef unsigned v4u __attribute__((ext_vector_type(4)));
typedef unsigned v2u __attribute__((ext_vector_type(2)));
typedef float f32x4 __attribute__((ext_vector_type(4)));
typedef float f32x16 __attribute__((ext_vector_type(16)));
typedef short bf16x8 __attribute__((ext_vector_type(8)));
typedef short s16x4 __attribute__((ext_vector_type(4)));
typedef GAS unsigned gu32;
#define RLX_AGENT __ATOMIC_RELAXED, __HIP_MEMORY_SCOPE_AGENT
#define LDS_WAIT() asm volatile("s_waitcnt lgkmcnt(0)" ::: "memory")
using pg8::pk_bf16; using pg8::EPSN; using pg8::LOGG; using pg8::hsum4;
#define MFMA32(a, b, c) __builtin_amdgcn_mfma_f32_32x32x16_bf16((a), (b), (c), 0, 0, 0)
DI int crow(int i, int h) { return (i & 3) + 8 * (i >> 2) + 4 * h; }
DI bf16x8 pack8(float a0, float a1, float a2, float a3, float a4, float a5, float a6, float a7) { v4u p; p.x = pk_bf16(a0, a1); p.y = pk_bf16(a2, a3); p.z = pk_bf16(a4, a5); p.w = pk_bf16(a6, a7); return __builtin_bit_cast(bf16x8, p); }
DI float bf2f(unsigned short b) { return __builtin_bit_cast(float, (unsigned)b << 16); }
DI float wave_sum(float v) {
#pragma unroll
    for (int o = 1; o < 64; o <<= 1) v += __shfl_xor(v, o);
    return v;
}
__constant__ float INVF[64] = { 1.000000000e+00f, 8.639884591e-01f, 7.464760542e-01f, 6.449466348e-01f, 5.572264791e-01f, 4.814372361e-01f, 4.159561992e-01f, 3.593813479e-01f, 3.105013072e-01f, 2.682695389e-01f, 2.317818105e-01f, 2.002568096e-01f, 1.730195731e-01f, 1.494868994e-01f, 1.291549653e-01f, 1.115883961e-01f,
    9.641107172e-02f, 8.329805732e-02f, 7.196855545e-02f, 6.218000501e-02f, 5.372280627e-02f, 4.641588405e-02f, 4.010278732e-02f, 3.464834765e-02f, 2.993577160e-02f, 2.586415969e-02f, 2.234633639e-02f, 1.930697635e-02f, 1.668100432e-02f, 1.441219542e-02f, 1.245197095e-02f, 1.075835899e-02f,
    9.295094758e-03f, 8.030855097e-03f, 6.938565988e-03f, 5.994841456e-03f, 5.179473665e-03f, 4.475004971e-03f, 3.866352839e-03f, 3.340484342e-03f, 2.886140021e-03f, 2.493591513e-03f, 2.154434333e-03f, 1.861406374e-03f, 1.608233550e-03f, 1.389495214e-03f, 1.200507861e-03f, 1.037224894e-03f,
    8.961503627e-04f, 7.742635789e-04f, 6.689548027e-04f, 5.779691855e-04f, 4.993587499e-04f, 4.314401885e-04f, 3.727593576e-04f, 3.220597864e-04f, 2.782559022e-04f, 2.404099068e-04f, 2.077113895e-04f, 1.794602285e-04f, 1.550515735e-04f, 1.339627779e-04f, 1.157422885e-04f, 9.999999747e-05f };
DI void transpose_item(const float* W, int N, const float* gain, bf16* WT, int Kd, int dst_row0, int src_col0, int k0, LAS float* scr, int lane) {
#pragma unroll 8
    for (int i = 0; i < 32; ++i) { const int kk = 2 * i + (lane >> 5); const float g = gain ? gain[k0 + kk] : 1.0f; scr[kk * 33 + (lane & 31)] = W[(size_t)(k0 + kk) * N + src_col0 + (lane & 31)] * g; }
    LDS_WAIT(); asm volatile("" ::: "memory");
    const int c = lane & 7;
#pragma unroll
    for (int j = 0; j < 4; ++j) { const int n = (lane >> 3) + 8 * j; const LAS float* s = scr + (8 * c) * 33 + n;
        v4u o; o.x = pk_bf16(s[0 * 33], s[1 * 33]); o.y = pk_bf16(s[2 * 33], s[3 * 33]); o.z = pk_bf16(s[4 * 33], s[5 * 33]); o.w = pk_bf16(s[6 * 33], s[7 * 33]);
        *(GAS v4u*)(WT + (size_t)(dst_row0 + n) * Kd + k0 + 8 * c) = o; }
    LDS_WAIT(); asm volatile("" ::: "memory");
}
DI void row_to_bf16(const float* xrow, bf16* orow, float* ssq, int lane) {
    const GAS f32x4* xr = (const GAS f32x4*)xrow + lane; GAS v2u* o8 = (GAS v2u*)orow + lane; float s = 0.f;
#pragma unroll
    for (int j = 0; j < 16; ++j) { const f32x4 v = xr[64 * j]; s += (v.x * v.x + v.y * v.y) + (v.z * v.z + v.w * v.w); v2u w; w.x = pk_bf16(v.x, v.y); w.y = pk_bf16(v.z, v.w); o8[64 * j] = w; }
    s = wave_sum(s); if (lane == 0) *ssq = s;
}
struct Ptrs {
    const float *x, *mem, *attn_norm, *w_in, *ret_norm, *sbq_norm, *sbk_norm, *sbo_norm, *w_out, *cross_norm, *mem_norm, *wq, *wkv, *cq_norm, *ck_norm, *wo, *ffn_norm, *w_up, *conv_w, *conv_b, *w_down;
    float* out; unsigned char* ws;
};
DI void p0_prologue(const Ptrs& P, LAS unsigned char* lds, int gw, int NGW, int wave, int lane) {
    unsigned char* ws = P.ws;
    LAS float* scr = (LAS float*)(lds + wave * 16384);
    constexpr int KB = DM / 64;
    constexpr int I_IN = KB * (INW / 32), I_OUT = KB * (DM / 32), I_Q = KB * (CW / 32), I_KV = KB * (2 * CW / 32), I_O = (CW / 64) * (DM / 32), I_UP = KB * (DFF2 / 32), I_DN = (DFF / 64) * (DM / 32);
    constexpr int NITEMS = I_IN + I_OUT + I_Q + I_KV + I_O + I_UP + I_DN;
    for (int it = gw; it < NITEMS; it += NGW) {
        int r = it;
        if (r < I_IN) { const int nb = r % (INW / 32), kb = r / (INW / 32), n0 = 32 * nb, reg = n0 >> 11;
            const int src = (reg == 0 ? 0 : reg == 1 ? 8192 : reg == 2 ? 2048 : reg == 3 ? 4096 : reg == 4 ? 6144 : reg == 5 ? 10240 : 12288) + (n0 & 2047);
            transpose_item(P.w_in, INW, P.attn_norm, (bf16*)(ws + WS_WIN), DM, n0, src, 64 * kb, scr, lane); continue; } r -= I_IN;
        if (r < I_OUT) { const int nb = r % (DM / 32), kb = r / (DM / 32); transpose_item(P.w_out, DM, nullptr, (bf16*)(ws + WS_WOUT), DM, 32 * nb, 32 * nb, 64 * kb, scr, lane); continue; } r -= I_OUT;
        if (r < I_Q) { const int nb = r % (CW / 32), kb = r / (CW / 32); transpose_item(P.wq, CW, P.cross_norm, (bf16*)(ws + WS_WQKV), DM, 32 * nb, 32 * nb, 64 * kb, scr, lane); continue; } r -= I_Q;
        if (r < I_KV) { const int nb = r % (2 * CW / 32), kb = r / (2 * CW / 32); transpose_item(P.wkv, 2 * CW, P.mem_norm, (bf16*)(ws + WS_WQKV), DM, CW + 32 * nb, 32 * nb, 64 * kb, scr, lane); continue; } r -= I_KV;
        if (r < I_O) { const int nb = r % (DM / 32), kb = r / (DM / 32); transpose_item(P.wo, DM, nullptr, (bf16*)(ws + WS_WO), CW, 32 * nb, 32 * nb, 64 * kb, scr, lane); continue; } r -= I_O;
        if (r < I_UP) { const int nb = r % (DFF2 / 32), kb = r / (DFF2 / 32); transpose_item(P.w_up, DFF2, P.ffn_norm, (bf16*)(ws + WS_WUP), DM, 32 * nb, 32 * nb, 64 * kb, scr, lane); continue; } r -= I_UP;
        { const int nb = r % (DM / 32), kb = r / (DM / 32); transpose_item(P.w_down, DM, nullptr, (bf16*)(ws + WS_WDOWN), DFF, 32 * nb, 32 * nb, 64 * kb, scr, lane); }
    }
    for (int m = gw; m < M; m += NGW) row_to_bf16(P.x + (size_t)m * DM, (bf16*)(ws + WS_HB) + (size_t)m * DM, (float*)(ws + WS_SSQ0) + m, lane);
    for (int m = gw; m < BATCH * NMEM; m += NGW) row_to_bf16(P.mem + (size_t)m * DM, (bf16*)(ws + WS_MB) + (size_t)m * DM, (float*)(ws + WS_SSQM) + m, lane);
    for (int idx = gw * 64 + lane; idx < SEQ * 64; idx += NGW * 64) {
        const int t = idx >> 6, i = idx & 63; const float angf = (float)t * INVF[i]; const double ang = (double)angf;
        const double kq = __builtin_rint(ang * 0.15915494309189535); const double rr = __builtin_fma(-kq, 6.283185307179586, ang) - kq * 2.4492935982947064e-16;
        const double r2 = rr * rr; double sn = 0.0, cs = 0.0;
#pragma unroll
        for (int k = 13; k >= 0; --k) { cs = cs * (-r2 / (double)((2 * k + 1) * (2 * k + 2))) + 1.0; sn = sn * (-r2 / (double)((2 * k + 2) * (2 * k + 3))) + 1.0; }
        ((float*)(ws + WS_COS))[idx] = (float)cs; ((float*)(ws + WS_SIN))[idx] = (float)(sn * rr);
    }
}
DI void stage_tile(LAS unsigned char* dst, int stride, const bf16* src, size_t ld, int rows, int tid) {
    for (int ch = tid; ch < rows * 16; ch += NWAVES * 64) { const int r = ch >> 4, c = ch & 15; const v4u v = *(const GAS v4u*)(src + (size_t)r * ld + c * 8); *(LAS v4u*)(dst + r * stride + c * 16) = v; }
}
DI bf16x8 tr_frag(LAS unsigned char* tile, int stride, int row0, int col0, int lane) {
    const int g = lane >> 4, i16 = lane & 15, q = i16 >> 2, p = i16 & 3, h = lane >> 5;
    LAS unsigned char* a = tile + (row0 + 4 * h + q) * stride + (col0 + 16 * (g & 1) + 4 * p) * 2;
    const s16x4 lo = __builtin_amdgcn_ds_read_tr16_b64_v4i16((LAS s16x4*)a);
    const s16x4 hi = __builtin_amdgcn_ds_read_tr16_b64_v4i16((LAS s16x4*)(a + 8 * stride));
    return __builtin_shufflevector(lo, hi, 0, 1, 2, 3, 4, 5, 6, 7);
}
DI f32x16 st_tile(LAS unsigned char* KT, int krow0, const bf16x8 (&qf)[8], int r, int h) {
    f32x16 acc;
#pragma unroll
    for (int i = 0; i < 16; ++i) acc[i] = 0.f;
#pragma unroll
    for (int ks = 0; ks < 8; ++ks) { const bf16x8 a = *(const LAS bf16x8*)(KT + (krow0 + r) * KSTR + (16 * ks + 8 * h) * 2); acc = MFMA32(a, qf[ks], acc); }
    return acc;
}
DI void load_qf(bf16x8 (&qf)[8], const bf16* qrowp, int h) {
#pragma unroll
    for (int ks = 0; ks < 8; ++ks) qf[ks] = *(const GAS bf16x8*)(qrowp + 16 * ks + 8 * h);
}

DI void ret_kv_unit(LAS unsigned char* lds, const bf16* PROJ, float* KVB, int unit, int tid) {
    const int lane = tid & 63, w = __builtin_amdgcn_readfirstlane(tid >> 6), r = lane & 31, h = lane >> 5;
    const int n = unit & 63, hd = (unit >> 6) & 15, b = unit >> 10;
    LAS unsigned char* KT = lds + L_KT; LAS unsigned char* VT = lds + L_VT;
    const size_t m0 = (size_t)b * SEQ + 128 * n;
    __syncthreads();
    stage_tile(KT, VSTR, PROJ + m0 * INW + C_RK + 128 * hd, INW, 128, tid);
    stage_tile(VT, VSTR, PROJ + m0 * INW + C_RV + 128 * hd, INW, 128, tid);
    __syncthreads();
    const int te = w >> 1, td0 = 2 * (w & 1);
    f32x16 acc[2];
#pragma unroll
    for (int t = 0; t < 2; ++t)
#pragma unroll
        for (int i = 0; i < 16; ++i) acc[t][i] = 0.f;
#pragma unroll
    for (int ks = 0; ks < 8; ++ks) {
        const bf16x8 a = tr_frag(VT, VSTR, 16 * ks, 32 * te, lane);
#pragma unroll
        for (int t = 0; t < 2; ++t) { const bf16x8 bb = tr_frag(KT, VSTR, 16 * ks, 32 * (td0 + t), lane); acc[t] = MFMA32(a, bb, acc[t]); }
    }
    const float sc = __expf(127.0f * LOGG[hd]);
    float* o = KVB + (size_t)unit * 16384;
#pragma unroll
    for (int t = 0; t < 2; ++t)
#pragma unroll
        for (int i = 0; i < 16; ++i) o[(32 * te + crow(i, h)) * 128 + 32 * (td0 + t) + r] = acc[t][i] * sc;
}
DI void ret_scan(const float* KVB, bf16* ST, int gt, int NT) {
    for (int idx = gt; idx < 32 * 4096; idx += NT) {
        const int bh = idx >> 12, e4 = idx & 4095; const float dec = __expf(128.0f * LOGG[bh & 15]);
        f32x4 S = {0.f, 0.f, 0.f, 0.f};
        for (int n = 0; n < 64; ++n) {
            const size_t off = ((size_t)(bh * 64 + n) * 4096 + e4) * 4;
            v2u w; w.x = pk_bf16(S[0], S[1]); w.y = pk_bf16(S[2], S[3]); *(GAS v2u*)(ST + off) = w;
            const f32x4 kv = *(const GAS f32x4*)(KVB + off); S = S * dec + kv;
        }
    }
}
DI void ret_out_unit(LAS unsigned char* lds, bf16* PROJ, const bf16* ST, const float* gret, int unit, int tid) {
    const int lane = tid & 63, w = __builtin_amdgcn_readfirstlane(tid >> 6), r = lane & 31, h = lane >> 5, qg = w & 3, eh = w >> 2;
    const int n = unit & 63, hd = (unit >> 6) & 15, b = unit >> 10;
    LAS unsigned char* KT = lds + L_KT; LAS unsigned char* VT = lds + L_VT; LAS float* RED = (LAS float*)(lds + L_RED);
    const size_t m0 = (size_t)b * SEQ + 128 * n, qrow = m0 + 32 * qg + r;
    __syncthreads();
    stage_tile(KT, KSTR, PROJ + m0 * INW + C_RK + 128 * hd, INW, 128, tid);
    stage_tile(VT, VSTR, PROJ + m0 * INW + C_RV + 128 * hd, INW, 128, tid);
    bf16x8 qf[8]; load_qf(qf, PROJ + qrow * INW + C_RQ + 128 * hd, h);
    const bf16* st = ST + (size_t)unit * 16384;
    f32x16 O[2];
#pragma unroll
    for (int et = 0; et < 2; ++et) {
#pragma unroll
        for (int i = 0; i < 16; ++i) O[et][i] = 0.f;
#pragma unroll
        for (int ks = 0; ks < 8; ++ks) { const bf16x8 a = *(const GAS bf16x8*)(st + (32 * (2 * eh + et) + r) * 128 + 16 * ks + 8 * h); O[et] = MFMA32(a, qf[ks], O[et]); }
    }
    const float g1 = __expf(LOGG[hd]);
#pragma unroll
    for (int et = 0; et < 2; ++et) O[et] = O[et] * g1;
    __syncthreads();
    for (int kt = 0; kt <= qg; ++kt) {
        f32x16 s = st_tile(KT, 32 * kt, qf, r, h);
        if (kt == qg) {
#pragma unroll
            for (int i = 0; i < 16; ++i) s[i] = (crow(i, h) <= r) ? s[i] : 0.f;
        }
        bf16x8 pb[2];
#pragma unroll
        for (int s2 = 0; s2 < 2; ++s2) pb[s2] = pack8(s[8 * s2], s[8 * s2 + 1], s[8 * s2 + 2], s[8 * s2 + 3], s[8 * s2 + 4], s[8 * s2 + 5], s[8 * s2 + 6], s[8 * s2 + 7]);
#pragma unroll
        for (int et = 0; et < 2; ++et)
#pragma unroll
            for (int s2 = 0; s2 < 2; ++s2) O[et] = MFMA32(tr_frag(VT, VSTR, 32 * kt + 16 * s2, 32 * (2 * eh + et), lane), pb[s2], O[et]);
    }
    float ss = 0.f;
#pragma unroll
    for (int et = 0; et < 2; ++et)
#pragma unroll
        for (int i = 0; i < 16; ++i) ss += O[et][i] * O[et][i];
    ss += __shfl_xor(ss, 32);
    if (h == 0) RED[w * 32 + r] = ss;
    __syncthreads();
    const float rstd = rsqrtf((RED[w * 32 + r] + RED[(w ^ 4) * 32 + r]) * (1.0f / 128.0f) + EPSN);
    bf16* orow = PROJ + qrow * INW + 128 * hd;
#pragma unroll
    for (int et = 0; et < 2; ++et)
#pragma unroll
        for (int G = 0; G < 4; ++G) {
            const int e = 32 * (2 * eh + et) + 8 * G + 4 * h;
            const f32x4 g = *(const f32x4*)(gret + e); const v2u gt = *(const GAS v2u*)(orow + C_RG + e);
            const float o0 = O[et][4 * G + 0] * rstd * g[0] * bf2f((unsigned short)(gt.x & 0xffff)), o1 = O[et][4 * G + 1] * rstd * g[1] * bf2f((unsigned short)(gt.x >> 16));
            const float o2 = O[et][4 * G + 2] * rstd * g[2] * bf2f((unsigned short)(gt.y & 0xffff)), o3 = O[et][4 * G + 3] * rstd * g[3] * bf2f((unsigned short)(gt.y >> 16));
            v2u wv; wv.x = pk_bf16(o0, o1); wv.y = pk_bf16(o2, o3); *(GAS v2u*)(orow + C_RQ + e) = wv;
        }
}
DI void sb_unit(LAS unsigned char* lds, bf16* PROJ, const float* ssqsb, const float* gout, int unit, int tid) {
    const int lane = tid & 63, w = __builtin_amdgcn_readfirstlane(tid >> 6), r = lane & 31, h = lane >> 5;
    const int qb = unit & 31, hd = (unit >> 5) & 15, b = unit >> 9;
    LAS unsigned char* KT = lds + L_KT; LAS unsigned char* VT = lds + L_VT; LAS float* RK = (LAS float*)(lds + L_RK); LAS unsigned* FL = (LAS unsigned*)(lds + L_FL);
    const size_t m0 = (size_t)b * SEQ + 256 * qb, qrow = m0 + 32 * w + r;
    const int qlo = 256 * qb + 32 * w, qhi = qlo + 31, tq = qlo + r;
    bf16x8 qf[8]; load_qf(qf, PROJ + qrow * INW + C_SQ + 128 * hd, h);
    const f32x4 pq = *(const GAS f32x4*)(ssqsb + (qrow * 32 + hd) * 4);
    const float qscale = rsqrtf(hsum4(pq) * (1.0f / 128.0f) + EPSN) * 0.08838834764831845f;
    f32x16 O[4];
#pragma unroll
    for (int dt = 0; dt < 4; ++dt)
#pragma unroll
        for (int i = 0; i < 16; ++i) O[dt][i] = 0.f;
    float R = 0.f;
    for (int kb = 2 * qb + 1; kb >= 0; --kb) {
        __syncthreads();
        if (kb != 2 * qb + 1) { const unsigned all = FL[0] & FL[1] & FL[2] & FL[3] & FL[4] & FL[5] & FL[6] & FL[7]; if (all) break; }
        const size_t k0row = (size_t)b * SEQ + 128 * kb;
        stage_tile(KT, KSTR, PROJ + k0row * INW + C_SK + 128 * hd, INW, 128, tid);
        stage_tile(VT, VSTR, PROJ + k0row * INW + C_SV + 128 * hd, INW, 128, tid);
        if (tid < 128) { const f32x4 pk = *(const GAS f32x4*)(ssqsb + ((k0row + tid) * 32 + 16 + hd) * 4); RK[tid] = rsqrtf(hsum4(pk) * (1.0f / 128.0f) + EPSN); }
        __syncthreads();
        const int k0b = 128 * kb;
        if (k0b < qhi) {
            for (int st = 3; st >= 0; --st) {
                const int k0 = k0b + 32 * st;
                if (k0 >= qhi) continue;
                const f32x16 s = st_tile(KT, 32 * st, qf, r, h);
                const bool need_mask = (k0 + 31 >= qlo);
                float a[16];
#pragma unroll
                for (int G = 3; G >= 0; --G) {
                    const f32x4 rk = *(const LAS f32x4*)(RK + 32 * st + 8 * G + 4 * h);
                    float z[4], sp[4]; bool ok[4];
#pragma unroll
                    for (int j = 0; j < 4; ++j) {
                        z[j] = s[4 * G + j] * qscale * rk[j];
                        ok[j] = !need_mask || (k0 + 8 * G + 4 * h + j < tq);
                        const float spv = fmaxf(z[j], 0.f) + __logf(1.0f + __expf(-fabsf(z[j])));
                        sp[j] = ok[j] ? spv : 0.f;
                    }
                    const float l3 = sp[3], l2 = sp[2] + l3, l1 = sp[1] + l2, l0 = sp[0] + l1;
                    const float To = __shfl_xor(l0, 32);
                    const float off = h ? R : R + To;
                    a[4 * G + 0] = ok[0] ? __expf(z[0] - (off + l0)) : 0.f; a[4 * G + 1] = ok[1] ? __expf(z[1] - (off + l1)) : 0.f;
                    a[4 * G + 2] = ok[2] ? __expf(z[2] - (off + l2)) : 0.f; a[4 * G + 3] = ok[3] ? __expf(z[3] - (off + l3)) : 0.f;
                    R = R + (l0 + To);
                }
                bf16x8 pb[2];
#pragma unroll
                for (int s2 = 0; s2 < 2; ++s2) pb[s2] = pack8(a[8 * s2], a[8 * s2 + 1], a[8 * s2 + 2], a[8 * s2 + 3], a[8 * s2 + 4], a[8 * s2 + 5], a[8 * s2 + 6], a[8 * s2 + 7]);
#pragma unroll
                for (int dt = 0; dt < 4; ++dt)
#pragma unroll
                    for (int s2 = 0; s2 < 2; ++s2) O[dt] = MFMA32(tr_frag(VT, VSTR, 32 * st + 16 * s2, 32 * dt, lane), pb[s2], O[dt]);
            }
        }
        const bool done = __all(R > SB_EXIT);
        if (lane == 0) FL[w] = done ? 1u : 0u;
    }
    float ss = 0.f;
#pragma unroll
    for (int dt = 0; dt < 4; ++dt)
#pragma unroll
        for (int i = 0; i < 16; ++i) ss += O[dt][i] * O[dt][i];
    ss += __shfl_xor(ss, 32);
    const float rstd = rsqrtf(ss * (1.0f / 128.0f) + EPSN);
    bf16* orow = PROJ + qrow * INW + C_SQ + 128 * hd;
#pragma unroll
    for (int dt = 0; dt < 4; ++dt)
#pragma unroll
        for (int G = 0; G < 4; ++G) {
            const int d = 32 * dt + 8 * G + 4 * h; const f32x4 g = *(const f32x4*)(gout + d);
            v2u wv; wv.x = pk_bf16(O[dt][4 * G] * rstd * g[0], O[dt][4 * G + 1] * rstd * g[1]); wv.y = pk_bf16(O[dt][4 * G + 2] * rstd * g[2], O[dt][4 * G + 3] * rstd * g[3]);
            *(GAS v2u*)(orow + d) = wv;
        }
}
DI void cross_stage(LAS unsigned char* lds, const float* CKV, const float* gk, LAS float* RKc, int b, int ch, int kh, bool withV, int tid) {
    for (int chn = tid; chn < 128 * 16; chn += NWAVES * 64) {
        const int rr = chn >> 4, c = chn & 15; const float* src = CKV + (size_t)(b * NMEM + 128 * kh + rr) * (2 * CW) + 128 * ch + 8 * c;
        const f32x4 a0 = *(const GAS f32x4*)src, a1 = *(const GAS f32x4*)(src + 4); const f32x4 g0 = *(const f32x4*)(gk + 8 * c), g1 = *(const f32x4*)(gk + 8 * c + 4); const float rs = RKc[128 * kh + rr];
        v4u o; o.x = pk_bf16(a0[0] * rs * g0[0], a0[1] * rs * g0[1]); o.y = pk_bf16(a0[2] * rs * g0[2], a0[3] * rs * g0[3]); o.z = pk_bf16(a1[0] * rs * g1[0], a1[1] * rs * g1[1]); o.w = pk_bf16(a1[2] * rs * g1[2], a1[3] * rs * g1[3]);
        *(LAS v4u*)(lds + L_KT + rr * KSTR + c * 16) = o;
        if (withV) { const f32x4 v0 = *(const GAS f32x4*)(src + CW), v1 = *(const GAS f32x4*)(src + CW + 4);
            v4u ov; ov.x = pk_bf16(v0[0], v0[1]); ov.y = pk_bf16(v0[2], v0[3]); ov.z = pk_bf16(v1[0], v1[1]); ov.w = pk_bf16(v1[2], v1[3]);
            *(LAS v4u*)(lds + L_VT + rr * VSTR + c * 16) = ov; }
    }
}
DI void cross_unit(LAS unsigned char* lds, const float* CQ, const float* CKV, const float* gq, const float* gk, bf16* CO, int unit, int tid) {
    const int lane = tid & 63, w = __builtin_amdgcn_readfirstlane(tid >> 6), r = lane & 31, h = lane >> 5;
    const int qb = unit & 31, ch = (unit >> 5) & 3, b = unit >> 7;
    LAS unsigned char* KT = lds + L_KT; LAS unsigned char* VT = lds + L_VT; LAS float* RKc = (LAS float*)(lds + L_RK);
    const size_t qrow = (size_t)b * SEQ + 256 * qb + 32 * w + r;
    __syncthreads();
    {
        const int key = tid >> 1, half = tid & 1; const float* src = CKV + (size_t)(b * NMEM + key) * (2 * CW) + 128 * ch + 64 * half; float s = 0.f;
#pragma unroll
        for (int j = 0; j < 16; ++j) { const f32x4 v = *(const GAS f32x4*)(src + 4 * j); s += (v.x * v.x + v.y * v.y) + (v.z * v.z + v.w * v.w); }
        s += __shfl_xor(s, 1);
        if (half == 0) RKc[key] = rsqrtf(s * (1.0f / 128.0f) + EPSN);
    }
    bf16x8 qf[8];
    {
        const float* qp = CQ + qrow * CW + 128 * ch; f32x4 qv[8][2]; float s = 0.f;
#pragma unroll
        for (int ks = 0; ks < 8; ++ks) { qv[ks][0] = *(const GAS f32x4*)(qp + 16 * ks + 8 * h); qv[ks][1] = *(const GAS f32x4*)(qp + 16 * ks + 8 * h + 4);
            s += (qv[ks][0].x * qv[ks][0].x + qv[ks][0].y * qv[ks][0].y) + (qv[ks][0].z * qv[ks][0].z + qv[ks][0].w * qv[ks][0].w) + (qv[ks][1].x * qv[ks][1].x + qv[ks][1].y * qv[ks][1].y) + (qv[ks][1].z * qv[ks][1].z + qv[ks][1].w * qv[ks][1].w); }
        s += __shfl_xor(s, 32);
        const float rs = rsqrtf(s * (1.0f / 128.0f) + EPSN) * 0.08838834764831845f;
#pragma unroll
        for (int ks = 0; ks < 8; ++ks) { const f32x4 g0 = *(const f32x4*)(gq + 16 * ks + 8 * h), g1 = *(const f32x4*)(gq + 16 * ks + 8 * h + 4); const f32x4 a0 = qv[ks][0] * g0 * rs, a1 = qv[ks][1] * g1 * rs;
            qf[ks] = pack8(a0[0], a0[1], a0[2], a0[3], a1[0], a1[1], a1[2], a1[3]); }
    }
    __syncthreads();
    float mx = -3.0e38f;
    for (int kh = 0; kh < 2; ++kh) {
        if (kh) __syncthreads();
        cross_stage(lds, CKV, gk, RKc, b, ch, kh, false, tid);
        __syncthreads();
#pragma unroll 1
        for (int st = 0; st < 4; ++st) { const f32x16 s = st_tile(KT, 32 * st, qf, r, h);
#pragma unroll
            for (int i = 0; i < 16; ++i) mx = fmaxf(mx, s[i]); }
    }
    mx = fmaxf(mx, __shfl_xor(mx, 32));
    f32x16 O[4]; float lsum = 0.f;
#pragma unroll
    for (int dt = 0; dt < 4; ++dt)
#pragma unroll
        for (int i = 0; i < 16; ++i) O[dt][i] = 0.f;
    for (int kh = 0; kh < 2; ++kh) {
        __syncthreads();
        cross_stage(lds, CKV, gk, RKc, b, ch, kh, true, tid);
        __syncthreads();
#pragma unroll 1
        for (int st = 0; st < 4; ++st) {
            const f32x16 s = st_tile(KT, 32 * st, qf, r, h); float p[16];
#pragma unroll
            for (int i = 0; i < 16; ++i) { p[i] = __expf(s[i] - mx); lsum += p[i]; }
            bf16x8 pb[2];
#pragma unroll
            for (int s2 = 0; s2 < 2; ++s2) pb[s2] = pack8(p[8 * s2], p[8 * s2 + 1], p[8 * s2 + 2], p[8 * s2 + 3], p[8 * s2 + 4], p[8 * s2 + 5], p[8 * s2 + 6], p[8 * s2 + 7]);
#pragma unroll
            for (int dt = 0; dt < 4; ++dt)
#pragma unroll
                for (int s2 = 0; s2 < 2; ++s2) O[dt] = MFMA32(tr_frag(VT, VSTR, 32 * st + 16 * s2, 32 * dt, lane), pb[s2], O[dt]);
        }
    }
    lsum += __shfl_xor(lsum, 32);
    const float inv = 1.0f / lsum;
    bf16* orow = CO + qrow * CW + 128 * ch;
#pragma unroll
    for (int dt = 0; dt < 4; ++dt)
#pragma unroll
        for (int G = 0; G < 4; ++G) { const int d = 32 * dt + 8 * G + 4 * h;
            v2u wv; wv.x = pk_bf16(O[dt][4 * G] * inv, O[dt][4 * G + 1] * inv); wv.y = pk_bf16(O[dt][4 * G + 2] * inv, O[dt][4 * G + 3] * inv); *(GAS v2u*)(orow + d) = wv; }
}
DI void ffn_act(const bf16* U, bf16* ACT, const float* cw, const float* cb, int half, int gt, int NT) {
    constexpr int NC = DFF / 8, RB = 16, NRB = SEQ / RB;
    for (int it = gt; it < NRB * NC; it += NT) {
        const int cc = it % NC, rb = it / NC, n0 = 8 * cc, t0 = rb * RB;
        float wg[3][8], wv[3][8], bg[8], bv[8];
#pragma unroll
        for (int j = 0; j < 3; ++j)
#pragma unroll
            for (int e = 0; e < 8; ++e) { wg[j][e] = cw[(size_t)j * DFF2 + n0 + e]; wv[j][e] = cw[(size_t)j * DFF2 + DFF + n0 + e]; }
#pragma unroll
        for (int e = 0; e < 8; ++e) { bg[e] = cb[n0 + e]; bv[e] = cb[DFF + n0 + e]; }
        float g1[8], g2[8], v1[8], v2[8];
#pragma unroll
        for (int e = 0; e < 8; ++e) { g1[e] = g2[e] = v1[e] = v2[e] = 0.f; }
        for (int tt = -2; tt < RB; ++tt) {
            const int t = t0 + tt; float gc[8], vc[8];
            if (t >= 0) { const v4u a = *(const GAS v4u*)(U + (size_t)t * DFF2 + n0), bq = *(const GAS v4u*)(U + (size_t)t * DFF2 + DFF + n0);
                const unsigned aw[4] = {a.x, a.y, a.z, a.w}, bw[4] = {bq.x, bq.y, bq.z, bq.w};
#pragma unroll
                for (int e = 0; e < 4; ++e) { gc[2 * e] = bf2f((unsigned short)(aw[e] & 0xffff)); gc[2 * e + 1] = bf2f((unsigned short)(aw[e] >> 16)); vc[2 * e] = bf2f((unsigned short)(bw[e] & 0xffff)); vc[2 * e + 1] = bf2f((unsigned short)(bw[e] >> 16)); }
            } else {
#pragma unroll
                for (int e = 0; e < 8; ++e) { gc[e] = 0.f; vc[e] = 0.f; } }
            if (tt >= 0) {
                float o[8];
#pragma unroll
                for (int e = 0; e < 8; ++e) { const float cg = bg[e] + wg[0][e] * g2[e] + wg[1][e] * g1[e] + wg[2][e] * gc[e], cv = bv[e] + wv[0][e] * v2[e] + wv[1][e] * v1[e] + wv[2][e] * vc[e];
                    o[e] = cg * __builtin_amdgcn_rcpf(1.0f + __expf(-cg)) * cv; }
                v4u ov; ov.x = pk_bf16(o[0], o[1]); ov.y = pk_bf16(o[2], o[3]); ov.z = pk_bf16(o[4], o[5]); ov.w = pk_bf16(o[6], o[7]);
                *(GAS v4u*)(ACT + ((size_t)half * SEQ + t) * DFF + n0) = ov;
            }
#pragma unroll
            for (int e = 0; e < 8; ++e) { g2[e] = g1[e]; g1[e] = gc[e]; v2[e] = v1[e]; v1[e] = vc[e]; }
        }
    }
}
struct Args { Ptrs p; int ph_lo, ph_hi; };
constexpr int N_PHASES = 14;
__global__ void __launch_bounds__(NWAVES * 64, 2) mk_fwd(Args args) {
    extern __shared__ __attribute__((aligned(16))) unsigned char lds_raw[];
    LAS unsigned char* lds = (LAS unsigned char*)lds_raw;
    volatile LAS unsigned* MISC = (volatile LAS unsigned*)(lds + MISC_OFF);
    const int tid = threadIdx.x, lane = tid & 63, wave = __builtin_amdgcn_readfirstlane(tid >> 6);
    const int G = gridDim.x, bx = blockIdx.x;
    const Ptrs& P = args.p; unsigned char* ws = P.ws;
    gu32* ctl = (gu32*)(ws + WS_CTL);
    for (int u = tid; u < (LDS_BYTES - LDSCTL_OFF) / 4; u += NWAVES * 64) ((LAS unsigned*)(lds + LDSCTL_OFF))[u] = 0u;
    __syncthreads();
    XcdBarrier bar = xcd_barrier_post((unsigned*)(ctl + CW_BAR), MISC + 8);
    const int lo = args.ph_lo, hi = args.ph_hi;
#ifndef PHMASK
#define PHMASK 0xffff
#endif
#define IN(k) (((PHMASK >> (k)) & 1) && lo <= (k) && (k) < hi)
#define SEAM(k) do { if (IN(k) && IN((k) + 1)) xcd_barrier(bar); } while (0)
    bf16* HB = (bf16*)(ws + WS_HB); bf16* PROJ = (bf16*)(ws + WS_PROJ);
    const int gw = bx * NWAVES + wave, NGW = G * NWAVES, gt = bx * NWAVES * 64 + tid, NT = G * NWAVES * 64;

    if (IN(0)) { p0_prologue(P, lds, gw, NGW, wave, lane); }
    SEAM(0);
    if (IN(1)) {
        pg8::Gemm g{HB, (const bf16*)(ws + WS_WIN), M, INW, DM, DM}; pg8::StaticOrder S; S.init(M, INW, G, bx);
        pg8::EpiProj E{PROJ, (const float*)(ws + WS_SSQ0), (const float*)(ws + WS_COS), (const float*)(ws + WS_SIN), P.sbq_norm, P.sbk_norm, (float*)(ws + WS_SSQSB)};
        pg8::gemm_phase<pg8::EpiProj, pg8::StaticOrder, true, true>(lds, g, S, E);
    }
    SEAM(1);
    if (IN(2)) { for (int u = bx; u < 2048; u += G) ret_kv_unit(lds, PROJ, (float*)(ws + WS_KV), u, tid); }
    SEAM(2);
    if (IN(3)) { ret_scan((const float*)(ws + WS_KV), (bf16*)(ws + WS_ST), gt, NT); }
    SEAM(3);
    if (IN(4)) {
        for (int u = bx; u < 1024; u += G) sb_unit(lds, PROJ, (const float*)(ws + WS_SSQSB), P.sbo_norm, u, tid);
        for (int u = bx; u < 2048; u += G) ret_out_unit(lds, PROJ, (const bf16*)(ws + WS_ST), P.ret_norm, u, tid);
        __syncthreads();
    }
    SEAM(4);
    if (IN(5)) {
        pg8::Gemm g{PROJ, (const bf16*)(ws + WS_WOUT), M, DM, DM, INW}; pg8::StaticOrder S; S.init(M, DM, G, bx);
        pg8::EpiRes<true> E{P.x, P.out, HB, (float*)(ws + WS_SSQ1)};
        pg8::gemm_phase<pg8::EpiRes<true>, pg8::StaticOrder, true, true>(lds, g, S, E);
    }
    SEAM(5);
    if (IN(6)) {
        { pg8::Gemm g{HB, (const bf16*)(ws + WS_WQKV), M, CW, DM, DM}; pg8::StaticOrder S; S.init(M, CW, G, bx);
          pg8::EpiScaleF32 E{(float*)(ws + WS_CQ), CW, (const float*)(ws + WS_SSQ1)};
          pg8::gemm_phase<pg8::EpiScaleF32, pg8::StaticOrder, true, true>(lds, g, S, E); }
        __syncthreads();
        { pg8::Gemm g{(const bf16*)(ws + WS_MB), (const bf16*)(ws + WS_WQKV) + (size_t)CW * DM, BATCH * NMEM, 2 * CW, DM, DM}; pg8::StaticOrder S; S.init(BATCH * NMEM, 2 * CW, G, (bx + G / 2) % G);
          pg8::EpiScaleF32 E{(float*)(ws + WS_CKV), 2 * CW, (const float*)(ws + WS_SSQM)};
          pg8::gemm_phase<pg8::EpiScaleF32, pg8::StaticOrder, true, true>(lds, g, S, E); }
    }
    SEAM(6);
    if (IN(7)) { for (int u = bx; u < 256; u += G) cross_unit(lds, (const float*)(ws + WS_CQ), (const float*)(ws + WS_CKV), P.cq_norm, P.ck_norm, (bf16*)(ws + WS_CO), u, tid); __syncthreads(); }
    SEAM(7);
    if (IN(8)) {
        pg8::Gemm g{(const bf16*)(ws + WS_CO), (const bf16*)(ws + WS_WO), M, DM, CW, CW}; pg8::StaticOrder S; S.init(M, DM, G, bx);
        pg8::EpiRes<true> E{P.out, P.out, HB, (float*)(ws + WS_SSQ2)};
        pg8::gemm_phase<pg8::EpiRes<true>, pg8::StaticOrder, true, true>(lds, g, S, E);
    }
    SEAM(8);
    if (IN(9)) {
        pg8::Gemm g{HB, (const bf16*)(ws + WS_WUP), SEQ, DFF2, DM, DM}; pg8::StaticOrder S; S.init(SEQ, DFF2, G, bx, 0);
        pg8::EpiScaleBf16 E{(bf16*)(ws + WS_U), DFF2, (const float*)(ws + WS_SSQ2)};
        pg8::gemm_phase<pg8::EpiScaleBf16, pg8::StaticOrder, true, true>(lds, g, S, E);
    }
    SEAM(9);
    if (IN(10)) { ffn_act((const bf16*)(ws + WS_U), (bf16*)(ws + WS_ACT), P.conv_w, P.conv_b, 0, gt, NT); }
    SEAM(10);
    if (IN(11)) {
        pg8::Gemm g{HB, (const bf16*)(ws + WS_WUP), SEQ, DFF2, DM, DM}; pg8::StaticOrder S; S.init(SEQ, DFF2, G, bx, SEQ / 256);
        pg8::EpiScaleBf16 E{(bf16*)(ws + WS_U) - (size_t)SEQ * DFF2, DFF2, (const float*)(ws + WS_SSQ2)};
        pg8::gemm_phase<pg8::EpiScaleBf16, pg8::StaticOrder, true, true>(lds, g, S, E);
    }
    SEAM(11);
    if (IN(12)) { ffn_act((const bf16*)(ws + WS_U), (bf16*)(ws + WS_ACT), P.conv_w, P.conv_b, 1, gt, NT); }
    SEAM(12);
    if (IN(13)) {
        pg8::Gemm g{(const bf16*)(ws + WS_ACT), (const bf16*)(ws + WS_WDOWN), M, DM, DFF, DFF}; pg8::StaticOrder S; S.init(M, DM, G, bx);
        pg8::EpiRes<false> E{P.out, P.out, nullptr, nullptr};
        pg8::gemm_phase<pg8::EpiRes<false>, pg8::StaticOrder, true, true>(lds, g, S, E);
    }
#undef IN
#undef SEAM
}

#ifndef MK_CUTS
#define MK_CUTS 0
#endif
extern "C" void kernel_launch(void* const* d_in, const int* in_sizes, int n_in, void* d_out, int out_size, void* d_ws, size_t ws_size, hipStream_t stream) {
    static int grid = 0;
    if (grid == 0) {
        if (n_in != 21 || in_sizes[0] != M * DM || out_size != M * DM || ws_size < WS_END) { fprintf(stderr, "kernel_launch: unexpected shapes (n_in %d, in0 %d, out %d, ws %zu < %zu); nothing launched\n", n_in, n_in > 0 ? in_sizes[0] : -1, out_size, ws_size, (size_t)WS_END); grid = -1; return; }
        int dev = 0, cus = 0, per_cu = 0;
        if (hipGetDevice(&dev) != hipSuccess || hipDeviceGetAttribute(&cus, hipDeviceAttributeMultiprocessorCount, dev) != hipSuccess) { grid = -1; return; }
        if (hipFuncSetAttribute((const void*)mk_fwd, hipFuncAttributeMaxDynamicSharedMemorySize, LDS_BYTES) != hipSuccess) { fprintf(stderr, "kernel_launch: hipFuncSetAttribute failed\n"); grid = -1; return; }
        if (hipOccupancyMaxActiveBlocksPerMultiprocessor(&per_cu, (const void*)mk_fwd, NWAVES * 64, LDS_BYTES) != hipSuccess || per_cu < 1) fprintf(stderr, "kernel_launch: note: occupancy query reports %d\n", per_cu);
        (void)hipGetLastError();
        grid = cus;
    }
    if (grid < 0) return;
    if (hipMemsetAsync((char*)d_ws + WS_CTL, 0, CTL_ZERO_BYTES, stream) != hipSuccess) return;
    Args a{};
    const float** pp = (const float**)&a.p;
    for (int i = 0; i < 21; ++i) pp[i] = (const float*)d_in[i];
    a.p.out = (float*)d_out; a.p.ws = (unsigned char*)d_ws;
#if MK_CUTS
    for (int ph = 0; ph < N_PHASES; ++ph) { a.ph_lo = ph; a.ph_hi = ph + 1; hipLaunchKernelGGL(mk_fwd, dim3(grid), dim3(NWAVES * 64), LDS_BYTES, stream, a); }
#else
    a.ph_lo = 0; a.ph_hi = N_PHASES;
    hipLaunchKernelGGL(mk_fwd, dim3(grid), dim3(NWAVES * 64), LDS_BYTES, stream, a);
#endif
    const hipError_t le = hipPeekAtLastError();
    if (le != hipSuccess) fprintf(stderr, "kernel_launch: launch failed: %s\n", hipGetErrorName(le));
}
```

```cpp
#include <hip/hip_runtime.h>
#include <cstdio>
#include <cstdint>
namespace pg8 {
#define PG8_LAS __attribute__((address_space(3)))
typedef unsigned short bf16_t;
typedef short bf16x8 __attribute__((ext_vector_type(8)));
typedef float f32x4 __attribute__((ext_vector_type(4)));
typedef unsigned u32x4 __attribute__((ext_vector_type(4)));
typedef unsigned u32x2 __attribute__((ext_vector_type(2)));
constexpr int BM = 256, BK = 64, HALF = 128, HTB = HALF * BK * 2  , STAGE_BYTES = 8 * HTB, NXCD = 8, WGM = 8;

__host__ __device__ __forceinline__ int lds_byte(int r, int c) { const int st = (r >> 4) * 2 + (c >> 5), rr = r & 15, cc = c & 31, ob = rr * 64 + cc * 2; return st * 1024 + (ob ^ (((ob >> 9) & 1) << 5)); }
__host__ __device__ __forceinline__ void stage_rc(int b, int& R, int& C) { const int st = b / 1024, sb = b % 1024, swz = sb ^ (((sb >> 9) & 1) << 5); R = (st >> 1) * 16 + swz / 64; C = (st & 1) * 32 + (swz % 64) / 2; }
__host__ __device__ __forceinline__ int perm32(int rho) { const int n = rho >> 4, i = rho & 15; return 8 * (i >> 2) + 4 * n + (i & 3); }
template <int PERM> __host__ __device__ __forceinline__ int permrow(int R) {
    if (PERM == 1) return (R & ~31) + perm32(R & 31);
    if (PERM == 2) return 64 * ((R >> 4) & 1) + 16 * (R >> 5) + (R & 15);
    return R;
}

struct Unit { int pm, pn; };
struct Gemm { const bf16_t* A; const bf16_t* Bt; int M, N, K, lda; };

struct StaticOrder {
    int nM, nN, nwg, G, c, pm0;
    __host__ __device__ void init(int M, int N, int G_, int c_, int pm0_ = 0) { nM = M / BM; nN = N / BM; nwg = nM * nN; G = G_; c = c_; pm0 = pm0_; }
    __host__ __device__ bool next(int i, Unit& u) const {
        const long L = (long)i * G + c; if (L >= nwg) return false;
        int wgid = (int)L; { const int q = nwg / NXCD, r = nwg % NXCD, xcd = wgid % NXCD, off = wgid / NXCD; wgid = (xcd < r ? xcd * (q + 1) : r * (q + 1) + (xcd - r) * q) + off; }
        const int nig = WGM * nN, gid = wgid / nig, fm = gid * WGM, gsz = (nM - fm) < WGM ? (nM - fm) : WGM;
        u.pm = pm0 + fm + ((wgid % nig) % gsz); u.pn = (wgid % nig) / gsz; return true;
    }
    __device__ __forceinline__ void a_ready(const Unit&) const {}
    __device__ __forceinline__ void done(const Unit&) const {}
};

typedef float f32x2 __attribute__((ext_vector_type(2)));
typedef __bf16 bf16v2 __attribute__((ext_vector_type(2)));
__device__ __forceinline__ unsigned pk_bf16(float lo, float hi) { const f32x2 f = {lo, hi}; const bf16v2 r = __builtin_convertvector(f, bf16v2); return __builtin_bit_cast(unsigned, r); }
constexpr float EPSN = 1e-6f;
__constant__ float LOGG[16] = { -3.174869716e-02f, -1.574835740e-02f, -7.843177766e-03f, -3.913899418e-03f, -1.955034910e-03f, -9.770396864e-04f, -4.884005175e-04f, -2.441704273e-04f,
                                -1.220777631e-04f, -6.103701890e-05f, -3.051804379e-05f, -1.525890548e-05f, -7.629423635e-06f, -3.814704542e-06f, -1.907350452e-06f, -9.536747712e-07f };
__device__ __forceinline__ float hsum4(const f32x4 v) { return (v[0] + v[1]) + (v[2] + v[3]); }
__device__ __forceinline__ float dot4(const f32x4 a, const f32x4 b) { return (a[0] * b[0] + a[1] * b[1]) + (a[2] * b[2] + a[3] * b[3]); }
__device__ __forceinline__ float row_rstd64(const float* part, int row, int fq, float invn) {
    const f32x4* p = (const f32x4*)(part + (size_t)row * 64 + fq * 16);
    float s = (hsum4(p[0]) + hsum4(p[1])) + (hsum4(p[2]) + hsum4(p[3]));
    s += __shfl_xor(s, 16); s += __shfl_xor(s, 32);
    return rsqrtf(s * invn + EPSN);
}

#define EPI_FENCE() asm volatile("" ::: "memory")
struct EpiProj {
    static constexpr int PERM = 2; static constexpr bool AFTER_DRAIN = false;
    bf16_t* P; const float* ssq0; const float* cosT; const float* sinT; const float* gq; const float* gk; float* ssqsb;
    template <int REG> __device__ __forceinline__ void body(const f32x4 (&acc)[2][2][4][2], const Unit& u, int wr, int wc, int fr, int fq) const {
        constexpr bool ROPE = (REG == 0 || REG == 2);
        const int pnr = u.pn & 7, d0 = 16 * wc + 4 * fq, rowb = u.pm * BM + wr * 64 + fr;
        float lg[2] = {0.f, 0.f}; f32x4 g0 = {1.f, 1.f, 1.f, 1.f}, g1 = g0;
        if (ROPE) { lg[0] = LOGG[2 * pnr]; lg[1] = LOGG[2 * pnr + 1]; }
        if (REG == 1 || REG == 5) { const float* g = (REG == 1) ? gq : gk; g0 = *(const f32x4*)(g + d0); g1 = *(const f32x4*)(g + 64 + d0); }
        float rsv[8];
#pragma unroll
        for (int g = 0; g < 8; ++g) rsv[g] = ssq0[rowb + (g >> 2) * HALF + (g & 3) * 16];
        f32x4 csn = {0.f, 0.f, 0.f, 0.f}, snn = csn;
        if (ROPE) { const int t = rowb & 8191; csn = *(const f32x4*)(cosT + (size_t)t * 64 + d0); snn = *(const f32x4*)(sinT + (size_t)t * 64 + d0); }
        EPI_FENCE();
#pragma unroll
        for (int g = 0; g < 8; ++g) {
            const int ai = g >> 2, m = g & 3;
            const int row = rowb + ai * HALF + m * 16;
            const float rs = rsqrtf(rsv[g] * (1.0f / 4096.0f) + EPSN);
            const int t = row & 8191; const float cpos = (float)(t & 127);
            const f32x4 cs = csn, sn = snn;
            if (ROPE && g < 7) { const int tn = (rowb + ((g + 1) >> 2) * HALF + ((g + 1) & 3) * 16) & 8191; csn = *(const f32x4*)(cosT + (size_t)tn * 64 + d0); snn = *(const f32x4*)(sinT + (size_t)tn * 64 + d0); }
            EPI_FENCE();
            bf16_t* rowp = P + (size_t)row * 14336 + u.pn * BM + d0;
#pragma unroll
            for (int bj = 0; bj < 2; ++bj) {
                const f32x4 v0 = acc[ai][bj][m][0] * rs, v1 = acc[ai][bj][m][1] * rs;
                f32x4 o0 = v0, o1 = v1;
                if (REG == 0) { const float sc = 0.08838834764831845f * __expf(cpos * lg[bj]); o0 = (v0 * cs - v1 * sn) * sc; o1 = (v1 * cs + v0 * sn) * sc; }
                if (REG == 2) { const float sc = __expf(-cpos * lg[bj]); o0 = (v0 * cs - v1 * sn) * sc; o1 = (v1 * cs + v0 * sn) * sc; }
                if (REG == 4) {
#pragma unroll
                    for (int j = 0; j < 4; ++j) { o0[j] = v0[j] * __builtin_amdgcn_rcpf(1.0f + __expf(-v0[j])); o1[j] = v1[j] * __builtin_amdgcn_rcpf(1.0f + __expf(-v1[j])); } }
                if (REG == 1 || REG == 5) {
                    float s = dot4(v0, v0) + dot4(v1, v1); s += __shfl_xor(s, 16); s += __shfl_xor(s, 32);
                    if (fq == 0) ssqsb[((size_t)row * 32 + (REG == 1 ? 0 : 16) + 2 * pnr + bj) * 4 + wc] = s;
                    o0 = v0 * g0; o1 = v1 * g1; }
                u32x2 w0, w1; w0.x = pk_bf16(o0[0], o0[1]); w0.y = pk_bf16(o0[2], o0[3]); w1.x = pk_bf16(o1[0], o1[1]); w1.y = pk_bf16(o1[2], o1[3]);
                *(u32x2*)(rowp + bj * HALF) = w0; *(u32x2*)(rowp + bj * HALF + 64) = w1;
            }
        }
    }
    __device__ __forceinline__ void operator()(const f32x4 (&acc)[2][2][4][2], const Unit& u, int wr, int wc, int fr, int fq) const {
        const int reg = u.pn >> 3;
        if (reg == 0) body<0>(acc, u, wr, wc, fr, fq); else if (reg == 1) body<1>(acc, u, wr, wc, fr, fq); else if (reg == 2) body<2>(acc, u, wr, wc, fr, fq);
        else if (reg == 4) body<4>(acc, u, wr, wc, fr, fq); else if (reg == 5) body<5>(acc, u, wr, wc, fr, fq); else body<3>(acc, u, wr, wc, fr, fq);
    }
};

template <bool WITH_HB> struct EpiRes {
    static constexpr int PERM = 1; static constexpr bool AFTER_DRAIN = false;
    const float* base; float* out; bf16_t* hb; float* ssq;
    __device__ __forceinline__ void operator()(const f32x4 (&acc)[2][2][4][2], const Unit& u, int wr, int wc, int fr, int fq) const {
        const int col0 = u.pn * BM + wc * 32 + 8 * fq, rowb = u.pm * BM + wr * 64 + fr;
        f32x4 bn[2][2];
#pragma unroll
        for (int bj = 0; bj < 2; ++bj) { const size_t off = (size_t)rowb * 4096 + col0 + bj * HALF; bn[bj][0] = *(const f32x4*)(base + off); bn[bj][1] = *(const f32x4*)(base + off + 4); }
#pragma unroll
        for (int g = 0; g < 8; ++g) {
            const int ai = g >> 2, m = g & 3, row = rowb + ai * HALF + m * 16; float s = 0.f;
            f32x4 b[2][2];
#pragma unroll
            for (int bj = 0; bj < 2; ++bj) { b[bj][0] = bn[bj][0]; b[bj][1] = bn[bj][1]; }
            if (g < 7) { const int rown = rowb + ((g + 1) >> 2) * HALF + ((g + 1) & 3) * 16;
#pragma unroll
                for (int bj = 0; bj < 2; ++bj) { const size_t off = (size_t)rown * 4096 + col0 + bj * HALF; bn[bj][0] = *(const f32x4*)(base + off); bn[bj][1] = *(const f32x4*)(base + off + 4); } }
            EPI_FENCE();
#pragma unroll
            for (int bj = 0; bj < 2; ++bj) {
                const size_t off = (size_t)row * 4096 + col0 + bj * HALF;
                const f32x4 o0 = b[bj][0] + acc[ai][bj][m][0], o1 = b[bj][1] + acc[ai][bj][m][1];
                *(f32x4*)(out + off) = o0; *(f32x4*)(out + off + 4) = o1;
                if (WITH_HB) { u32x4 w; w.x = pk_bf16(o0[0], o0[1]); w.y = pk_bf16(o0[2], o0[3]); w.z = pk_bf16(o1[0], o1[1]); w.w = pk_bf16(o1[2], o1[3]); *(u32x4*)(hb + off) = w; s += dot4(o0, o0) + dot4(o1, o1); }
            }
            if (WITH_HB) { s += __shfl_xor(s, 16); s += __shfl_xor(s, 32); if (fq == 0) __hip_atomic_fetch_add(ssq + row, s, __ATOMIC_RELAXED, __HIP_MEMORY_SCOPE_AGENT); }
            EPI_FENCE();
        }
    }
};

struct EpiScaleF32 {
    static constexpr int PERM = 1; static constexpr bool AFTER_DRAIN = false;
    float* C; int ldc; const float* ssq;
    __device__ __forceinline__ void operator()(const f32x4 (&acc)[2][2][4][2], const Unit& u, int wr, int wc, int fr, int fq) const {
        const int col0 = u.pn * BM + wc * 32 + 8 * fq, rowb = u.pm * BM + wr * 64 + fr;
        float rsv[8];
#pragma unroll
        for (int g = 0; g < 8; ++g) rsv[g] = ssq[rowb + (g >> 2) * HALF + (g & 3) * 16];
        EPI_FENCE();
#pragma unroll
        for (int g = 0; g < 8; ++g) {
            const int ai = g >> 2, m = g & 3, row = rowb + ai * HALF + m * 16; const float rs = rsqrtf(rsv[g] * (1.0f / 4096.0f) + EPSN);
#pragma unroll
            for (int bj = 0; bj < 2; ++bj) { float* p = C + (size_t)row * ldc + col0 + bj * HALF; *(f32x4*)p = acc[ai][bj][m][0] * rs; *(f32x4*)(p + 4) = acc[ai][bj][m][1] * rs; }
        }
    }
};
struct EpiScaleBf16 {
    static constexpr int PERM = 1; static constexpr bool AFTER_DRAIN = false;
    bf16_t* O; int ldc; const float* ssq;
    __device__ __forceinline__ void operator()(const f32x4 (&acc)[2][2][4][2], const Unit& u, int wr, int wc, int fr, int fq) const {
        const int col0 = u.pn * BM + wc * 32 + 8 * fq, rowb = u.pm * BM + wr * 64 + fr;
        float rsv[8];
#pragma unroll
        for (int g = 0; g < 8; ++g) rsv[g] = ssq[rowb + (g >> 2) * HALF + (g & 3) * 16];
        EPI_FENCE();
#pragma unroll
        for (int g = 0; g < 8; ++g) {
            const int ai = g >> 2, m = g & 3, row = rowb + ai * HALF + m * 16; const float rs = rsqrtf(rsv[g] * (1.0f / 4096.0f) + EPSN);
#pragma unroll
            for (int bj = 0; bj < 2; ++bj) { const f32x4 v0 = acc[ai][bj][m][0] * rs, v1 = acc[ai][bj][m][1] * rs;
                u32x4 w; w.x = pk_bf16(v0[0], v0[1]); w.y = pk_bf16(v0[2], v0[3]); w.z = pk_bf16(v1[0], v1[1]); w.w = pk_bf16(v1[2], v1[3]);
                *(u32x4*)(O + (size_t)row * ldc + col0 + bj * HALF) = w; }
        }
    }
};

template <class Epi, class Sched, bool ALIGN_EPI = false, bool SP2 = false>
__device__ __forceinline__ void gemm_phase(PG8_LAS unsigned char* lds, const Gemm g, const Sched& S, const Epi& E) {
    const int tid = threadIdx.x, wid = __builtin_amdgcn_readfirstlane(tid >> 6), lane = tid & 63, wr = wid >> 2, wc = wid & 3, fr = lane & 15, fq = lane >> 4;
    const int K = g.K, nt = K / BK;
    unsigned voffA[2], voffB[2];
#pragma unroll
    for (int i = 0; i < 2; ++i) { int R, C; stage_rc(tid * 16 + i * 8192, R, C); const int Rb = permrow<Epi::PERM>(R);
        voffA[i] = (unsigned)(R * g.lda + C) * 2u; voffB[i] = (unsigned)(Rb * K + C) * 2u; }
    const size_t kstep = (size_t)(BK * 2);
    const size_t hstep = (size_t)HALF * K * 2;
    const size_t tstep = 2 * hstep;
    const size_t hstepA = (size_t)HALF * g.lda * 2, tstepA = 2 * hstepA;
    const unsigned ldsw = (unsigned)wid * 1024u;
    const int aoff = lds_byte(wr * 64 + fr, fq * 8), boff = lds_byte(wc * 32 + fr, fq * 8);
#define PG8_SA(b, h) (((b) * 2 + (h)) * HTB)
#define PG8_SB(b, h) ((4 + (b) * 2 + (h)) * HTB)
#define PG8_STAGE(bufoff, gbase, voff) do { _Pragma("unroll") for (int _i = 0; _i < 2; ++_i) \
        __builtin_amdgcn_global_load_lds((const unsigned*)((const char*)(gbase) + (voff)[_i]), (PG8_LAS unsigned*)(lds + (bufoff) + ldsw + _i * 8192), 16, 0, 0); } while (0)
#define PG8_LDA(dst, b, h) do { _Pragma("unroll") for (int m = 0; m < 4; ++m) _Pragma("unroll") for (int k = 0; k < 2; ++k) dst[m][k] = *(const PG8_LAS bf16x8*)(lds + PG8_SA(b, h) + aoff + m * 2048 + k * 1024); } while (0)
#define PG8_LDB(dst, b, h) do { _Pragma("unroll") for (int n = 0; n < 2; ++n) _Pragma("unroll") for (int k = 0; k < 2; ++k) dst[n][k] = *(const PG8_LAS bf16x8*)(lds + PG8_SB(b, h) + boff + n * 2048 + k * 1024); } while (0)
#define PG8_MMA(ai, bj, At, Bt) do { __builtin_amdgcn_s_setprio(1); _Pragma("unroll") for (int m = 0; m < 4; ++m) _Pragma("unroll") for (int n = 0; n < 2; ++n) _Pragma("unroll") for (int k = 0; k < 2; ++k) \
        acc[ai][bj][m][n] = __builtin_amdgcn_mfma_f32_16x16x32_bf16(Bt[n][k], At[m][k], acc[ai][bj][m][n], 0, 0, 0); __builtin_amdgcn_s_setprio(0); } while (0)
#define PG8_WAIT_V(n) asm volatile("s_waitcnt vmcnt(" #n ")" ::: "memory")
#define PG8_WAIT_L(n) asm volatile("s_waitcnt lgkmcnt(" #n ")" ::: "memory")
#define PG8_BAR __builtin_amdgcn_s_barrier()
#define PG8_SCHED __builtin_amdgcn_sched_barrier(0)
    Unit cur, nxt; int ui = 0;
    if (!S.next(0, cur)) return;
    f32x4 acc[2][2][4][2];
#pragma unroll
    for (int a = 0; a < 2; ++a)
#pragma unroll
        for (int b = 0; b < 2; ++b)
#pragma unroll
            for (int m = 0; m < 4; ++m)
#pragma unroll
                for (int n = 0; n < 2; ++n) acc[a][b][m][n] = (f32x4){0.f, 0.f, 0.f, 0.f};
    bf16x8 At[4][2], B0[2][2], B1[2][2];
    const char* cA = (const char*)g.A + (size_t)cur.pm * tstepA; const char* cB = (const char*)g.Bt + (size_t)cur.pn * tstep;
    S.a_ready(cur);
    if constexpr (SP2) {
        PG8_STAGE(PG8_SB(0, 0), cB, voffB); PG8_STAGE(PG8_SB(0, 1), cB + hstep, voffB); PG8_STAGE(PG8_SA(0, 0), cA, voffA); PG8_STAGE(PG8_SA(0, 1), cA + hstepA, voffA);
        if (wr == 1) PG8_BAR;
        PG8_WAIT_V(2); PG8_BAR;
        PG8_STAGE(PG8_SB(1, 0), cB + kstep, voffB); PG8_STAGE(PG8_SA(1, 0), cA + kstep, voffA); PG8_STAGE(PG8_SB(1, 1), cB + hstep + kstep, voffB);
        PG8_WAIT_V(6); PG8_BAR;
    } else {
        PG8_STAGE(PG8_SB(0, 0), cB, voffB); PG8_STAGE(PG8_SA(0, 0), cA, voffA); PG8_STAGE(PG8_SB(0, 1), cB + hstep, voffB); PG8_STAGE(PG8_SA(0, 1), cA + hstepA, voffA);
        if (wr == 1) PG8_BAR;
        PG8_WAIT_V(4); PG8_BAR;
        PG8_STAGE(PG8_SB(1, 0), cB + kstep, voffB); PG8_STAGE(PG8_SA(1, 0), cA + kstep, voffA); PG8_STAGE(PG8_SB(1, 1), cB + hstep + kstep, voffB);
        PG8_WAIT_V(6); PG8_BAR;
    }
    for (;;) {
        const bool has_next = S.next(ui + 1, nxt);
        const char* nA = has_next ? (const char*)g.A + (size_t)nxt.pm * tstepA : cA; const char* nB = has_next ? (const char*)g.Bt + (size_t)nxt.pn * tstep : cB;
        for (int t = 0; t < nt; t += 2) {
            const bool last = (t == nt - 2);
            const char* a1 = cA + (size_t)(t + 1) * kstep;
            const char* a2 = last ? nA : cA + (size_t)(t + 2) * kstep; const char* b2 = last ? nB : cB + (size_t)(t + 2) * kstep;
            const char* a3 = a2 + kstep; const char* b3 = b2 + kstep;
            if (last && has_next) S.a_ready(nxt);
            if constexpr (SP2) {
            PG8_LDB(B0, 0, 0); PG8_LDB(B1, 0, 1); PG8_SCHED; PG8_LDA(At, 0, 0); PG8_STAGE(PG8_SA(1, 1), a1 + hstepA, voffA);
            PG8_WAIT_V(8); PG8_WAIT_L(0); PG8_BAR; PG8_MMA(0, 0, At, B0); PG8_MMA(0, 1, At, B1); PG8_BAR; PG8_SCHED;
            PG8_LDA(At, 0, 1); PG8_STAGE(PG8_SB(0, 0), b2, voffB); PG8_STAGE(PG8_SB(0, 1), b2 + hstep, voffB); PG8_STAGE(PG8_SA(0, 0), a2, voffA);
            PG8_WAIT_V(8); PG8_WAIT_L(0); PG8_BAR; PG8_MMA(1, 0, At, B0); PG8_MMA(1, 1, At, B1); PG8_BAR; PG8_SCHED;
            PG8_LDB(B0, 1, 0); PG8_LDB(B1, 1, 1); PG8_SCHED; PG8_LDA(At, 1, 0); PG8_STAGE(PG8_SA(0, 1), a2 + hstepA, voffA);
            PG8_WAIT_V(8); PG8_WAIT_L(0); PG8_BAR; PG8_MMA(0, 0, At, B0); PG8_MMA(0, 1, At, B1); PG8_BAR; PG8_SCHED;
            PG8_LDA(At, 1, 1); PG8_STAGE(PG8_SB(1, 0), b3, voffB); PG8_STAGE(PG8_SB(1, 1), b3 + hstep, voffB); PG8_STAGE(PG8_SA(1, 0), a3, voffA);
            PG8_WAIT_V(8); PG8_WAIT_L(0); PG8_BAR; PG8_MMA(1, 0, At, B0); PG8_MMA(1, 1, At, B1); PG8_BAR; PG8_SCHED;
            } else {
            PG8_LDB(B0, 0, 0); PG8_SCHED; PG8_LDA(At, 0, 0); PG8_STAGE(PG8_SA(1, 1), a1 + hstepA, voffA);
            PG8_WAIT_L(8); PG8_BAR; PG8_WAIT_L(0); PG8_MMA(0, 0, At, B0); PG8_BAR; PG8_SCHED;
            PG8_LDB(B1, 0, 1); PG8_STAGE(PG8_SB(0, 0), b2, voffB);
            PG8_BAR; PG8_WAIT_L(0); PG8_MMA(0, 1, At, B1); PG8_BAR;
            PG8_LDA(At, 0, 1); PG8_STAGE(PG8_SA(0, 0), a2, voffA);
            PG8_BAR; PG8_WAIT_L(0); PG8_MMA(1, 0, At, B0); PG8_BAR; PG8_SCHED;
            PG8_STAGE(PG8_SB(0, 1), b2 + hstep, voffB);
            PG8_WAIT_V(6); PG8_BAR; PG8_MMA(1, 1, At, B1); PG8_BAR;
            PG8_LDB(B0, 1, 0); PG8_SCHED; PG8_LDA(At, 1, 0); PG8_STAGE(PG8_SA(0, 1), a2 + hstepA, voffA);
            PG8_WAIT_L(8); PG8_BAR; PG8_WAIT_L(0); PG8_MMA(0, 0, At, B0); PG8_BAR; PG8_SCHED;
            PG8_LDB(B1, 1, 1); PG8_STAGE(PG8_SB(1, 0), b3, voffB);
            PG8_BAR; PG8_WAIT_L(0); PG8_MMA(0, 1, At, B1); PG8_BAR;
            PG8_LDA(At, 1, 1); PG8_STAGE(PG8_SA(1, 0), a3, voffA);
            PG8_BAR; PG8_WAIT_L(0); PG8_MMA(1, 0, At, B0); PG8_BAR; PG8_SCHED;
            PG8_STAGE(PG8_SB(1, 1), b3 + hstep, voffB);
            PG8_WAIT_V(6); PG8_BAR; PG8_MMA(1, 1, At, B1); PG8_BAR;
            }
        }
        if constexpr (ALIGN_EPI) { if (wr == 0) PG8_BAR; }
        if constexpr (!Epi::AFTER_DRAIN) { E(acc, cur, wr, wc, fr, fq); S.done(cur); }
        if (!has_next) break;
#pragma unroll
        for (int a = 0; a < 2; ++a)
#pragma unroll
            for (int b = 0; b < 2; ++b)
#pragma unroll
                for (int m = 0; m < 4; ++m)
#pragma unroll
                    for (int n = 0; n < 2; ++n) acc[a][b][m][n] = (f32x4){0.f, 0.f, 0.f, 0.f};
        cur = nxt; cA = nA; cB = nB; ++ui;
        if constexpr (ALIGN_EPI) { if (wr == 1) PG8_BAR; }
    }
    PG8_WAIT_V(0);
    if constexpr (!ALIGN_EPI) { if (wr == 0) PG8_BAR; }
    PG8_BAR;
    if constexpr (Epi::AFTER_DRAIN) { E.fused(acc, cur, wr, wc, fr, fq, lds, wid, lane); S.done(cur); }
#undef PG8_SA
#undef PG8_SB
#undef PG8_STAGE
#undef PG8_LDA
#undef PG8_LDB
#undef PG8_MMA
#undef PG8_WAIT_V
#undef PG8_WAIT_L
#undef PG8_BAR
#undef PG8_SCHED
}
}
#define LAS __attribute__((address_space(3)))
#define XB_TMO      128
#define XB_XCNT(j)  (256  + 64 * (j))
#define XB_XSUB(j)  (1280 + 64 * (j))
#define XB_XGEN(j)  (2304 + 64 * (j))
#define XB_TOP      3328
#define XB_TOPGEN   3392
#define XCD_BAR_WORDS 3456
#define XB_SPIN_CAP (1u << 18)

__device__ __forceinline__ unsigned xb_ld(unsigned* p)              { return __hip_atomic_load(p, __ATOMIC_RELAXED, __HIP_MEMORY_SCOPE_AGENT); }
__device__ __forceinline__ unsigned xb_add(unsigned* p, unsigned v) { return __hip_atomic_fetch_add(p, v, __ATOMIC_RELAXED, __HIP_MEMORY_SCOPE_AGENT); }
__device__ __forceinline__ unsigned xb_xcc_id() { return (unsigned)__builtin_amdgcn_s_getreg((3 << 11) | 20) & 0xFu; }
#define XB_SPIN(cond, bar) do { unsigned _sp = 0; while (cond) { __builtin_amdgcn_s_sleep(1); \
    if ((++_sp & 255u) == 0u) { if (xb_ld(&(bar)[XB_TMO])) break; if (_sp > XB_SPIN_CAP) { atomicAdd(&(bar)[XB_TMO], 1u); break; } } } } while (0)

struct XcdBarrier {
    unsigned* bar; unsigned x;
    volatile LAS unsigned* st;
};

__device__ __forceinline__ XcdBarrier xcd_barrier_post(unsigned* bar, volatile LAS unsigned* st) {
    XcdBarrier b; b.bar = bar; b.x = xb_xcc_id(); b.st = st;
    if (threadIdx.x == 0) (void)xb_add(&bar[XB_XCNT(b.x)], 1u);
    return b;
}
__device__ __forceinline__ void xcd_barrier_complete(unsigned* bar, unsigned x, unsigned& nloc, unsigned& nx) {
    const unsigned G = gridDim.x * gridDim.y * gridDim.z;
    unsigned sum, cnt, mine, sp = 0u;
    for (;;) {
        sum = 0u; cnt = 0u; mine = 0u;
#pragma unroll
        for (unsigned j = 0; j < 16; ++j) { const unsigned c = xb_ld(&bar[XB_XCNT(j)]); sum += c; cnt += (c > 0u) ? 1u : 0u; mine = (j == x) ? c : mine; }
        if (sum == G) break;
        __builtin_amdgcn_s_sleep(1);
        if ((++sp & 255u) == 0u) { if (xb_ld(&bar[XB_TMO])) break; if (sp > XB_SPIN_CAP) { atomicAdd(&bar[XB_TMO], 1u); break; } }
    }
    nloc = mine > 0u ? mine : 1u; nx = cnt > 0u ? cnt : 1u;
}

__device__ __forceinline__ void xcd_barrier(const XcdBarrier& b) {
    asm volatile("s_waitcnt vmcnt(0)" ::: "memory");
    __syncthreads();
    if (threadIdx.x == 0) {
        unsigned* bar = b.bar;
        __builtin_amdgcn_s_waitcnt(0);
        unsigned nloc = b.st[0], nx = b.st[1];
        if (nloc == 0u) { xcd_barrier_complete(bar, b.x, nloc, nx); b.st[0] = nloc; b.st[1] = nx; }
        const unsigned old = xb_add(&bar[XB_XSUB(b.x)], 1u);
        const unsigned gen = old / nloc;
        if (old + 1u == (gen + 1u) * nloc) {
            __builtin_amdgcn_fence(__ATOMIC_RELEASE, "agent");
            asm volatile("s_waitcnt vmcnt(0)" ::: "memory");
            const unsigned og = xb_add(&bar[XB_TOP], 1u);
            const unsigned tg = og / nx;
            if (og + 1u == (tg + 1u) * nx) xb_add(&bar[XB_TOPGEN], 1u);
            else XB_SPIN(xb_ld(&bar[XB_TOPGEN]) == tg, bar);
            __builtin_amdgcn_fence(__ATOMIC_ACQUIRE, "agent");
            xb_add(&bar[XB_XGEN(b.x)], 1u);
            asm volatile("s_waitcnt vmcnt(0)" ::: "memory");
        } else {
            XB_SPIN(xb_ld(&bar[XB_XGEN(b.x)]) == gen, bar);
            __builtin_amdgcn_fence(__ATOMIC_ACQUIRE, "agent");
            asm volatile("s_waitcnt vmcnt(0)" ::: "memory");
        }
    }
    __syncthreads();
}
constexpr int NWAVES = 8;
constexpr int SEQ = 8192, BATCH = 2, M = BATCH * SEQ, DM = 4096, HD = 128, NH = 16, INW = 14336, NMEM = 256, CW = 512, DFF = 11008, DFF2 = 2 * DFF;
constexpr int C_RQ = 0, C_SQ = 2048, C_RK = 4096, C_RV = 6144, C_RG = 8192, C_SK = 10240, C_SV = 12288;
constexpr float SB_EXIT = 110.0f;
constexpr size_t MiB = 1u << 20;
constexpr size_t WS_CTL = 0, CTL_ZERO_BYTES = 1 * MiB;
constexpr size_t WS_COS = 1 * MiB, WS_SIN = 3 * MiB, WS_SSQ0 = 5 * MiB, WS_SSQM = 5 * MiB + 256 * 1024, WS_SSQ1 = 256 * 1024, WS_SSQ2 = 512 * 1024  , WS_SSQSB = 14 * MiB;
constexpr size_t WS_MB = 22 * MiB, WS_CQ = 26 * MiB, WS_CKV = 58 * MiB, WS_CO = 60 * MiB;
constexpr size_t WS_WQKV = 76 * MiB, WS_WO = 88 * MiB, WS_WUP = 92 * MiB, WS_WDOWN = 264 * MiB, WS_HB = 350 * MiB;
constexpr size_t WS_WIN = 478 * MiB, WS_WOUT = 590 * MiB, WS_PROJ = 622 * MiB, WS_KV = 1070 * MiB, WS_ST = 1198 * MiB, WS_END = 1262 * MiB;
constexpr size_t WS_U = 478 * MiB, WS_ACT = 822 * MiB;
static_assert(WS_U + (size_t)SEQ * DFF2 * 2 <= WS_ACT && WS_ACT + (size_t)M * DFF * 2 <= WS_END, "ffn overlays");
static_assert(WS_PROJ + (size_t)M * INW * 2 <= WS_KV && WS_KV + (size_t)2048 * 16384 * 4 <= WS_ST && WS_ST + (size_t)2048 * 16384 * 2 <= WS_END, "mixer map");
static_assert(WS_WIN + (size_t)INW * DM * 2 <= WS_WOUT && WS_WOUT + (size_t)DM * DM * 2 <= WS_PROJ && WS_WUP + (size_t)DFF2 * DM * 2 <= WS_WDOWN && WS_WDOWN + (size_t)DM * DFF * 2 <= WS_HB && WS_HB + (size_t)M * DM * 2 <= WS_WIN, "weights map");
constexpr int CW_BAR = 4096;
constexpr int RING_BYTES = 131072, LDSCTL_OFF = RING_BYTES, MISC_OFF = LDSCTL_OFF + 320, LDS_BYTES = 147456;
constexpr int L_KT = 0, L_VT = 40960, L_RK = 81920, L_FL = 82944, L_RED = 83200;
constexpr int KSTR = 272, VSTR = 320;

#define GAS __attribute__((address_space(1)))
#define LAS __attribute__((address_space(3)))
#define DI __device__ __forceinline__
typedef unsigned short bf16;
typedef unsigned v4u __attribute__((ext_vector_type(4)));
typedef unsigned v2u __attribute__((ext_vector_type(2)));
typedef float f32x4 __attribute__((ext_vector_type(4)));
typedef float f32x16 __attribute__((ext_vector_type(16)));
typedef short bf16x8 __attribute__((ext_vector_type(8)));
typedef short s16x4 __attribute__((ext_vector_type(4)));
typedef GAS unsigned gu32;
#define RLX_AGENT __ATOMIC_RELAXED, __HIP_MEMORY_SCOPE_AGENT
#define LDS_WAIT() asm volatile("s_waitcnt lgkmcnt(0)" ::: "memory")
using pg8::pk_bf16; using pg8::EPSN; using pg8::LOGG; using pg8::hsum4;
#define MFMA32(a, b, c) __builtin_amdgcn_mfma_f32_32x32x16_bf16((a), (b), (c), 0, 0, 0)
DI int crow(int i, int h) { return (i & 3) + 8 * (i >> 2) + 4 * h; }
DI bf16x8 pack8(float a0, float a1, float a2, float a3, float a4, float a5, float a6, float a7) { v4u p; p.x = pk_bf16(a0, a1); p.y = pk_bf16(a2, a3); p.z = pk_bf16(a4, a5); p.w = pk_bf16(a6, a7); return __builtin_bit_cast(bf16x8, p); }
DI float bf2f(unsigned short b) { return __builtin_bit_cast(float, (unsigned)b << 16); }
DI float wave_sum(float v) {
#pragma unroll
    for (int o = 1; o < 64; o <<= 1) v += __shfl_xor(v, o);
    return v;
}
__constant__ float INVF[64] = { 1.000000000e+00f, 8.639884591e-01f, 7.464760542e-01f, 6.449466348e-01f, 5.572264791e-01f, 4.814372361e-01f, 4.159561992e-01f, 3.593813479e-01f, 3.105013072e-01f, 2.682695389e-01f, 2.317818105e-01f, 2.002568096e-01f, 1.730195731e-01f, 1.494868994e-01f, 1.291549653e-01f, 1.115883961e-01f,
    9.641107172e-02f, 8.329805732e-02f, 7.196855545e-02f, 6.218000501e-02f, 5.372280627e-02f, 4.641588405e-02f, 4.010278732e-02f, 3.464834765e-02f, 2.993577160e-02f, 2.586415969e-02f, 2.234633639e-02f, 1.930697635e-02f, 1.668100432e-02f, 1.441219542e-02f, 1.245197095e-02f, 1.075835899e-02f,
    9.295094758e-03f, 8.030855097e-03f, 6.938565988e-03f, 5.994841456e-03f, 5.179473665e-03f, 4.475004971e-03f, 3.866352839e-03f, 3.340484342e-03f, 2.886140021e-03f, 2.493591513e-03f, 2.154434333e-03f, 1.861406374e-03f, 1.608233550e-03f, 1.389495214e-03f, 1.200507861e-03f, 1.037224894e-03f,
    8.961503627e-04f, 7.742635789e-04f, 6.689548027e-04f, 5.779691855e-04f, 4.993587499e-04f, 4.314401885e-04f, 3.727593576e-04f, 3.220597864e-04f, 2.782559022e-04f, 2.404099068e-04f, 2.077113895e-04f, 1.794602285e-04f, 1.550515735e-04f, 1.339627779e-04f, 1.157422885e-04f, 9.999999747e-05f };
typedef float f32x2g __attribute__((ext_vector_type(2)));
template <bool HASG> DI void transpose_tile64(const float* __restrict__ W, int N, const float* __restrict__ gain, bf16* __restrict__ WT, int Kd, int dst_row0, int src_col0, int k0, LAS unsigned* scr, int lane) {
    const int n4 = lane & 15, kk = lane >> 4;
    f32x4 a[8], b[8]; f32x2g gg[8];
    const float* src = W + (size_t)(k0 + 2 * kk) * N + src_col0 + 4 * n4;
#pragma unroll
    for (int i = 0; i < 8; ++i) { a[i] = *(const GAS f32x4*)(src + (size_t)(8 * i) * N); b[i] = *(const GAS f32x4*)(src + (size_t)(8 * i + 1) * N); }
#pragma unroll
    for (int i = 0; i < 8; ++i) { if (HASG) gg[i] = *(const GAS f32x2g*)(gain + k0 + 8 * i + 2 * kk); else gg[i] = (f32x2g){1.f, 1.f}; }
    asm volatile("" ::: "memory");
#pragma unroll
    for (int i = 0; i < 8; ++i)
#pragma unroll
        for (int j = 0; j < 4; ++j) scr[(4 * n4 + j) * 33 + 4 * i + kk] = pk_bf16(a[i][j] * gg[i].x, b[i][j] * gg[i].y);
    LDS_WAIT(); asm volatile("" ::: "memory");
    const int c = lane & 7, nr = lane >> 3;
#pragma unroll
    for (int it = 0; it < 8; ++it) { const int n = 8 * it + nr; const LAS unsigned* sp = scr + n * 33 + 4 * c;
        v4u o; o.x = sp[0]; o.y = sp[1]; o.z = sp[2]; o.w = sp[3];
        *(GAS v4u*)(WT + (size_t)(dst_row0 + n) * Kd + k0 + 8 * c) = o; }
    LDS_WAIT(); asm volatile("" ::: "memory");
}
DI void row_to_bf16(const float* __restrict__ xrow, bf16* __restrict__ orow, float* __restrict__ ssq, int lane) {
    const GAS f32x4* xr = (const GAS f32x4*)xrow + lane; GAS v2u* o8 = (GAS v2u*)orow + lane; float s = 0.f; f32x4 v[16];
#pragma unroll
    for (int j = 0; j < 16; ++j) v[j] = xr[64 * j];
    asm volatile("" ::: "memory");
#pragma unroll
    for (int j = 0; j < 16; ++j) { s += (v[j].x * v[j].x + v[j].y * v[j].y) + (v[j].z * v[j].z + v[j].w * v[j].w); v2u w; w.x = pk_bf16(v[j].x, v[j].y); w.y = pk_bf16(v[j].z, v[j].w); o8[64 * j] = w; }
    s = wave_sum(s); if (lane == 0) *ssq = s;
}
struct Ptrs {
    const float *x, *mem, *attn_norm, *w_in, *ret_norm, *sbq_norm, *sbk_norm, *sbo_norm, *w_out, *cross_norm, *mem_norm, *wq, *wkv, *cq_norm, *ck_norm, *wo, *ffn_norm, *w_up, *conv_w, *conv_b, *w_down;
    float* out; unsigned char* ws;
};
DI void p0_prologue(const Ptrs& P, LAS unsigned char* lds, int gw, int NGW, int wave, int lane) {
    unsigned char* ws = P.ws;
    LAS unsigned* scr = (LAS unsigned*)(lds + wave * 16384);
    constexpr int KB = DM / 64;
    constexpr int I_IN = KB * (INW / 64), I_OUT = KB * (DM / 64), I_Q = KB * (CW / 64), I_KV = KB * (2 * CW / 64), I_O = (CW / 64) * (DM / 64), I_UP = KB * (DFF2 / 64), I_DN = (DFF / 64) * (DM / 64);
    constexpr int NITEMS = I_IN + I_OUT + I_Q + I_KV + I_O + I_UP + I_DN;
    for (int it = gw; it < NITEMS; it += NGW) {
        int r = it;
        if (r < I_IN) { const int nb = r % (INW / 64), kb = r / (INW / 64), n0 = 64 * nb, reg = n0 >> 11;
            const int src = (reg == 0 ? 0 : reg == 1 ? 8192 : reg == 2 ? 2048 : reg == 3 ? 4096 : reg == 4 ? 6144 : reg == 5 ? 10240 : 12288) + (n0 & 2047);
            transpose_tile64<true>(P.w_in, INW, P.attn_norm, (bf16*)(ws + WS_WIN), DM, n0, src, 64 * kb, scr, lane); continue; } r -= I_IN;
        if (r < I_OUT) { const int nb = r % (DM / 64), kb = r / (DM / 64); transpose_tile64<false>(P.w_out, DM, nullptr, (bf16*)(ws + WS_WOUT), DM, 64 * nb, 64 * nb, 64 * kb, scr, lane); continue; } r -= I_OUT;
        if (r < I_Q) { const int nb = r % (CW / 64), kb = r / (CW / 64); transpose_tile64<true>(P.wq, CW, P.cross_norm, (bf16*)(ws + WS_WQKV), DM, 64 * nb, 64 * nb, 64 * kb, scr, lane); continue; } r -= I_Q;
        if (r < I_KV) { const int nb = r % (2 * CW / 64), kb = r / (2 * CW / 64); transpose_tile64<true>(P.wkv, 2 * CW, P.mem_norm, (bf16*)(ws + WS_WQKV), DM, CW + 64 * nb, 64 * nb, 64 * kb, scr, lane); continue; } r -= I_KV;
        if (r < I_O) { const int nb = r % (DM / 64), kb = r / (DM / 64); transpose_tile64<false>(P.wo, DM, nullptr, (bf16*)(ws + WS_WO), CW, 64 * nb, 64 * nb, 64 * kb, scr, lane); continue; } r -= I_O;
        if (r < I_UP) { const int nb = r % (DFF2 / 64), kb = r / (DFF2 / 64); transpose_tile64<true>(P.w_up, DFF2, P.ffn_norm, (bf16*)(ws + WS_WUP), DM, 64 * nb, 64 * nb, 64 * kb, scr, lane); continue; } r -= I_UP;
        { const int nb = r % (DM / 64), kb = r / (DM / 64); transpose_tile64<false>(P.w_down, DM, nullptr, (bf16*)(ws + WS_WDOWN), DFF, 64 * nb, 64 * nb, 64 * kb, scr, lane); }
    }
    for (int m = gw; m < M; m += NGW) row_to_bf16(P.x + (size_t)m * DM, (bf16*)(ws + WS_HB) + (size_t)m * DM, (float*)(ws + WS_SSQ0) + m, lane);
    for (int m = gw; m < BATCH * NMEM; m += NGW) row_to_bf16(P.mem + (size_t)m * DM, (bf16*)(ws + WS_MB) + (size_t)m * DM, (float*)(ws + WS_SSQM) + m, lane);
    for (int idx = gw * 64 + lane; idx < SEQ * 64; idx += NGW * 64) {
        const int t = idx >> 6, i = idx & 63; const float angf = (float)t * INVF[i]; const double ang = (double)angf;
        const double kq = __builtin_rint(ang * 0.15915494309189535); const double rr = __builtin_fma(-kq, 6.283185307179586, ang) - kq * 2.4492935982947064e-16;
        const double r2 = rr * rr; double sn = 0.0, cs = 0.0;
#pragma unroll
        for (int k = 13; k >= 0; --k) { cs = cs * (-r2 / (double)((2 * k + 1) * (2 * k + 2))) + 1.0; sn = sn * (-r2 / (double)((2 * k + 2) * (2 * k + 3))) + 1.0; }
        ((float*)(ws + WS_COS))[idx] = (float)cs; ((float*)(ws + WS_SIN))[idx] = (float)(sn * rr);
    }
}
DI void stage_tile(LAS unsigned char* dst, int stride, const bf16* src, size_t ld, int rows, int tid) {
    for (int ch = tid; ch < rows * 16; ch += NWAVES * 64) { const int r = ch >> 4, c = ch & 15; const v4u v = *(const GAS v4u*)(src + (size_t)r * ld + c * 8); *(LAS v4u*)(dst + r * stride + c * 16) = v; }
}
DI bf16x8 tr_frag(LAS unsigned char* tile, int stride, int row0, int col0, int lane) {
    const int g = lane >> 4, i16 = lane & 15, q = i16 >> 2, p = i16 & 3, h = lane >> 5;
    LAS unsigned char* a = tile + (row0 + 4 * h + q) * stride + (col0 + 16 * (g & 1) + 4 * p) * 2;
    const s16x4 lo = __builtin_amdgcn_ds_read_tr16_b64_v4i16((LAS s16x4*)a);
    const s16x4 hi = __builtin_amdgcn_ds_read_tr16_b64_v4i16((LAS s16x4*)(a + 8 * stride));
    return __builtin_shufflevector(lo, hi, 0, 1, 2, 3, 4, 5, 6, 7);
}
DI f32x16 st_tile(LAS unsigned char* KT, int krow0, const bf16x8 (&qf)[8], int r, int h) {
    f32x16 acc;
#pragma unroll
    for (int i = 0; i < 16; ++i) acc[i] = 0.f;
#pragma unroll
    for (int ks = 0; ks < 8; ++ks) { const bf16x8 a = *(const LAS bf16x8*)(KT + (krow0 + r) * KSTR + (16 * ks + 8 * h) * 2); acc = MFMA32(a, qf[ks], acc); }
    return acc;
}
DI void load_qf(bf16x8 (&qf)[8], const bf16* qrowp, int h) {
#pragma unroll
    for (int ks = 0; ks < 8; ++ks) qf[ks] = *(const GAS bf16x8*)(qrowp + 16 * ks + 8 * h);
}

DI void ret_kv_unit(LAS unsigned char* lds, const bf16* PROJ, float* KVB, int unit, int tid) {
    const int lane = tid & 63, w = __builtin_amdgcn_readfirstlane(tid >> 6), r = lane & 31, h = lane >> 5;
    const int n = unit & 63, hd = (unit >> 6) & 15, b = unit >> 10;
    LAS unsigned char* KT = lds + L_KT; LAS unsigned char* VT = lds + L_VT;
    const size_t m0 = (size_t)b * SEQ + 128 * n;
    __syncthreads();
    stage_tile(KT, VSTR, PROJ + m0 * INW + C_RK + 128 * hd, INW, 128, tid);
    stage_tile(VT, VSTR, PROJ + m0 * INW + C_RV + 128 * hd, INW, 128, tid);
    __syncthreads();
    const int te = w >> 1, td0 = 2 * (w & 1);
    f32x16 acc[2];
#pragma unroll
    for (int t = 0; t < 2; ++t)
#pragma unroll
        for (int i = 0; i < 16; ++i) acc[t][i] = 0.f;
#pragma unroll
    for (int ks = 0; ks < 8; ++ks) {
        const bf16x8 a = tr_frag(VT, VSTR, 16 * ks, 32 * te, lane);
#pragma unroll
        for (int t = 0; t < 2; ++t) { const bf16x8 bb = tr_frag(KT, VSTR, 16 * ks, 32 * (td0 + t), lane); acc[t] = MFMA32(a, bb, acc[t]); }
    }
    const float sc = __expf(127.0f * LOGG[hd]);
    float* o = KVB + (size_t)unit * 16384;
#pragma unroll
    for (int t = 0; t < 2; ++t)
#pragma unroll
        for (int i = 0; i < 16; ++i) o[(32 * te + crow(i, h)) * 128 + 32 * (td0 + t) + r] = acc[t][i] * sc;
}
DI void ret_scan(const float* KVB, bf16* ST, int gt, int NT) {
    for (int idx = gt; idx < 32 * 4096; idx += NT) {
        const int bh = idx >> 12, e4 = idx & 4095; const float dec = __expf(128.0f * LOGG[bh & 15]);
        f32x4 S = {0.f, 0.f, 0.f, 0.f};
        for (int n = 0; n < 64; ++n) {
            const size_t off = ((size_t)(bh * 64 + n) * 4096 + e4) * 4;
            v2u w; w.x = pk_bf16(S[0], S[1]); w.y = pk_bf16(S[2], S[3]); *(GAS v2u*)(ST + off) = w;
            const f32x4 kv = *(const GAS f32x4*)(KVB + off); S = S * dec + kv;
        }
    }
}
DI void ret_out_unit(LAS unsigned char* lds, bf16* PROJ, const bf16* ST, const float* gret, int unit, int tid) {
    const int lane = tid & 63, w = __builtin_amdgcn_readfirstlane(tid >> 6), r = lane & 31, h = lane >> 5, qg = w & 3, eh = w >> 2;
    const int n = unit & 63, hd = (unit >> 6) & 15, b = unit >> 10;
    LAS unsigned char* KT = lds + L_KT; LAS unsigned char* VT = lds + L_VT; LAS float* RED = (LAS float*)(lds + L_RED);
    const size_t m0 = (size_t)b * SEQ + 128 * n, qrow = m0 + 32 * qg + r;
    __syncthreads();
    stage_tile(KT, KSTR, PROJ + m0 * INW + C_RK + 128 * hd, INW, 128, tid);
    stage_tile(VT, VSTR, PROJ + m0 * INW + C_RV + 128 * hd, INW, 128, tid);
    bf16x8 qf[8]; load_qf(qf, PROJ + qrow * INW + C_RQ + 128 * hd, h);
    const bf16* st = ST + (size_t)unit * 16384;
    f32x16 O[2];
#pragma unroll
    for (int et = 0; et < 2; ++et) {
#pragma unroll
        for (int i = 0; i < 16; ++i) O[et][i] = 0.f;
#pragma unroll
        for (int ks = 0; ks < 8; ++ks) { const bf16x8 a = *(const GAS bf16x8*)(st + (32 * (2 * eh + et) + r) * 128 + 16 * ks + 8 * h); O[et] = MFMA32(a, qf[ks], O[et]); }
    }
    const float g1 = __expf(LOGG[hd]);
#pragma unroll
    for (int et = 0; et < 2; ++et) O[et] = O[et] * g1;
    __syncthreads();
    for (int kt = 0; kt <= qg; ++kt) {
        f32x16 s = st_tile(KT, 32 * kt, qf, r, h);
        if (kt == qg) {
#pragma unroll
            for (int i = 0; i < 16; ++i) s[i] = (crow(i, h) <= r) ? s[i] : 0.f;
        }
        bf16x8 pb[2];
#pragma unroll
        for (int s2 = 0; s2 < 2; ++s2) pb[s2] = pack8(s[8 * s2], s[8 * s2 + 1], s[8 * s2 + 2], s[8 * s2 + 3], s[8 * s2 + 4], s[8 * s2 + 5], s[8 * s2 + 6], s[8 * s2 + 7]);
#pragma unroll
        for (int et = 0; et < 2; ++et)
#pragma unroll
            for (int s2 = 0; s2 < 2; ++s2) O[et] = MFMA32(tr_frag(VT, VSTR, 32 * kt + 16 * s2, 32 * (2 * eh + et), lane), pb[s2], O[et]);
    }
    float ss = 0.f;
#pragma unroll
    for (int et = 0; et < 2; ++et)
#pragma unroll
        for (int i = 0; i < 16; ++i) ss += O[et][i] * O[et][i];
    ss += __shfl_xor(ss, 32);
    if (h == 0) RED[w * 32 + r] = ss;
    __syncthreads();
    const float rstd = rsqrtf((RED[w * 32 + r] + RED[(w ^ 4) * 32 + r]) * (1.0f / 128.0f) + EPSN);
    bf16* orow = PROJ + qrow * INW + 128 * hd;
#pragma unroll
    for (int et = 0; et < 2; ++et)
#pragma unroll
        for (int G = 0; G < 4; ++G) {
            const int e = 32 * (2 * eh + et) + 8 * G + 4 * h;
            const f32x4 g = *(const f32x4*)(gret + e); const v2u gt = *(const GAS v2u*)(orow + C_RG + e);
            const float o0 = O[et][4 * G + 0] * rstd * g[0] * bf2f((unsigned short)(gt.x & 0xffff)), o1 = O[et][4 * G + 1] * rstd * g[1] * bf2f((unsigned short)(gt.x >> 16));
            const float o2 = O[et][4 * G + 2] * rstd * g[2] * bf2f((unsigned short)(gt.y & 0xffff)), o3 = O[et][4 * G + 3] * rstd * g[3] * bf2f((unsigned short)(gt.y >> 16));
            v2u wv; wv.x = pk_bf16(o0, o1); wv.y = pk_bf16(o2, o3); *(GAS v2u*)(orow + C_RQ + e) = wv;
        }
}
DI void sb_unit(LAS unsigned char* lds, bf16* PROJ, const float* ssqsb, const float* gout, int unit, int tid) {
    const int lane = tid & 63, w = __builtin_amdgcn_readfirstlane(tid >> 6), r = lane & 31, h = lane >> 5;
    const int qb = unit & 31, hd = (unit >> 5) & 15, b = unit >> 9;
    LAS unsigned char* KT = lds + L_KT; LAS unsigned char* VT = lds + L_VT; LAS float* RK = (LAS float*)(lds + L_RK); LAS unsigned* FL = (LAS unsigned*)(lds + L_FL);
    const size_t m0 = (size_t)b * SEQ + 256 * qb, qrow = m0 + 32 * w + r;
    const int qlo = 256 * qb + 32 * w, qhi = qlo + 31, tq = qlo + r;
    bf16x8 qf[8]; load_qf(qf, PROJ + qrow * INW + C_SQ + 128 * hd, h);
    const f32x4 pq = *(const GAS f32x4*)(ssqsb + (qrow * 32 + hd) * 4);
    const float qscale = rsqrtf(hsum4(pq) * (1.0f / 128.0f) + EPSN) * 0.08838834764831845f;
    f32x16 O[4];
#pragma unroll
    for (int dt = 0; dt < 4; ++dt)
#pragma unroll
        for (int i = 0; i < 16; ++i) O[dt][i] = 0.f;
    float R = 0.f;
    for (int kb = 2 * qb + 1; kb >= 0; --kb) {
        __syncthreads();
        if (kb != 2 * qb + 1) { const unsigned all = FL[0] & FL[1] & FL[2] & FL[3] & FL[4] & FL[5] & FL[6] & FL[7]; if (all) break; }
        const size_t k0row = (size_t)b * SEQ + 128 * kb;
        stage_tile(KT, KSTR, PROJ + k0row * INW + C_SK + 128 * hd, INW, 128, tid);
        stage_tile(VT, VSTR, PROJ + k0row * INW + C_SV + 128 * hd, INW, 128, tid);
        if (tid < 128) { const f32x4 pk = *(const GAS f32x4*)(ssqsb + ((k0row + tid) * 32 + 16 + hd) * 4); RK[tid] = rsqrtf(hsum4(pk) * (1.0f / 128.0f) + EPSN); }
        __syncthreads();
        const int k0b = 128 * kb;
        if (k0b < qhi) {
            for (int st = 3; st >= 0; --st) {
                const int k0 = k0b + 32 * st;
                if (k0 >= qhi) continue;
                const f32x16 s = st_tile(KT, 32 * st, qf, r, h);
                const bool need_mask = (k0 + 31 >= qlo);
                float a[16];
#pragma unroll
                for (int G = 3; G >= 0; --G) {
                    const f32x4 rk = *(const LAS f32x4*)(RK + 32 * st + 8 * G + 4 * h);
                    float z[4], sp[4]; bool ok[4];
#pragma unroll
                    for (int j = 0; j < 4; ++j) {
                        z[j] = s[4 * G + j] * qscale * rk[j];
                        ok[j] = !need_mask || (k0 + 8 * G + 4 * h + j < tq);
                        const float spv = fmaxf(z[j], 0.f) + __logf(1.0f + __expf(-fabsf(z[j])));
                        sp[j] = ok[j] ? spv : 0.f;
                    }
                    const float l3 = sp[3], l2 = sp[2] + l3, l1 = sp[1] + l2, l0 = sp[0] + l1;
                    const float To = __shfl_xor(l0, 32);
                    const float off = h ? R : R + To;
                    a[4 * G + 0] = ok[0] ? __expf(z[0] - (off + l0)) : 0.f; a[4 * G + 1] = ok[1] ? __expf(z[1] - (off + l1)) : 0.f;
                    a[4 * G + 2] = ok[2] ? __expf(z[2] - (off + l2)) : 0.f; a[4 * G + 3] = ok[3] ? __expf(z[3] - (off + l3)) : 0.f;
                    R = R + (l0 + To);
                }
                bf16x8 pb[2];
#pragma unroll
                for (int s2 = 0; s2 < 2; ++s2) pb[s2] = pack8(a[8 * s2], a[8 * s2 + 1], a[8 * s2 + 2], a[8 * s2 + 3], a[8 * s2 + 4], a[8 * s2 + 5], a[8 * s2 + 6], a[8 * s2 + 7]);
#pragma unroll
                for (int dt = 0; dt < 4; ++dt)
#pragma unroll
                    for (int s2 = 0; s2 < 2; ++s2) O[dt] = MFMA32(tr_frag(VT, VSTR, 32 * st + 16 * s2, 32 * dt, lane), pb[s2], O[dt]);
            }
        }
        const bool done = __all(R > SB_EXIT);
        if (lane == 0) FL[w] = done ? 1u : 0u;
    }
    float ss = 0.f;
#pragma unroll
    for (int dt = 0; dt < 4; ++dt)
#pragma unroll
        for (int i = 0; i < 16; ++i) ss += O[dt][i] * O[dt][i];
    ss += __shfl_xor(ss, 32);
    const float rstd = rsqrtf(ss * (1.0f / 128.0f) + EPSN);
    bf16* orow = PROJ + qrow * INW + C_SQ + 128 * hd;
#pragma unroll
    for (int dt = 0; dt < 4; ++dt)
#pragma unroll
        for (int G = 0; G < 4; ++G) {
            const int d = 32 * dt + 8 * G + 4 * h; const f32x4 g = *(const f32x4*)(gout + d);
            v2u wv; wv.x = pk_bf16(O[dt][4 * G] * rstd * g[0], O[dt][4 * G + 1] * rstd * g[1]); wv.y = pk_bf16(O[dt][4 * G + 2] * rstd * g[2], O[dt][4 * G + 3] * rstd * g[3]);
            *(GAS v2u*)(orow + d) = wv;
        }
}
DI void cross_stage(LAS unsigned char* lds, const float* CKV, const float* gk, LAS float* RKc, int b, int ch, int kh, bool withV, int tid) {
    for (int chn = tid; chn < 128 * 16; chn += NWAVES * 64) {
        const int rr = chn >> 4, c = chn & 15; const float* src = CKV + (size_t)(b * NMEM + 128 * kh + rr) * (2 * CW) + 128 * ch + 8 * c;
        const f32x4 a0 = *(const GAS f32x4*)src, a1 = *(const GAS f32x4*)(src + 4); const f32x4 g0 = *(const f32x4*)(gk + 8 * c), g1 = *(const f32x4*)(gk + 8 * c + 4); const float rs = RKc[128 * kh + rr];
        v4u o; o.x = pk_bf16(a0[0] * rs * g0[0], a0[1] * rs * g0[1]); o.y = pk_bf16(a0[2] * rs * g0[2], a0[3] * rs * g0[3]); o.z = pk_bf16(a1[0] * rs * g1[0], a1[1] * rs * g1[1]); o.w = pk_bf16(a1[2] * rs * g1[2], a1[3] * rs * g1[3]);
        *(LAS v4u*)(lds + L_KT + rr * KSTR + c * 16) = o;
        if (withV) { const f32x4 v0 = *(const GAS f32x4*)(src + CW), v1 = *(const GAS f32x4*)(src + CW + 4);
            v4u ov; ov.x = pk_bf16(v0[0], v0[1]); ov.y = pk_bf16(v0[2], v0[3]); ov.z = pk_bf16(v1[0], v1[1]); ov.w = pk_bf16(v1[2], v1[3]);
            *(LAS v4u*)(lds + L_VT + rr * VSTR + c * 16) = ov; }
    }
}
DI void cross_unit(LAS unsigned char* lds, const float* CQ, const float* CKV, const float* gq, const float* gk, bf16* CO, int unit, int tid) {
    const int lane = tid & 63, w = __builtin_amdgcn_readfirstlane(tid >> 6), r = lane & 31, h = lane >> 5;
    const int qb = unit & 31, ch = (unit >> 5) & 3, b = unit >> 7;
    LAS unsigned char* KT = lds + L_KT; LAS unsigned char* VT = lds + L_VT; LAS float* RKc = (LAS float*)(lds + L_RK);
    const size_t qrow = (size_t)b * SEQ + 256 * qb + 32 * w + r;
    __syncthreads();
    {
        const int key = tid >> 1, half = tid & 1; const float* src = CKV + (size_t)(b * NMEM + key) * (2 * CW) + 128 * ch + 64 * half; float s = 0.f;
#pragma unroll
        for (int j = 0; j < 16; ++j) { const f32x4 v = *(const GAS f32x4*)(src + 4 * j); s += (v.x * v.x + v.y * v.y) + (v.z * v.z + v.w * v.w); }
        s += __shfl_xor(s, 1);
        if (half == 0) RKc[key] = rsqrtf(s * (1.0f / 128.0f) + EPSN);
    }
    bf16x8 qf[8];
    {
        const float* qp = CQ + qrow * CW + 128 * ch; f32x4 qv[8][2]; float s = 0.f;
#pragma unroll
        for (int ks = 0; ks < 8; ++ks) { qv[ks][0] = *(const GAS f32x4*)(qp + 16 * ks + 8 * h); qv[ks][1] = *(const GAS f32x4*)(qp + 16 * ks + 8 * h + 4);
            s += (qv[ks][0].x * qv[ks][0].x + qv[ks][0].y * qv[ks][0].y) + (qv[ks][0].z * qv[ks][0].z + qv[ks][0].w * qv[ks][0].w) + (qv[ks][1].x * qv[ks][1].x + qv[ks][1].y * qv[ks][1].y) + (qv[ks][1].z * qv[ks][1].z + qv[ks][1].w * qv[ks][1].w); }
        s += __shfl_xor(s, 32);
        const float rs = rsqrtf(s * (1.0f / 128.0f) + EPSN) * 0.08838834764831845f;
#pragma unroll
        for (int ks = 0; ks < 8; ++ks) { const f32x4 g0 = *(const f32x4*)(gq + 16 * ks + 8 * h), g1 = *(const f32x4*)(gq + 16 * ks + 8 * h + 4); const f32x4 a0 = qv[ks][0] * g0 * rs, a1 = qv[ks][1] * g1 * rs;
            qf[ks] = pack8(a0[0], a0[1], a0[2], a0[3], a1[0], a1[1], a1[2], a1[3]); }
    }
    __syncthreads();
    float mx = -3.0e38f;
    for (int kh = 0; kh < 2; ++kh) {
        if (kh) __syncthreads();
        cross_stage(lds, CKV, gk, RKc, b, ch, kh, false, tid);
        __syncthreads();
#pragma unroll 1
        for (int st = 0; st < 4; ++st) { const f32x16 s = st_tile(KT, 32 * st, qf, r, h);
#pragma unroll
            for (int i = 0; i < 16; ++i) mx = fmaxf(mx, s[i]); }
    }
    mx = fmaxf(mx, __shfl_xor(mx, 32));
    f32x16 O[4]; float lsum = 0.f;
#pragma unroll
    for (int dt = 0; dt < 4; ++dt)
#pragma unroll
        for (int i = 0; i < 16; ++i) O[dt][i] = 0.f;
    for (int kh = 0; kh < 2; ++kh) {
        __syncthreads();
        cross_stage(lds, CKV, gk, RKc, b, ch, kh, true, tid);
        __syncthreads();
#pragma unroll 1
        for (int st = 0; st < 4; ++st) {
            const f32x16 s = st_tile(KT, 32 * st, qf, r, h); float p[16];
#pragma unroll
            for (int i = 0; i < 16; ++i) { p[i] = __expf(s[i] - mx); lsum += p[i]; }
            bf16x8 pb[2];
#pragma unroll
            for (int s2 = 0; s2 < 2; ++s2) pb[s2] = pack8(p[8 * s2], p[8 * s2 + 1], p[8 * s2 + 2], p[8 * s2 + 3], p[8 * s2 + 4], p[8 * s2 + 5], p[8 * s2 + 6], p[8 * s2 + 7]);
#pragma unroll
            for (int dt = 0; dt < 4; ++dt)
#pragma unroll
                for (int s2 = 0; s2 < 2; ++s2) O[dt] = MFMA32(tr_frag(VT, VSTR, 32 * st + 16 * s2, 32 * dt, lane), pb[s2], O[dt]);
        }
    }
    lsum += __shfl_xor(lsum, 32);
    const float inv = 1.0f / lsum;
    bf16* orow = CO + qrow * CW + 128 * ch;
#pragma unroll
    for (int dt = 0; dt < 4; ++dt)
#pragma unroll
        for (int G = 0; G < 4; ++G) { const int d = 32 * dt + 8 * G + 4 * h;
            v2u wv; wv.x = pk_bf16(O[dt][4 * G] * inv, O[dt][4 * G + 1] * inv); wv.y = pk_bf16(O[dt][4 * G + 2] * inv, O[dt][4 * G + 3] * inv); *(GAS v2u*)(orow + d) = wv; }
}
DI void ffn_act(const bf16* U, bf16* ACT, const float* cw, const float* cb, int half, int gt, int NT) {
    constexpr int NC = DFF / 8, RB = 16, NRB = SEQ / RB;
    for (int it = gt; it < NRB * NC; it += NT) {
        const int cc = it % NC, rb = it / NC, n0 = 8 * cc, t0 = rb * RB;
        float wg[3][8], wv[3][8], bg[8], bv[8];
#pragma unroll
        for (int j = 0; j < 3; ++j)
#pragma unroll
            for (int e = 0; e < 8; ++e) { wg[j][e] = cw[(size_t)j * DFF2 + n0 + e]; wv[j][e] = cw[(size_t)j * DFF2 + DFF + n0 + e]; }
#pragma unroll
        for (int e = 0; e < 8; ++e) { bg[e] = cb[n0 + e]; bv[e] = cb[DFF + n0 + e]; }
        float g1[8], g2[8], v1[8], v2[8];
#pragma unroll
        for (int e = 0; e < 8; ++e) { g1[e] = g2[e] = v1[e] = v2[e] = 0.f; }
        for (int tt = -2; tt < RB; ++tt) {
            const int t = t0 + tt; float gc[8], vc[8];
            if (t >= 0) { const v4u a = *(const GAS v4u*)(U + (size_t)t * DFF2 + n0), bq = *(const GAS v4u*)(U + (size_t)t * DFF2 + DFF + n0);
                const unsigned aw[4] = {a.x, a.y, a.z, a.w}, bw[4] = {bq.x, bq.y, bq.z, bq.w};
#pragma unroll
                for (int e = 0; e < 4; ++e) { gc[2 * e] = bf2f((unsigned short)(aw[e] & 0xffff)); gc[2 * e + 1] = bf2f((unsigned short)(aw[e] >> 16)); vc[2 * e] = bf2f((unsigned short)(bw[e] & 0xffff)); vc[2 * e + 1] = bf2f((unsigned short)(bw[e] >> 16)); }
            } else {
#pragma unroll
                for (int e = 0; e < 8; ++e) { gc[e] = 0.f; vc[e] = 0.f; } }
            if (tt >= 0) {
                float o[8];
#pragma unroll
                for (int e = 0; e < 8; ++e) { const float cg = bg[e] + wg[0][e] * g2[e] + wg[1][e] * g1[e] + wg[2][e] * gc[e], cv = bv[e] + wv[0][e] * v2[e] + wv[1][e] * v1[e] + wv[2][e] * vc[e];
                    o[e] = cg * __builtin_amdgcn_rcpf(1.0f + __expf(-cg)) * cv; }
                v4u ov; ov.x = pk_bf16(o[0], o[1]); ov.y = pk_bf16(o[2], o[3]); ov.z = pk_bf16(o[4], o[5]); ov.w = pk_bf16(o[6], o[7]);
                *(GAS v4u*)(ACT + ((size_t)half * SEQ + t) * DFF + n0) = ov;
            }
#pragma unroll
            for (int e = 0; e < 8; ++e) { g2[e] = g1[e]; g1[e] = gc[e]; v2[e] = v1[e]; v1[e] = vc[e]; }
        }
    }
}
struct Args { Ptrs p; int ph_lo, ph_hi; };
constexpr int N_PHASES = 14;
__global__ void __launch_bounds__(NWAVES * 64, 2) mk_fwd(Args args) {
    extern __shared__ __attribute__((aligned(16))) unsigned char lds_raw[];
    LAS unsigned char* lds = (LAS unsigned char*)lds_raw;
    volatile LAS unsigned* MISC = (volatile LAS unsigned*)(lds + MISC_OFF);
    const int tid = threadIdx.x, lane = tid & 63, wave = __builtin_amdgcn_readfirstlane(tid >> 6);
    const int G = gridDim.x, bx = blockIdx.x;
    const Ptrs& P = args.p; unsigned char* ws = P.ws;
    gu32* ctl = (gu32*)(ws + WS_CTL);
    for (int u = tid; u < (LDS_BYTES - LDSCTL_OFF) / 4; u += NWAVES * 64) ((LAS unsigned*)(lds + LDSCTL_OFF))[u] = 0u;
    __syncthreads();
    XcdBarrier bar = xcd_barrier_post((unsigned*)(ctl + CW_BAR), MISC + 8);
    const int lo = args.ph_lo, hi = args.ph_hi;
#ifndef PHMASK
#define PHMASK 0xffff
#endif
#define IN(k) (((PHMASK >> (k)) & 1) && lo <= (k) && (k) < hi)
#define SEAM(k) do { if (IN(k) && IN((k) + 1)) xcd_barrier(bar); } while (0)
    bf16* HB = (bf16*)(ws + WS_HB); bf16* PROJ = (bf16*)(ws + WS_PROJ);
    const int gw = bx * NWAVES + wave, NGW = G * NWAVES, gt = bx * NWAVES * 64 + tid, NT = G * NWAVES * 64;

    if (IN(0)) { p0_prologue(P, lds, gw, NGW, wave, lane); }
    SEAM(0);
    if (IN(1)) {
        pg8::Gemm g{HB, (const bf16*)(ws + WS_WIN), M, INW, DM, DM}; pg8::StaticOrder S; S.init(M, INW, G, bx);
        pg8::EpiProj E{PROJ, (const float*)(ws + WS_SSQ0), (const float*)(ws + WS_COS), (const float*)(ws + WS_SIN), P.sbq_norm, P.sbk_norm, (float*)(ws + WS_SSQSB)};
        pg8::gemm_phase<pg8::EpiProj, pg8::StaticOrder, true, true>(lds, g, S, E);
    }
    SEAM(1);
    if (IN(2)) { for (int u = bx; u < 2048; u += G) ret_kv_unit(lds, PROJ, (float*)(ws + WS_KV), u, tid); }
    SEAM(2);
    if (IN(3)) { ret_scan((const float*)(ws + WS_KV), (bf16*)(ws + WS_ST), gt, NT); }
    SEAM(3);
    if (IN(4)) {
        for (int u = bx; u < 1024; u += G) sb_unit(lds, PROJ, (const float*)(ws + WS_SSQSB), P.sbo_norm, u, tid);
        for (int u = bx; u < 2048; u += G) ret_out_unit(lds, PROJ, (const bf16*)(ws + WS_ST), P.ret_norm, u, tid);
        __syncthreads();
    }
    SEAM(4);
    if (IN(5)) {
        pg8::Gemm g{PROJ, (const bf16*)(ws + WS_WOUT), M, DM, DM, INW}; pg8::StaticOrder S; S.init(M, DM, G, bx);
        pg8::EpiRes<true> E{P.x, P.out, HB, (float*)(ws + WS_SSQ1)};
        pg8::gemm_phase<pg8::EpiRes<true>, pg8::StaticOrder, true, true>(lds, g, S, E);
    }
    SEAM(5);
    if (IN(6)) {
        { pg8::Gemm g{HB, (const bf16*)(ws + WS_WQKV), M, CW, DM, DM}; pg8::StaticOrder S; S.init(M, CW, G, bx);
          pg8::EpiScaleF32 E{(float*)(ws + WS_CQ), CW, (const float*)(ws + WS_SSQ1)};
          pg8::gemm_phase<pg8::EpiScaleF32, pg8::StaticOrder, true, true>(lds, g, S, E); }
        __syncthreads();
        { pg8::Gemm g{(const bf16*)(ws + WS_MB), (const bf16*)(ws + WS_WQKV) + (size_t)CW * DM, BATCH * NMEM, 2 * CW, DM, DM}; pg8::StaticOrder S; S.init(BATCH * NMEM, 2 * CW, G, (bx + G / 2) % G);
          pg8::EpiScaleF32 E{(float*)(ws + WS_CKV), 2 * CW, (const float*)(ws + WS_SSQM)};
          pg8::gemm_phase<pg8::EpiScaleF32, pg8::StaticOrder, true, true>(lds, g, S, E); }
    }
    SEAM(6);
    if (IN(7)) { for (int u = bx; u < 256; u += G) cross_unit(lds, (const float*)(ws + WS_CQ), (const float*)(ws + WS_CKV), P.cq_norm, P.ck_norm, (bf16*)(ws + WS_CO), u, tid); __syncthreads(); }
    SEAM(7);
    if (IN(8)) {
        pg8::Gemm g{(const bf16*)(ws + WS_CO), (const bf16*)(ws + WS_WO), M, DM, CW, CW}; pg8::StaticOrder S; S.init(M, DM, G, bx);
        pg8::EpiRes<true> E{P.out, P.out, HB, (float*)(ws + WS_SSQ2)};
        pg8::gemm_phase<pg8::EpiRes<true>, pg8::StaticOrder, true, true>(lds, g, S, E);
    }
    SEAM(8);
    if (IN(9)) {
        pg8::Gemm g{HB, (const bf16*)(ws + WS_WUP), SEQ, DFF2, DM, DM}; pg8::StaticOrder S; S.init(SEQ, DFF2, G, bx, 0);
        pg8::EpiScaleBf16 E{(bf16*)(ws + WS_U), DFF2, (const float*)(ws + WS_SSQ2)};
        pg8::gemm_phase<pg8::EpiScaleBf16, pg8::StaticOrder, true, true>(lds, g, S, E);
    }
    SEAM(9);
    if (IN(10)) { ffn_act((const bf16*)(ws + WS_U), (bf16*)(ws + WS_ACT), P.conv_w, P.conv_b, 0, gt, NT); }
    SEAM(10);
    if (IN(11)) {
        pg8::Gemm g{HB, (const bf16*)(ws + WS_WUP), SEQ, DFF2, DM, DM}; pg8::StaticOrder S; S.init(SEQ, DFF2, G, bx, SEQ / 256);
        pg8::EpiScaleBf16 E{(bf16*)(ws + WS_U) - (size_t)SEQ * DFF2, DFF2, (const float*)(ws + WS_SSQ2)};
        pg8::gemm_phase<pg8::EpiScaleBf16, pg8::StaticOrder, true, true>(lds, g, S, E);
    }
    SEAM(11);
    if (IN(12)) { ffn_act((const bf16*)(ws + WS_U), (bf16*)(ws + WS_ACT), P.conv_w, P.conv_b, 1, gt, NT); }
    SEAM(12);
    if (IN(13)) {
        pg8::Gemm g{(const bf16*)(ws + WS_ACT), (const bf16*)(ws + WS_WDOWN), M, DM, DFF, DFF}; pg8::StaticOrder S; S.init(M, DM, G, bx);
        pg8::EpiRes<false> E{P.out, P.out, nullptr, nullptr};
        pg8::gemm_phase<pg8::EpiRes<false>, pg8::StaticOrder, true, true>(lds, g, S, E);
    }
#undef IN
#undef SEAM
}

#ifndef MK_CUTS
#define MK_CUTS 0
#endif
extern "C" void kernel_launch(void* const* d_in, const int* in_sizes, int n_in, void* d_out, int out_size, void* d_ws, size_t ws_size, hipStream_t stream) {
    static int grid = 0;
    if (grid == 0) {
        if (n_in != 21 || in_sizes[0] != M * DM || out_size != M * DM || ws_size < WS_END) { fprintf(stderr, "kernel_launch: unexpected shapes (n_in %d, in0 %d, out %d, ws %zu < %zu); nothing launched\n", n_in, n_in > 0 ? in_sizes[0] : -1, out_size, ws_size, (size_t)WS_END); grid = -1; return; }
        int dev = 0, cus = 0, per_cu = 0;
        if (hipGetDevice(&dev) != hipSuccess || hipDeviceGetAttribute(&cus, hipDeviceAttributeMultiprocessorCount, dev) != hipSuccess) { grid = -1; return; }
        if (hipFuncSetAttribute((const void*)mk_fwd, hipFuncAttributeMaxDynamicSharedMemorySize, LDS_BYTES) != hipSuccess) { fprintf(stderr, "kernel_launch: hipFuncSetAttribute failed\n"); grid = -1; return; }
        if (hipOccupancyMaxActiveBlocksPerMultiprocessor(&per_cu, (const void*)mk_fwd, NWAVES * 64, LDS_BYTES) != hipSuccess || per_cu < 1) fprintf(stderr, "kernel_launch: note: occupancy query reports %d\n", per_cu);
        (void)hipGetLastError();
        grid = cus;
    }
    if (grid < 0) return;
    if (hipMemsetAsync((char*)d_ws + WS_CTL, 0, CTL_ZERO_BYTES, stream) != hipSuccess) return;
    Args a{};
    const float** pp = (const float**)&a.p;
    for (int i = 0; i < 21; ++i) pp[i] = (const float*)d_in[i];
    a.p.out = (float*)d_out; a.p.ws = (unsigned char*)d_ws;
#if MK_CUTS
    for (int ph = 0; ph < N_PHASES; ++ph) { a.ph_lo = ph; a.ph_hi = ph + 1; hipLaunchKernelGGL(mk_fwd, dim3(grid), dim3(NWAVES * 64), LDS_BYTES, stream, a); }
#else
    a.ph_lo = 0; a.ph_hi = N_PHASES;
    hipLaunchKernelGGL(mk_fwd, dim3(grid), dim3(NWAVES * 64), LDS_BYTES, stream, a);
#endif
    const hipError_t le = hipPeekAtLastError();
    if (le != hipSuccess) fprintf(stderr, "kernel_launch: launch failed: %s\n", hipGetErrorName(le));
}
```

```cpp
#include <hip/hip_runtime.h>
#include <cstdio>
#include <cstdint>
namespace pg8 {
#define PG8_LAS __attribute__((address_space(3)))
typedef unsigned short bf16_t;
typedef short bf16x8 __attribute__((ext_vector_type(8)));
typedef float f32x4 __attribute__((ext_vector_type(4)));
typedef unsigned u32x4 __attribute__((ext_vector_type(4)));
typedef unsigned u32x2 __attribute__((ext_vector_type(2)));
constexpr int BM = 256, BK = 64, HALF = 128, HTB = HALF * BK * 2  , STAGE_BYTES = 8 * HTB, NXCD = 8, WGM = 8;

__host__ __device__ __forceinline__ int lds_byte(int r, int c) { const int st = (r >> 4) * 2 + (c >> 5), rr = r & 15, cc = c & 31, ob = rr * 64 + cc * 2; return st * 1024 + (ob ^ (((ob >> 9) & 1) << 5)); }
__host__ __device__ __forceinline__ void stage_rc(int b, int& R, int& C) { const int st = b / 1024, sb = b % 1024, swz = sb ^ (((sb >> 9) & 1) << 5); R = (st >> 1) * 16 + swz / 64; C = (st & 1) * 32 + (swz % 64) / 2; }
__host__ __device__ __forceinline__ int perm32(int rho) { const int n = rho >> 4, i = rho & 15; return 8 * (i >> 2) + 4 * n + (i & 3); }
template <int PERM> __host__ __device__ __forceinline__ int permrow(int R) {
    if (PERM == 1) return (R & ~31) + perm32(R & 31);
    if (PERM == 2) return 64 * ((R >> 4) & 1) + 16 * (R >> 5) + (R & 15);
    return R;
}

struct Unit { int pm, pn; };
struct Gemm { const bf16_t* A; const bf16_t* Bt; int M, N, K, lda; };

struct StaticOrder {
    int nM, nN, nwg, G, c, pm0;
    __host__ __device__ void init(int M, int N, int G_, int c_, int pm0_ = 0) { nM = M / BM; nN = N / BM; nwg = nM * nN; G = G_; c = c_; pm0 = pm0_; }
    __host__ __device__ bool next(int i, Unit& u) const {
        const long L = (long)i * G + c; if (L >= nwg) return false;
        int wgid = (int)L; { const int q = nwg / NXCD, r = nwg % NXCD, xcd = wgid % NXCD, off = wgid / NXCD; wgid = (xcd < r ? xcd * (q + 1) : r * (q + 1) + (xcd - r) * q) + off; }
        const int nig = WGM * nN, gid = wgid / nig, fm = gid * WGM, gsz = (nM - fm) < WGM ? (nM - fm) : WGM;
        u.pm = pm0 + fm + ((wgid % nig) % gsz); u.pn = (wgid % nig) / gsz; return true;
    }
    __device__ __forceinline__ void a_ready(const Unit&) const {}
    __device__ __forceinline__ void done(const Unit&) const {}
};

typedef float f32x2 __attribute__((ext_vector_type(2)));
typedef __bf16 bf16v2 __attribute__((ext_vector_type(2)));
__device__ __forceinline__ unsigned pk_bf16(float lo, float hi) { const f32x2 f = {lo, hi}; const bf16v2 r = __builtin_convertvector(f, bf16v2); return __builtin_bit_cast(unsigned, r); }
constexpr float EPSN = 1e-6f;
__constant__ float LOGG[16] = { -3.174869716e-02f, -1.574835740e-02f, -7.843177766e-03f, -3.913899418e-03f, -1.955034910e-03f, -9.770396864e-04f, -4.884005175e-04f, -2.441704273e-04f,
                                -1.220777631e-04f, -6.103701890e-05f, -3.051804379e-05f, -1.525890548e-05f, -7.629423635e-06f, -3.814704542e-06f, -1.907350452e-06f, -9.536747712e-07f };
__device__ __forceinline__ float hsum4(const f32x4 v) { return (v[0] + v[1]) + (v[2] + v[3]); }
__device__ __forceinline__ float dot4(const f32x4 a, const f32x4 b) { return (a[0] * b[0] + a[1] * b[1]) + (a[2] * b[2] + a[3] * b[3]); }
__device__ __forceinline__ float row_rstd64(const float* part, int row, int fq, float invn) {
    const f32x4* p = (const f32x4*)(part + (size_t)row * 64 + fq * 16);
    float s = (hsum4(p[0]) + hsum4(p[1])) + (hsum4(p[2]) + hsum4(p[3]));
    s += __shfl_xor(s, 16); s += __shfl_xor(s, 32);
    return rsqrtf(s * invn + EPSN);
}

#define EPI_FENCE() asm volatile("" ::: "memory")
struct EpiProj {
    static constexpr int PERM = 2; static constexpr bool AFTER_DRAIN = false;
    bf16_t* P; const float* ssq0; const float* cosT; const float* sinT; const float* gq; const float* gk; float* ssqsb;
    template <int REG> __device__ __forceinline__ void body(const f32x4 (&acc)[2][2][4][2], const Unit& u, int wr, int wc, int fr, int fq) const {
        constexpr bool ROPE = (REG == 0 || REG == 2);
        const int pnr = u.pn & 7, d0 = 16 * wc + 4 * fq, rowb = u.pm * BM + wr * 64 + fr;
        float lg[2] = {0.f, 0.f}; f32x4 g0 = {1.f, 1.f, 1.f, 1.f}, g1 = g0;
        if (ROPE) { lg[0] = LOGG[2 * pnr]; lg[1] = LOGG[2 * pnr + 1]; }
        if (REG == 1 || REG == 5) { const float* g = (REG == 1) ? gq : gk; g0 = *(const f32x4*)(g + d0); g1 = *(const f32x4*)(g + 64 + d0); }
        float rsv[8];
#pragma unroll
        for (int g = 0; g < 8; ++g) rsv[g] = ssq0[rowb + (g >> 2) * HALF + (g & 3) * 16];
        f32x4 csn = {0.f, 0.f, 0.f, 0.f}, snn = csn;
        if (ROPE) { const int t = rowb & 8191; csn = *(const f32x4*)(cosT + (size_t)t * 64 + d0); snn = *(const f32x4*)(sinT + (size_t)t * 64 + d0); }
        EPI_FENCE();
#pragma unroll
        for (int g = 0; g < 8; ++g) {
            const int ai = g >> 2, m = g & 3;
            const int row = rowb + ai * HALF + m * 16;
            const float rs = rsqrtf(rsv[g] * (1.0f / 4096.0f) + EPSN);
            const int t = row & 8191; const float cpos = (float)(t & 127);
            const f32x4 cs = csn, sn = snn;
            if (ROPE && g < 7) { const int tn = (rowb + ((g + 1) >> 2) * HALF + ((g + 1) & 3) * 16) & 8191; csn = *(const f32x4*)(cosT + (size_t)tn * 64 + d0); snn = *(const f32x4*)(sinT + (size_t)tn * 64 + d0); }
            EPI_FENCE();
            bf16_t* rowp = P + (size_t)row * 14336 + u.pn * BM + d0;
#pragma unroll
            for (int bj = 0; bj < 2; ++bj) {
                const f32x4 v0 = acc[ai][bj][m][0] * rs, v1 = acc[ai][bj][m][1] * rs;
                f32x4 o0 = v0, o1 = v1;
                if (REG == 0) { const float sc = 0.08838834764831845f * __expf(cpos * lg[bj]); o0 = (v0 * cs - v1 * sn) * sc; o1 = (v1 * cs + v0 * sn) * sc; }
                if (REG == 2) { const float sc = __expf(-cpos * lg[bj]); o0 = (v0 * cs - v1 * sn) * sc; o1 = (v1 * cs + v0 * sn) * sc; }
                if (REG == 4) {
#pragma unroll
                    for (int j = 0; j < 4; ++j) { o0[j] = v0[j] * __builtin_amdgcn_rcpf(1.0f + __expf(-v0[j])); o1[j] = v1[j] * __builtin_amdgcn_rcpf(1.0f + __expf(-v1[j])); } }
                if (REG == 1 || REG == 5) {
                    float s = dot4(v0, v0) + dot4(v1, v1); s += __shfl_xor(s, 16); s += __shfl_xor(s, 32);
                    if (fq == 0) ssqsb[((size_t)row * 32 + (REG == 1 ? 0 : 16) + 2 * pnr + bj) * 4 + wc] = s;
                    o0 = v0 * g0; o1 = v1 * g1; }
                u32x2 w0, w1; w0.x = pk_bf16(o0[0], o0[1]); w0.y = pk_bf16(o0[2], o0[3]); w1.x = pk_bf16(o1[0], o1[1]); w1.y = pk_bf16(o1[2], o1[3]);
                *(u32x2*)(rowp + bj * HALF) = w0; *(u32x2*)(rowp + bj * HALF + 64) = w1;
            }
        }
    }
    __device__ __forceinline__ void operator()(const f32x4 (&acc)[2][2][4][2], const Unit& u, int wr, int wc, int fr, int fq) const {
        const int reg = u.pn >> 3;
        if (reg == 0) body<0>(acc, u, wr, wc, fr, fq); else if (reg == 1) body<1>(acc, u, wr, wc, fr, fq); else if (reg == 2) body<2>(acc, u, wr, wc, fr, fq);
        else if (reg == 4) body<4>(acc, u, wr, wc, fr, fq); else if (reg == 5) body<5>(acc, u, wr, wc, fr, fq); else body<3>(acc, u, wr, wc, fr, fq);
    }
};

template <bool WITH_HB> struct EpiRes {
    static constexpr int PERM = 1; static constexpr bool AFTER_DRAIN = false;
    const float* base; float* out; bf16_t* hb; float* ssq;
    __device__ __forceinline__ void operator()(const f32x4 (&acc)[2][2][4][2], const Unit& u, int wr, int wc, int fr, int fq) const {
        const int col0 = u.pn * BM + wc * 32 + 8 * fq, rowb = u.pm * BM + wr * 64 + fr;
        f32x4 bn[2][2];
#pragma unroll
        for (int bj = 0; bj < 2; ++bj) { const size_t off = (size_t)rowb * 4096 + col0 + bj * HALF; bn[bj][0] = *(const f32x4*)(base + off); bn[bj][1] = *(const f32x4*)(base + off + 4); }
#pragma unroll
        for (int g = 0; g < 8; ++g) {
            const int ai = g >> 2, m = g & 3, row = rowb + ai * HALF + m * 16; float s = 0.f;
            f32x4 b[2][2];
#pragma unroll
            for (int bj = 0; bj < 2; ++bj) { b[bj][0] = bn[bj][0]; b[bj][1] = bn[bj][1]; }
            if (g < 7) { const int rown = rowb + ((g + 1) >> 2) * HALF + ((g + 1) & 3) * 16;
#pragma unroll
                for (int bj = 0; bj < 2; ++bj) { const size_t off = (size_t)rown * 4096 + col0 + bj * HALF; bn[bj][0] = *(const f32x4*)(base + off); bn[bj][1] = *(const f32x4*)(base + off + 4); } }
            EPI_FENCE();
#pragma unroll
            for (int bj = 0; bj < 2; ++bj) {
                const size_t off = (size_t)row * 4096 + col0 + bj * HALF;
                const f32x4 o0 = b[bj][0] + acc[ai][bj][m][0], o1 = b[bj][1] + acc[ai][bj][m][1];
                *(f32x4*)(out + off) = o0; *(f32x4*)(out + off + 4) = o1;
                if (WITH_HB) { u32x4 w; w.x = pk_bf16(o0[0], o0[1]); w.y = pk_bf16(o0[2], o0[3]); w.z = pk_bf16(o1[0], o1[1]); w.w = pk_bf16(o1[2], o1[3]); *(u32x4*)(hb + off) = w; s += dot4(o0, o0) + dot4(o1, o1); }
            }
            if (WITH_HB) { s += __shfl_xor(s, 16); s += __shfl_xor(s, 32); if (fq == 0) __hip_atomic_fetch_add(ssq + row, s, __ATOMIC_RELAXED, __HIP_MEMORY_SCOPE_AGENT); }
            EPI_FENCE();
        }
    }
};

struct EpiScaleF32 {
    static constexpr int PERM = 1; static constexpr bool AFTER_DRAIN = false;
    float* C; int ldc; const float* ssq;
    __device__ __forceinline__ void operator()(const f32x4 (&acc)[2][2][4][2], const Unit& u, int wr, int wc, int fr, int fq) const {
        const int col0 = u.pn * BM + wc * 32 + 8 * fq, rowb = u.pm * BM + wr * 64 + fr;
        float rsv[8];
#pragma unroll
        for (int g = 0; g < 8; ++g) rsv[g] = ssq[rowb + (g >> 2) * HALF + (g & 3) * 16];
        EPI_FENCE();
#pragma unroll
        for (int g = 0; g < 8; ++g) {
            const int ai = g >> 2, m = g & 3, row = rowb + ai * HALF + m * 16; const float rs = rsqrtf(rsv[g] * (1.0f / 4096.0f) + EPSN);
#pragma unroll
            for (int bj = 0; bj < 2; ++bj) { float* p = C + (size_t)row * ldc + col0 + bj * HALF; *(f32x4*)p = acc[ai][bj][m][0] * rs; *(f32x4*)(p + 4) = acc[ai][bj][m][1] * rs; }
        }
    }
};
struct EpiScaleBf16 {
    static constexpr int PERM = 1; static constexpr bool AFTER_DRAIN = false;
    bf16_t* O; int ldc; const float* ssq;
    __device__ __forceinline__ void operator()(const f32x4 (&acc)[2][2][4][2], const Unit& u, int wr, int wc, int fr, int fq) const {
        const int col0 = u.pn * BM + wc * 32 + 8 * fq, rowb = u.pm * BM + wr * 64 + fr;
        float rsv[8];
#pragma unroll
        for (int g = 0; g < 8; ++g) rsv[g] = ssq[rowb + (g >> 2) * HALF + (g & 3) * 16];
        EPI_FENCE();
#pragma unroll
        for (int g = 0; g < 8; ++g) {
            const int ai = g >> 2, m = g & 3, row = rowb + ai * HALF + m * 16; const float rs = rsqrtf(rsv[g] * (1.0f / 4096.0f) + EPSN);
#pragma unroll
            for (int bj = 0; bj < 2; ++bj) { const f32x4 v0 = acc[ai][bj][m][0] * rs, v1 = acc[ai][bj][m][1] * rs;
                u32x4 w; w.x = pk_bf16(v0[0], v0[1]); w.y = pk_bf16(v0[2], v0[3]); w.z = pk_bf16(v1[0], v1[1]); w.w = pk_bf16(v1[2], v1[3]);
                *(u32x4*)(O + (size_t)row * ldc + col0 + bj * HALF) = w; }
        }
    }
};

__device__ __forceinline__ float dpp_ror1(float x) { return __builtin_bit_cast(float, __builtin_amdgcn_update_dpp(0, __builtin_bit_cast(int, x), 0x121, 0xf, 0xf, false)); }
__device__ __forceinline__ float dpp_ror2(float x) { return __builtin_bit_cast(float, __builtin_amdgcn_update_dpp(0, __builtin_bit_cast(int, x), 0x122, 0xf, 0xf, false)); }
struct EpiFfn {
    static constexpr int PERM = 1; static constexpr bool AFTER_DRAIN = false;
    bf16_t* ACT; bf16_t* UB; const float* ssq; const float* cw; const float* cb; PG8_LAS float* wl;
    static constexpr int DFF = 11008;
    __device__ __forceinline__ void operator()(const f32x4 (&acc)[2][2][4][2], const Unit& u, int wr, int wc, int fr, int fq) const {
        const int cc0 = 32 * wc + 8 * fq, colg = u.pn * HALF + cc0, rowb = u.pm * BM + wr * 64 + fr;
        float rs[8];
#pragma unroll
        for (int g = 0; g < 8; ++g) rs[g] = ssq[rowb + (g >> 2) * HALF + (g & 3) * 16];
        {
            f32x4 wv[2][4][2];
#pragma unroll
            for (int bj = 0; bj < 2; ++bj)
#pragma unroll
                for (int t = 0; t < 4; ++t)
#pragma unroll
                    for (int n = 0; n < 2; ++n) { const int col = bj * DFF + colg + 4 * n; wv[bj][t][n] = (t < 3) ? *(const f32x4*)(cw + (size_t)t * (2 * DFF) + col) : *(const f32x4*)(cb + col); }
            EPI_FENCE();
#pragma unroll
            for (int bj = 0; bj < 2; ++bj)
#pragma unroll
                for (int t = 0; t < 4; ++t)
#pragma unroll
                    for (int n = 0; n < 2; ++n) *(PG8_LAS f32x4*)(wl + (bj * 4 + t) * 32 + 8 * fq + 4 * n) = wv[bj][t][n];
        }
#pragma unroll
        for (int g = 0; g < 8; ++g) rs[g] = rsqrtf(rs[g] * (1.0f / 4096.0f) + EPSN);
        asm volatile("s_waitcnt lgkmcnt(0)" ::: "memory");
#pragma unroll
        for (int n = 0; n < 2; ++n) {
#pragma unroll
            for (int ai = 0; ai < 2; ++ai) {
                const int row0 = rowb + ai * HALF, blk = (u.pm * BM + ai * HALF + wr * 64) >> 6;
                f32x4 sg[4];
#pragma unroll
                for (int bj = 0; bj < 2; ++bj) {
                    const PG8_LAS float* wp = wl + (bj * 4) * 32 + 8 * fq + 4 * n;
                    const f32x4 w0 = *(const PG8_LAS f32x4*)(wp), w1 = *(const PG8_LAS f32x4*)(wp + 32), w2 = *(const PG8_LAS f32x4*)(wp + 64), bb = *(const PG8_LAS f32x4*)(wp + 96);
                    f32x4 pr1 = {0.f, 0.f, 0.f, 0.f}, pr2 = pr1;
#pragma unroll
                    for (int m = 0; m < 4; ++m) {
                        const f32x4 x = acc[ai][bj][m][n] * rs[ai * 4 + m]; f32x4 r1, r2;
#pragma unroll
                        for (int j = 0; j < 4; ++j) { r1[j] = dpp_ror1(x[j]); r2[j] = dpp_ror2(x[j]); }
                        const f32x4 p1 = (m == 0) ? r1 : ((fr == 0) ? pr1 : r1);
                        const f32x4 p2 = (m == 0) ? r2 : ((fr < 2) ? pr2 : r2);
                        const f32x4 c = bb + w2 * x + w1 * p1 + w0 * p2;
                        pr1 = r1; pr2 = r2;
                        if (bj == 0) {
#pragma unroll
                            for (int j = 0; j < 4; ++j) sg[m][j] = c[j] * __builtin_amdgcn_rcpf(1.0f + __expf(-c[j])); }
                        else {
                            const f32x4 o = sg[m] * c; u32x2 pkd; pkd.x = pk_bf16(o[0], o[1]); pkd.y = pk_bf16(o[2], o[3]);
                            if (m > 0 || fr >= 2) *(u32x2*)(ACT + (size_t)(row0 + 16 * m) * DFF + colg + 4 * n) = pkd;
                        }
                        if (m == 0 || m == 3) {
                            const bool sel = (m == 0) ? (fr < 2) : (fr >= 14); const int slot = (m == 0) ? fr : 2 + (fr - 14);
                            if (sel) { u32x2 rw; rw.x = pk_bf16(x[0], x[1]); rw.y = pk_bf16(x[2], x[3]); *(u32x2*)(UB + ((size_t)blk * 4 + slot) * (2 * DFF) + bj * DFF + colg + 4 * n) = rw; }
                        }
                        __builtin_amdgcn_sched_barrier(0);
                    }
                }
            }
        }
    }
};

template <class Epi, class Sched, bool ALIGN_EPI = false, bool SP2 = false>
__device__ __forceinline__ void gemm_phase(PG8_LAS unsigned char* lds, const Gemm g, const Sched& S, const Epi& E) {
    const int tid = threadIdx.x, wid = __builtin_amdgcn_readfirstlane(tid >> 6), lane = tid & 63, wr = wid >> 2, wc = wid & 3, fr = lane & 15, fq = lane >> 4;
    const int K = g.K, nt = K / BK;
    unsigned voffA[2], voffB[2];
#pragma unroll
    for (int i = 0; i < 2; ++i) { int R, C; stage_rc(tid * 16 + i * 8192, R, C); const int Rb = permrow<Epi::PERM>(R);
        voffA[i] = (unsigned)(R * g.lda + C) * 2u; voffB[i] = (unsigned)(Rb * K + C) * 2u; }
    const size_t kstep = (size_t)(BK * 2);
    const size_t hstep = (size_t)HALF * K * 2;
    const size_t tstep = 2 * hstep;
    const size_t hstepA = (size_t)HALF * g.lda * 2, tstepA = 2 * hstepA;
    const unsigned ldsw = (unsigned)wid * 1024u;
    const int aoff = lds_byte(wr * 64 + fr, fq * 8), boff = lds_byte(wc * 32 + fr, fq * 8);
#define PG8_SA(b, h) (((b) * 2 + (h)) * HTB)
#define PG8_SB(b, h) ((4 + (b) * 2 + (h)) * HTB)
#define PG8_STAGE(bufoff, gbase, voff) do { _Pragma("unroll") for (int _i = 0; _i < 2; ++_i) \
        __builtin_amdgcn_global_load_lds((const unsigned*)((const char*)(gbase) + (voff)[_i]), (PG8_LAS unsigned*)(lds + (bufoff) + ldsw + _i * 8192), 16, 0, 0); } while (0)
#define PG8_LDA(dst, b, h) do { _Pragma("unroll") for (int m = 0; m < 4; ++m) _Pragma("unroll") for (int k = 0; k < 2; ++k) dst[m][k] = *(const PG8_LAS bf16x8*)(lds + PG8_SA(b, h) + aoff + m * 2048 + k * 1024); } while (0)
#define PG8_LDB(dst, b, h) do { _Pragma("unroll") for (int n = 0; n < 2; ++n) _Pragma("unroll") for (int k = 0; k < 2; ++k) dst[n][k] = *(const PG8_LAS bf16x8*)(lds + PG8_SB(b, h) + boff + n * 2048 + k * 1024); } while (0)
#define PG8_MMA(ai, bj, At, Bt) do { __builtin_amdgcn_s_setprio(1); _Pragma("unroll") for (int m = 0; m < 4; ++m) _Pragma("unroll") for (int n = 0; n < 2; ++n) _Pragma("unroll") for (int k = 0; k < 2; ++k) \
        acc[ai][bj][m][n] = __builtin_amdgcn_mfma_f32_16x16x32_bf16(Bt[n][k], At[m][k], acc[ai][bj][m][n], 0, 0, 0); __builtin_amdgcn_s_setprio(0); } while (0)
#define PG8_WAIT_V(n) asm volatile("s_waitcnt vmcnt(" #n ")" ::: "memory")
#define PG8_WAIT_L(n) asm volatile("s_waitcnt lgkmcnt(" #n ")" ::: "memory")
#define PG8_BAR __builtin_amdgcn_s_barrier()
#define PG8_SCHED __builtin_amdgcn_sched_barrier(0)
    Unit cur, nxt; int ui = 0;
    if (!S.next(0, cur)) return;
    f32x4 acc[2][2][4][2];
#pragma unroll
    for (int a = 0; a < 2; ++a)
#pragma unroll
        for (int b = 0; b < 2; ++b)
#pragma unroll
            for (int m = 0; m < 4; ++m)
#pragma unroll
                for (int n = 0; n < 2; ++n) acc[a][b][m][n] = (f32x4){0.f, 0.f, 0.f, 0.f};
    bf16x8 At[4][2], B0[2][2], B1[2][2];
    const char* cA = (const char*)g.A + (size_t)cur.pm * tstepA; const char* cB = (const char*)g.Bt + (size_t)cur.pn * tstep;
    S.a_ready(cur);
    if constexpr (SP2) {
        PG8_STAGE(PG8_SB(0, 0), cB, voffB); PG8_STAGE(PG8_SB(0, 1), cB + hstep, voffB); PG8_STAGE(PG8_SA(0, 0), cA, voffA); PG8_STAGE(PG8_SA(0, 1), cA + hstepA, voffA);
        if (wr == 1) PG8_BAR;
        PG8_WAIT_V(2); PG8_BAR;
        PG8_STAGE(PG8_SB(1, 0), cB + kstep, voffB); PG8_STAGE(PG8_SA(1, 0), cA + kstep, voffA); PG8_STAGE(PG8_SB(1, 1), cB + hstep + kstep, voffB);
        PG8_WAIT_V(6); PG8_BAR;
    } else {
        PG8_STAGE(PG8_SB(0, 0), cB, voffB); PG8_STAGE(PG8_SA(0, 0), cA, voffA); PG8_STAGE(PG8_SB(0, 1), cB + hstep, voffB); PG8_STAGE(PG8_SA(0, 1), cA + hstepA, voffA);
        if (wr == 1) PG8_BAR;
        PG8_WAIT_V(4); PG8_BAR;
        PG8_STAGE(PG8_SB(1, 0), cB + kstep, voffB); PG8_STAGE(PG8_SA(1, 0), cA + kstep, voffA); PG8_STAGE(PG8_SB(1, 1), cB + hstep + kstep, voffB);
        PG8_WAIT_V(6); PG8_BAR;
    }
    for (;;) {
        const bool has_next = S.next(ui + 1, nxt);
        const char* nA = has_next ? (const char*)g.A + (size_t)nxt.pm * tstepA : cA; const char* nB = has_next ? (const char*)g.Bt + (size_t)nxt.pn * tstep : cB;
        for (int t = 0; t < nt; t += 2) {
            const bool last = (t == nt - 2);
            const char* a1 = cA + (size_t)(t + 1) * kstep;
            const char* a2 = last ? nA : cA + (size_t)(t + 2) * kstep; const char* b2 = last ? nB : cB + (size_t)(t + 2) * kstep;
            const char* a3 = a2 + kstep; const char* b3 = b2 + kstep;
            if (last && has_next) S.a_ready(nxt);
            if constexpr (SP2) {
            PG8_LDB(B0, 0, 0); PG8_LDB(B1, 0, 1); PG8_SCHED; PG8_LDA(At, 0, 0); PG8_STAGE(PG8_SA(1, 1), a1 + hstepA, voffA);
            PG8_WAIT_V(8); PG8_WAIT_L(0); PG8_BAR; PG8_MMA(0, 0, At, B0); PG8_MMA(0, 1, At, B1); PG8_BAR; PG8_SCHED;
            PG8_LDA(At, 0, 1); PG8_STAGE(PG8_SB(0, 0), b2, voffB); PG8_STAGE(PG8_SB(0, 1), b2 + hstep, voffB); PG8_STAGE(PG8_SA(0, 0), a2, voffA);
            PG8_WAIT_V(8); PG8_WAIT_L(0); PG8_BAR; PG8_MMA(1, 0, At, B0); PG8_MMA(1, 1, At, B1); PG8_BAR; PG8_SCHED;
            PG8_LDB(B0, 1, 0); PG8_LDB(B1, 1, 1); PG8_SCHED; PG8_LDA(At, 1, 0); PG8_STAGE(PG8_SA(0, 1), a2 + hstepA, voffA);
            PG8_WAIT_V(8); PG8_WAIT_L(0); PG8_BAR; PG8_MMA(0, 0, At, B0); PG8_MMA(0, 1, At, B1); PG8_BAR; PG8_SCHED;
            PG8_LDA(At, 1, 1); PG8_STAGE(PG8_SB(1, 0), b3, voffB); PG8_STAGE(PG8_SB(1, 1), b3 + hstep, voffB); PG8_STAGE(PG8_SA(1, 0), a3, voffA);
            PG8_WAIT_V(8); PG8_WAIT_L(0); PG8_BAR; PG8_MMA(1, 0, At, B0); PG8_MMA(1, 1, At, B1); PG8_BAR; PG8_SCHED;
            } else {
            PG8_LDB(B0, 0, 0); PG8_SCHED; PG8_LDA(At, 0, 0); PG8_STAGE(PG8_SA(1, 1), a1 + hstepA, voffA);
            PG8_WAIT_L(8); PG8_BAR; PG8_WAIT_L(0); PG8_MMA(0, 0, At, B0); PG8_BAR; PG8_SCHED;
            PG8_LDB(B1, 0, 1); PG8_STAGE(PG8_SB(0, 0), b2, voffB);
            PG8_BAR; PG8_WAIT_L(0); PG8_MMA(0, 1, At, B1); PG8_BAR;
            PG8_LDA(At, 0, 1); PG8_STAGE(PG8_SA(0, 0), a2, voffA);
            PG8_BAR; PG8_WAIT_L(0); PG8_MMA(1, 0, At, B0); PG8_BAR; PG8_SCHED;
            PG8_STAGE(PG8_SB(0, 1), b2 + hstep, voffB);
            PG8_WAIT_V(6); PG8_BAR; PG8_MMA(1, 1, At, B1); PG8_BAR;
            PG8_LDB(B0, 1, 0); PG8_SCHED; PG8_LDA(At, 1, 0); PG8_STAGE(PG8_SA(0, 1), a2 + hstepA, voffA);
            PG8_WAIT_L(8); PG8_BAR; PG8_WAIT_L(0); PG8_MMA(0, 0, At, B0); PG8_BAR; PG8_SCHED;
            PG8_LDB(B1, 1, 1); PG8_STAGE(PG8_SB(1, 0), b3, voffB);
            PG8_BAR; PG8_WAIT_L(0); PG8_MMA(0, 1, At, B1); PG8_BAR;
            PG8_LDA(At, 1, 1); PG8_STAGE(PG8_SA(1, 0), a3, voffA);
            PG8_BAR; PG8_WAIT_L(0); PG8_MMA(1, 0, At, B0); PG8_BAR; PG8_SCHED;
            PG8_STAGE(PG8_SB(1, 1), b3 + hstep, voffB);
            PG8_WAIT_V(6); PG8_BAR; PG8_MMA(1, 1, At, B1); PG8_BAR;
            }
        }
        if constexpr (ALIGN_EPI) { if (wr == 0) PG8_BAR; }
        if constexpr (!Epi::AFTER_DRAIN) { E(acc, cur, wr, wc, fr, fq); S.done(cur); }
        if (!has_next) break;
#pragma unroll
        for (int a = 0; a < 2; ++a)
#pragma unroll
            for (int b = 0; b < 2; ++b)
#pragma unroll
                for (int m = 0; m < 4; ++m)
#pragma unroll
                    for (int n = 0; n < 2; ++n) acc[a][b][m][n] = (f32x4){0.f, 0.f, 0.f, 0.f};
        cur = nxt; cA = nA; cB = nB; ++ui;
        if constexpr (ALIGN_EPI) { if (wr == 1) PG8_BAR; }
    }
    PG8_WAIT_V(0);
    if constexpr (!ALIGN_EPI) { if (wr == 0) PG8_BAR; }
    PG8_BAR;
    if constexpr (Epi::AFTER_DRAIN) { E.fused(acc, cur, wr, wc, fr, fq, lds, wid, lane); S.done(cur); }
#undef PG8_SA
#undef PG8_SB
#undef PG8_STAGE
#undef PG8_LDA
#undef PG8_LDB
#undef PG8_MMA
#undef PG8_WAIT_V
#undef PG8_WAIT_L
#undef PG8_BAR
#undef PG8_SCHED
}
}
#define LAS __attribute__((address_space(3)))
#define XB_TMO      128
#define XB_XCNT(j)  (256  + 64 * (j))
#define XB_XSUB(j)  (1280 + 64 * (j))
#define XB_XGEN(j)  (2304 + 64 * (j))
#define XB_TOP      3328
#define XB_TOPGEN   3392
#define XCD_BAR_WORDS 3456
#define XB_SPIN_CAP (1u << 18)

__device__ __forceinline__ unsigned xb_ld(unsigned* p)              { return __hip_atomic_load(p, __ATOMIC_RELAXED, __HIP_MEMORY_SCOPE_AGENT); }
__device__ __forceinline__ unsigned xb_add(unsigned* p, unsigned v) { return __hip_atomic_fetch_add(p, v, __ATOMIC_RELAXED, __HIP_MEMORY_SCOPE_AGENT); }
__device__ __forceinline__ unsigned xb_xcc_id() { return (unsigned)__builtin_amdgcn_s_getreg((3 << 11) | 20) & 0xFu; }
#define XB_SPIN(cond, bar) do { unsigned _sp = 0; while (cond) { __builtin_amdgcn_s_sleep(1); \
    if ((++_sp & 255u) == 0u) { if (xb_ld(&(bar)[XB_TMO])) break; if (_sp > XB_SPIN_CAP) { atomicAdd(&(bar)[XB_TMO], 1u); break; } } } } while (0)

struct XcdBarrier {
    unsigned* bar; unsigned x;
    volatile LAS unsigned* st;
};

__device__ __forceinline__ XcdBarrier xcd_barrier_post(unsigned* bar, volatile LAS unsigned* st) {
    XcdBarrier b; b.bar = bar; b.x = xb_xcc_id(); b.st = st;
    if (threadIdx.x == 0) (void)xb_add(&bar[XB_XCNT(b.x)], 1u);
    return b;
}
__device__ __forceinline__ void xcd_barrier_complete(unsigned* bar, unsigned x, unsigned& nloc, unsigned& nx) {
    const unsigned G = gridDim.x * gridDim.y * gridDim.z;
    unsigned sum, cnt, mine, sp = 0u;
    for (;;) {
        sum = 0u; cnt = 0u; mine = 0u;
#pragma unroll
        for (unsigned j = 0; j < 16; ++j) { const unsigned c = xb_ld(&bar[XB_XCNT(j)]); sum += c; cnt += (c > 0u) ? 1u : 0u; mine = (j == x) ? c : mine; }
        if (sum == G) break;
        __builtin_amdgcn_s_sleep(1);
        if ((++sp & 255u) == 0u) { if (xb_ld(&bar[XB_TMO])) break; if (sp > XB_SPIN_CAP) { atomicAdd(&bar[XB_TMO], 1u); break; } }
    }
    nloc = mine > 0u ? mine : 1u; nx = cnt > 0u ? cnt : 1u;
}

__device__ __forceinline__ void xcd_barrier(const XcdBarrier& b) {
    asm volatile("s_waitcnt vmcnt(0)" ::: "memory");
    __syncthreads();
    if (threadIdx.x == 0) {
        unsigned* bar = b.bar;
        __builtin_amdgcn_s_waitcnt(0);
        unsigned nloc = b.st[0], nx = b.st[1];
        if (nloc == 0u) { xcd_barrier_complete(bar, b.x, nloc, nx); b.st[0] = nloc; b.st[1] = nx; }
        const unsigned old = xb_add(&bar[XB_XSUB(b.x)], 1u);
        const unsigned gen = old / nloc;
        if (old + 1u == (gen + 1u) * nloc) {
            __builtin_amdgcn_fence(__ATOMIC_RELEASE, "agent");
            asm volatile("s_waitcnt vmcnt(0)" ::: "memory");
            const unsigned og = xb_add(&bar[XB_TOP], 1u);
            const unsigned tg = og / nx;
            if (og + 1u == (tg + 1u) * nx) xb_add(&bar[XB_TOPGEN], 1u);
            else XB_SPIN(xb_ld(&bar[XB_TOPGEN]) == tg, bar);
            __builtin_amdgcn_fence(__ATOMIC_ACQUIRE, "agent");
            xb_add(&bar[XB_XGEN(b.x)], 1u);
            asm volatile("s_waitcnt vmcnt(0)" ::: "memory");
        } else {
            XB_SPIN(xb_ld(&bar[XB_XGEN(b.x)]) == gen, bar);
            __builtin_amdgcn_fence(__ATOMIC_ACQUIRE, "agent");
            asm volatile("s_waitcnt vmcnt(0)" ::: "memory");
        }
    }
    __syncthreads();
}
constexpr int NWAVES = 8;
constexpr int SEQ = 8192, BATCH = 2, M = BATCH * SEQ, DM = 4096, HD = 128, NH = 16, INW = 14336, NMEM = 256, CW = 512, DFF = 11008, DFF2 = 2 * DFF;
constexpr int C_RQ = 0, C_SQ = 2048, C_RK = 4096, C_RV = 6144, C_RG = 8192, C_SK = 10240, C_SV = 12288;
constexpr float SB_EXIT = 110.0f;
constexpr size_t MiB = 1u << 20;
constexpr size_t WS_CTL = 0, CTL_ZERO_BYTES = 1 * MiB;
constexpr size_t WS_COS = 1 * MiB, WS_SIN = 3 * MiB, WS_SSQ0 = 5 * MiB, WS_SSQM = 5 * MiB + 256 * 1024, WS_SSQ1 = 256 * 1024, WS_SSQ2 = 512 * 1024  , WS_SSQSB = 14 * MiB;
constexpr size_t WS_MB = 22 * MiB, WS_CQ = 26 * MiB, WS_CKV = 58 * MiB, WS_CO = 60 * MiB;
constexpr size_t WS_WQKV = 76 * MiB, WS_WO = 88 * MiB, WS_WUP = 92 * MiB, WS_WDOWN = 264 * MiB, WS_HB = 350 * MiB;
constexpr size_t WS_WIN = 478 * MiB, WS_WOUT = 590 * MiB, WS_PROJ = 622 * MiB, WS_KV = 1070 * MiB, WS_ST = 1198 * MiB, WS_END = 1262 * MiB;
constexpr size_t WS_UB = 478 * MiB, WS_ACT = 822 * MiB;
static_assert(WS_UB + (size_t)(M / 64) * 4 * DFF2 * 2 <= WS_WOUT && WS_ACT + (size_t)M * DFF * 2 <= WS_END && WS_ACT >= WS_PROJ, "ffn overlays");
static_assert(WS_PROJ + (size_t)M * INW * 2 <= WS_KV && WS_KV + (size_t)2048 * 16384 * 4 <= WS_ST && WS_ST + (size_t)2048 * 16384 * 2 <= WS_END, "mixer map");
static_assert(WS_WIN + (size_t)INW * DM * 2 <= WS_WOUT && WS_WOUT + (size_t)DM * DM * 2 <= WS_PROJ && WS_WUP + (size_t)DFF2 * DM * 2 <= WS_WDOWN && WS_WDOWN + (size_t)DM * DFF * 2 <= WS_HB && WS_HB + (size_t)M * DM * 2 <= WS_WIN, "weights map");
constexpr int CW_BAR = 4096;
constexpr int RING_BYTES = 131072, LDSCTL_OFF = RING_BYTES, MISC_OFF = LDSCTL_OFF + 320, L_EPIW = RING_BYTES + 1024  , LDS_BYTES = 147456;
constexpr int L_KT = 0, L_VT = 40960, L_RK = 81920, L_FL = 82944, L_RED = 83200;
constexpr int KSTR = 272, VSTR = 320;

#define GAS __attribute__((address_space(1)))
#define LAS __attribute__((address_space(3)))
#define DI __device__ __forceinline__
typedef unsigned short bf16;
typedef unsigned v4u __attribute__((ext_vector_type(4)));
typedef unsigned v2u __attribute__((ext_vector_type(2)));
typedef float f32x4 __attribute__((ext_vector_type(4)));
typedef float f32x16 __attribute__((ext_vector_type(16)));
typedef short bf16x8 __attribute__((ext_vector_type(8)));
typedef short s16x4 __attribute__((ext_vector_type(4)));
typedef GAS unsigned gu32;
#define RLX_AGENT __ATOMIC_RELAXED, __HIP_MEMORY_SCOPE_AGENT
#define LDS_WAIT() asm volatile("s_waitcnt lgkmcnt(0)" ::: "memory")
using pg8::pk_bf16; using pg8::EPSN; using pg8::LOGG; using pg8::hsum4;
#define MFMA32(a, b, c) __builtin_amdgcn_mfma_f32_32x32x16_bf16((a), (b), (c), 0, 0, 0)
DI int crow(int i, int h) { return (i & 3) + 8 * (i >> 2) + 4 * h; }
DI bf16x8 pack8(float a0, float a1, float a2, float a3, float a4, float a5, float a6, float a7) { v4u p; p.x = pk_bf16(a0, a1); p.y = pk_bf16(a2, a3); p.z = pk_bf16(a4, a5); p.w = pk_bf16(a6, a7); return __builtin_bit_cast(bf16x8, p); }
DI float bf2f(unsigned short b) { return __builtin_bit_cast(float, (unsigned)b << 16); }
DI float wave_sum(float v) {
#pragma unroll
    for (int o = 1; o < 64; o <<= 1) v += __shfl_xor(v, o);
    return v;
}
__constant__ float INVF[64] = { 1.000000000e+00f, 8.639884591e-01f, 7.464760542e-01f, 6.449466348e-01f, 5.572264791e-01f, 4.814372361e-01f, 4.159561992e-01f, 3.593813479e-01f, 3.105013072e-01f, 2.682695389e-01f, 2.317818105e-01f, 2.002568096e-01f, 1.730195731e-01f, 1.494868994e-01f, 1.291549653e-01f, 1.115883961e-01f,
    9.641107172e-02f, 8.329805732e-02f, 7.196855545e-02f, 6.218000501e-02f, 5.372280627e-02f, 4.641588405e-02f, 4.010278732e-02f, 3.464834765e-02f, 2.993577160e-02f, 2.586415969e-02f, 2.234633639e-02f, 1.930697635e-02f, 1.668100432e-02f, 1.441219542e-02f, 1.245197095e-02f, 1.075835899e-02f,
    9.295094758e-03f, 8.030855097e-03f, 6.938565988e-03f, 5.994841456e-03f, 5.179473665e-03f, 4.475004971e-03f, 3.866352839e-03f, 3.340484342e-03f, 2.886140021e-03f, 2.493591513e-03f, 2.154434333e-03f, 1.861406374e-03f, 1.608233550e-03f, 1.389495214e-03f, 1.200507861e-03f, 1.037224894e-03f,
    8.961503627e-04f, 7.742635789e-04f, 6.689548027e-04f, 5.779691855e-04f, 4.993587499e-04f, 4.314401885e-04f, 3.727593576e-04f, 3.220597864e-04f, 2.782559022e-04f, 2.404099068e-04f, 2.077113895e-04f, 1.794602285e-04f, 1.550515735e-04f, 1.339627779e-04f, 1.157422885e-04f, 9.999999747e-05f };
typedef float f32x2g __attribute__((ext_vector_type(2)));
template <bool HASG> DI void transpose_tile64(const float* __restrict__ W, int N, const float* __restrict__ gain, bf16* __restrict__ WT, int Kd, int dst_row0, int src_col0, int k0, LAS unsigned* scr, int lane) {
    const int n4 = lane & 15, kk = lane >> 4;
    f32x4 a[8], b[8]; f32x2g gg[8];
    const float* src = W + (size_t)(k0 + 2 * kk) * N + src_col0 + 4 * n4;
#pragma unroll
    for (int i = 0; i < 8; ++i) { a[i] = *(const GAS f32x4*)(src + (size_t)(8 * i) * N); b[i] = *(const GAS f32x4*)(src + (size_t)(8 * i + 1) * N); }
#pragma unroll
    for (int i = 0; i < 8; ++i) { if (HASG) gg[i] = *(const GAS f32x2g*)(gain + k0 + 8 * i + 2 * kk); else gg[i] = (f32x2g){1.f, 1.f}; }
    asm volatile("" ::: "memory");
#pragma unroll
    for (int i = 0; i < 8; ++i)
#pragma unroll
        for (int j = 0; j < 4; ++j) scr[(4 * n4 + j) * 33 + 4 * i + kk] = pk_bf16(a[i][j] * gg[i].x, b[i][j] * gg[i].y);
    LDS_WAIT(); asm volatile("" ::: "memory");
    const int c = lane & 7, nr = lane >> 3;
#pragma unroll
    for (int it = 0; it < 8; ++it) { const int n = 8 * it + nr; const LAS unsigned* sp = scr + n * 33 + 4 * c;
        v4u o; o.x = sp[0]; o.y = sp[1]; o.z = sp[2]; o.w = sp[3];
        *(GAS v4u*)(WT + (size_t)(dst_row0 + n) * Kd + k0 + 8 * c) = o; }
    LDS_WAIT(); asm volatile("" ::: "memory");
}
DI void row_to_bf16(const float* __restrict__ xrow, bf16* __restrict__ orow, float* __restrict__ ssq, int lane) {
    const GAS f32x4* xr = (const GAS f32x4*)xrow + lane; GAS v2u* o8 = (GAS v2u*)orow + lane; float s = 0.f; f32x4 v[16];
#pragma unroll
    for (int j = 0; j < 16; ++j) v[j] = xr[64 * j];
    asm volatile("" ::: "memory");
#pragma unroll
    for (int j = 0; j < 16; ++j) { s += (v[j].x * v[j].x + v[j].y * v[j].y) + (v[j].z * v[j].z + v[j].w * v[j].w); v2u w; w.x = pk_bf16(v[j].x, v[j].y); w.y = pk_bf16(v[j].z, v[j].w); o8[64 * j] = w; }
    s = wave_sum(s); if (lane == 0) *ssq = s;
}
struct Ptrs {
    const float *x, *mem, *attn_norm, *w_in, *ret_norm, *sbq_norm, *sbk_norm, *sbo_norm, *w_out, *cross_norm, *mem_norm, *wq, *wkv, *cq_norm, *ck_norm, *wo, *ffn_norm, *w_up, *conv_w, *conv_b, *w_down;
    float* out; unsigned char* ws;
};
DI void p0_prologue(const Ptrs& P, LAS unsigned char* lds, int gw, int NGW, int wave, int lane) {
    unsigned char* ws = P.ws;
    LAS unsigned* scr = (LAS unsigned*)(lds + wave * 16384);
    constexpr int KB = DM / 64;
    constexpr int I_IN = KB * (INW / 64), I_OUT = KB * (DM / 64), I_Q = KB * (CW / 64), I_KV = KB * (2 * CW / 64), I_O = (CW / 64) * (DM / 64), I_UP = KB * (DFF2 / 64), I_DN = (DFF / 64) * (DM / 64);
    constexpr int NITEMS = I_IN + I_OUT + I_Q + I_KV + I_O + I_UP + I_DN;
    for (int it = gw; it < NITEMS; it += NGW) {
        int r = it;
        if (r < I_IN) { const int nb = r % (INW / 64), kb = r / (INW / 64), n0 = 64 * nb, reg = n0 >> 11;
            const int src = (reg == 0 ? 0 : reg == 1 ? 8192 : reg == 2 ? 2048 : reg == 3 ? 4096 : reg == 4 ? 6144 : reg == 5 ? 10240 : 12288) + (n0 & 2047);
            transpose_tile64<true>(P.w_in, INW, P.attn_norm, (bf16*)(ws + WS_WIN), DM, n0, src, 64 * kb, scr, lane); continue; } r -= I_IN;
        if (r < I_OUT) { const int nb = r % (DM / 64), kb = r / (DM / 64); transpose_tile64<false>(P.w_out, DM, nullptr, (bf16*)(ws + WS_WOUT), DM, 64 * nb, 64 * nb, 64 * kb, scr, lane); continue; } r -= I_OUT;
        if (r < I_Q) { const int nb = r % (CW / 64), kb = r / (CW / 64); transpose_tile64<true>(P.wq, CW, P.cross_norm, (bf16*)(ws + WS_WQKV), DM, 64 * nb, 64 * nb, 64 * kb, scr, lane); continue; } r -= I_Q;
        if (r < I_KV) { const int nb = r % (2 * CW / 64), kb = r / (2 * CW / 64); transpose_tile64<true>(P.wkv, 2 * CW, P.mem_norm, (bf16*)(ws + WS_WQKV), DM, CW + 64 * nb, 64 * nb, 64 * kb, scr, lane); continue; } r -= I_KV;
        if (r < I_O) { const int nb = r % (DM / 64), kb = r / (DM / 64); transpose_tile64<false>(P.wo, DM, nullptr, (bf16*)(ws + WS_WO), CW, 64 * nb, 64 * nb, 64 * kb, scr, lane); continue; } r -= I_O;
        if (r < I_UP) { const int nb = r % (DFF2 / 64), kb = r / (DFF2 / 64), n0 = 64 * nb, src = ((n0 >> 7) & 1) * DFF + 128 * (n0 >> 8) + (n0 & 127);
            transpose_tile64<true>(P.w_up, DFF2, P.ffn_norm, (bf16*)(ws + WS_WUP), DM, n0, src, 64 * kb, scr, lane); continue; } r -= I_UP;
        { const int nb = r % (DM / 64), kb = r / (DM / 64); transpose_tile64<false>(P.w_down, DM, nullptr, (bf16*)(ws + WS_WDOWN), DFF, 64 * nb, 64 * nb, 64 * kb, scr, lane); }
    }
    for (int m = gw; m < M; m += NGW) row_to_bf16(P.x + (size_t)m * DM, (bf16*)(ws + WS_HB) + (size_t)m * DM, (float*)(ws + WS_SSQ0) + m, lane);
    for (int m = gw; m < BATCH * NMEM; m += NGW) row_to_bf16(P.mem + (size_t)m * DM, (bf16*)(ws + WS_MB) + (size_t)m * DM, (float*)(ws + WS_SSQM) + m, lane);
    for (int idx = gw * 64 + lane; idx < SEQ * 64; idx += NGW * 64) {
        const int t = idx >> 6, i = idx & 63; const float angf = (float)t * INVF[i]; const double ang = (double)angf;
        const double kq = __builtin_rint(ang * 0.15915494309189535); const double rr = __builtin_fma(-kq, 6.283185307179586, ang) - kq * 2.4492935982947064e-16;
        const double r2 = rr * rr; double sn = 0.0, cs = 0.0;
#pragma unroll
        for (int k = 13; k >= 0; --k) { cs = cs * (-r2 / (double)((2 * k + 1) * (2 * k + 2))) + 1.0; sn = sn * (-r2 / (double)((2 * k + 2) * (2 * k + 3))) + 1.0; }
        ((float*)(ws + WS_COS))[idx] = (float)cs; ((float*)(ws + WS_SIN))[idx] = (float)(sn * rr);
    }
}
DI void stage_tile(LAS unsigned char* dst, int stride, const bf16* src, size_t ld, int rows, int tid) {
    for (int ch = tid; ch < rows * 16; ch += NWAVES * 64) { const int r = ch >> 4, c = ch & 15; const v4u v = *(const GAS v4u*)(src + (size_t)r * ld + c * 8); *(LAS v4u*)(dst + r * stride + c * 16) = v; }
}
DI bf16x8 tr_frag(LAS unsigned char* tile, int stride, int row0, int col0, int lane) {
    const int g = lane >> 4, i16 = lane & 15, q = i16 >> 2, p = i16 & 3, h = lane >> 5;
    LAS unsigned char* a = tile + (row0 + 4 * h + q) * stride + (col0 + 16 * (g & 1) + 4 * p) * 2;
    const s16x4 lo = __builtin_amdgcn_ds_read_tr16_b64_v4i16((LAS s16x4*)a);
    const s16x4 hi = __builtin_amdgcn_ds_read_tr16_b64_v4i16((LAS s16x4*)(a + 8 * stride));
    return __builtin_shufflevector(lo, hi, 0, 1, 2, 3, 4, 5, 6, 7);
}
DI f32x16 st_tile(LAS unsigned char* KT, int krow0, const bf16x8 (&qf)[8], int r, int h) {
    f32x16 acc;
#pragma unroll
    for (int i = 0; i < 16; ++i) acc[i] = 0.f;
#pragma unroll
    for (int ks = 0; ks < 8; ++ks) { const bf16x8 a = *(const LAS bf16x8*)(KT + (krow0 + r) * KSTR + (16 * ks + 8 * h) * 2); acc = MFMA32(a, qf[ks], acc); }
    return acc;
}
DI void load_qf(bf16x8 (&qf)[8], const bf16* qrowp, int h) {
#pragma unroll
    for (int ks = 0; ks < 8; ++ks) qf[ks] = *(const GAS bf16x8*)(qrowp + 16 * ks + 8 * h);
}

DI void ret_kv_unit(LAS unsigned char* lds, const bf16* PROJ, float* KVB, int unit, int tid) {
    const int lane = tid & 63, w = __builtin_amdgcn_readfirstlane(tid >> 6), r = lane & 31, h = lane >> 5;
    const int n = unit & 63, hd = (unit >> 6) & 15, b = unit >> 10;
    LAS unsigned char* KT = lds + L_KT; LAS unsigned char* VT = lds + L_VT;
    const size_t m0 = (size_t)b * SEQ + 128 * n;
    __syncthreads();
    stage_tile(KT, VSTR, PROJ + m0 * INW + C_RK + 128 * hd, INW, 128, tid);
    stage_tile(VT, VSTR, PROJ + m0 * INW + C_RV + 128 * hd, INW, 128, tid);
    __syncthreads();
    const int te = w >> 1, td0 = 2 * (w & 1);
    f32x16 acc[2];
#pragma unroll
    for (int t = 0; t < 2; ++t)
#pragma unroll
        for (int i = 0; i < 16; ++i) acc[t][i] = 0.f;
#pragma unroll
    for (int ks = 0; ks < 8; ++ks) {
        const bf16x8 a = tr_frag(VT, VSTR, 16 * ks, 32 * te, lane);
#pragma unroll
        for (int t = 0; t < 2; ++t) { const bf16x8 bb = tr_frag(KT, VSTR, 16 * ks, 32 * (td0 + t), lane); acc[t] = MFMA32(a, bb, acc[t]); }
    }
    const float sc = __expf(127.0f * LOGG[hd]);
    float* o = KVB + (size_t)unit * 16384;
#pragma unroll
    for (int t = 0; t < 2; ++t)
#pragma unroll
        for (int i = 0; i < 16; ++i) o[(32 * te + crow(i, h)) * 128 + 32 * (td0 + t) + r] = acc[t][i] * sc;
}
DI void ret_scan(const float* KVB, bf16* ST, int gt, int NT) {
    for (int idx = gt; idx < 32 * 4096; idx += NT) {
        const int bh = idx >> 12, e4 = idx & 4095; const float dec = __expf(128.0f * LOGG[bh & 15]);
        f32x4 S = {0.f, 0.f, 0.f, 0.f};
        for (int n = 0; n < 64; ++n) {
            const size_t off = ((size_t)(bh * 64 + n) * 4096 + e4) * 4;
            v2u w; w.x = pk_bf16(S[0], S[1]); w.y = pk_bf16(S[2], S[3]); *(GAS v2u*)(ST + off) = w;
            const f32x4 kv = *(const GAS f32x4*)(KVB + off); S = S * dec + kv;
        }
    }
}
DI void ret_out_unit(LAS unsigned char* lds, bf16* PROJ, const bf16* ST, const float* gret, int unit, int tid) {
    const int lane = tid & 63, w = __builtin_amdgcn_readfirstlane(tid >> 6), r = lane & 31, h = lane >> 5, qg = w & 3, eh = w >> 2;
    const int n = unit & 63, hd = (unit >> 6) & 15, b = unit >> 10;
    LAS unsigned char* KT = lds + L_KT; LAS unsigned char* VT = lds + L_VT; LAS float* RED = (LAS float*)(lds + L_RED);
    const size_t m0 = (size_t)b * SEQ + 128 * n, qrow = m0 + 32 * qg + r;
    __syncthreads();
    stage_tile(KT, KSTR, PROJ + m0 * INW + C_RK + 128 * hd, INW, 128, tid);
    stage_tile(VT, VSTR, PROJ + m0 * INW + C_RV + 128 * hd, INW, 128, tid);
    bf16x8 qf[8]; load_qf(qf, PROJ + qrow * INW + C_RQ + 128 * hd, h);
    const bf16* st = ST + (size_t)unit * 16384;
    f32x16 O[2];
#pragma unroll
    for (int et = 0; et < 2; ++et) {
#pragma unroll
        for (int i = 0; i < 16; ++i) O[et][i] = 0.f;
#pragma unroll
        for (int ks = 0; ks < 8; ++ks) { const bf16x8 a = *(const GAS bf16x8*)(st + (32 * (2 * eh + et) + r) * 128 + 16 * ks + 8 * h); O[et] = MFMA32(a, qf[ks], O[et]); }
    }
    const float g1 = __expf(LOGG[hd]);
#pragma unroll
    for (int et = 0; et < 2; ++et) O[et] = O[et] * g1;
    __syncthreads();
    for (int kt = 0; kt <= qg; ++kt) {
        f32x16 s = st_tile(KT, 32 * kt, qf, r, h);
        if (kt == qg) {
#pragma unroll
            for (int i = 0; i < 16; ++i) s[i] = (crow(i, h) <= r) ? s[i] : 0.f;
        }
        bf16x8 pb[2];
#pragma unroll
        for (int s2 = 0; s2 < 2; ++s2) pb[s2] = pack8(s[8 * s2], s[8 * s2 + 1], s[8 * s2 + 2], s[8 * s2 + 3], s[8 * s2 + 4], s[8 * s2 + 5], s[8 * s2 + 6], s[8 * s2 + 7]);
#pragma unroll
        for (int et = 0; et < 2; ++et)
#pragma unroll
            for (int s2 = 0; s2 < 2; ++s2) O[et] = MFMA32(tr_frag(VT, VSTR, 32 * kt + 16 * s2, 32 * (2 * eh + et), lane), pb[s2], O[et]);
    }
    float ss = 0.f;
#pragma unroll
    for (int et = 0; et < 2; ++et)
#pragma unroll
        for (int i = 0; i < 16; ++i) ss += O[et][i] * O[et][i];
    ss += __shfl_xor(ss, 32);
    if (h == 0) RED[w * 32 + r] = ss;
    __syncthreads();
    const float rstd = rsqrtf((RED[w * 32 + r] + RED[(w ^ 4) * 32 + r]) * (1.0f / 128.0f) + EPSN);
    bf16* orow = PROJ + qrow * INW + 128 * hd;
#pragma unroll
    for (int et = 0; et < 2; ++et)
#pragma unroll
        for (int G = 0; G < 4; ++G) {
            const int e = 32 * (2 * eh + et) + 8 * G + 4 * h;
            const f32x4 g = *(const f32x4*)(gret + e); const v2u gt = *(const GAS v2u*)(orow + C_RG + e);
            const float o0 = O[et][4 * G + 0] * rstd * g[0] * bf2f((unsigned short)(gt.x & 0xffff)), o1 = O[et][4 * G + 1] * rstd * g[1] * bf2f((unsigned short)(gt.x >> 16));
            const float o2 = O[et][4 * G + 2] * rstd * g[2] * bf2f((unsigned short)(gt.y & 0xffff)), o3 = O[et][4 * G + 3] * rstd * g[3] * bf2f((unsigned short)(gt.y >> 16));
            v2u wv; wv.x = pk_bf16(o0, o1); wv.y = pk_bf16(o2, o3); *(GAS v2u*)(orow + C_RQ + e) = wv;
        }
}
DI void sb_unit(LAS unsigned char* lds, bf16* PROJ, const float* ssqsb, const float* gout, int unit, int tid) {
    const int lane = tid & 63, w = __builtin_amdgcn_readfirstlane(tid >> 6), r = lane & 31, h = lane >> 5;
    const int qb = unit & 31, hd = (unit >> 5) & 15, b = unit >> 9;
    LAS unsigned char* KT = lds + L_KT; LAS unsigned char* VT = lds + L_VT; LAS float* RK = (LAS float*)(lds + L_RK); LAS unsigned* FL = (LAS unsigned*)(lds + L_FL);
    const size_t m0 = (size_t)b * SEQ + 256 * qb, qrow = m0 + 32 * w + r;
    const int qlo = 256 * qb + 32 * w, qhi = qlo + 31, tq = qlo + r;
    bf16x8 qf[8]; load_qf(qf, PROJ + qrow * INW + C_SQ + 128 * hd, h);
    const f32x4 pq = *(const GAS f32x4*)(ssqsb + (qrow * 32 + hd) * 4);
    const float qscale = rsqrtf(hsum4(pq) * (1.0f / 128.0f) + EPSN) * 0.08838834764831845f;
    f32x16 O[4];
#pragma unroll
    for (int dt = 0; dt < 4; ++dt)
#pragma unroll
        for (int i = 0; i < 16; ++i) O[dt][i] = 0.f;
    float R = 0.f;
    for (int kb = 2 * qb + 1; kb >= 0; --kb) {
        __syncthreads();
        if (kb != 2 * qb + 1) { const unsigned all = FL[0] & FL[1] & FL[2] & FL[3] & FL[4] & FL[5] & FL[6] & FL[7]; if (all) break; }
        const size_t k0row = (size_t)b * SEQ + 128 * kb;
        stage_tile(KT, KSTR, PROJ + k0row * INW + C_SK + 128 * hd, INW, 128, tid);
        stage_tile(VT, VSTR, PROJ + k0row * INW + C_SV + 128 * hd, INW, 128, tid);
        if (tid < 128) { const f32x4 pk = *(const GAS f32x4*)(ssqsb + ((k0row + tid) * 32 + 16 + hd) * 4); RK[tid] = rsqrtf(hsum4(pk) * (1.0f / 128.0f) + EPSN); }
        __syncthreads();
        const int k0b = 128 * kb;
        if (k0b < qhi) {
            for (int st = 3; st >= 0; --st) {
                const int k0 = k0b + 32 * st;
                if (k0 >= qhi) continue;
                const f32x16 s = st_tile(KT, 32 * st, qf, r, h);
                const bool need_mask = (k0 + 31 >= qlo);
                float a[16];
#pragma unroll
                for (int G = 3; G >= 0; --G) {
                    const f32x4 rk = *(const LAS f32x4*)(RK + 32 * st + 8 * G + 4 * h);
                    float z[4], sp[4]; bool ok[4];
#pragma unroll
                    for (int j = 0; j < 4; ++j) {
                        z[j] = s[4 * G + j] * qscale * rk[j];
                        ok[j] = !need_mask || (k0 + 8 * G + 4 * h + j < tq);
                        const float spv = fmaxf(z[j], 0.f) + __logf(1.0f + __expf(-fabsf(z[j])));
                        sp[j] = ok[j] ? spv : 0.f;
                    }
                    const float l3 = sp[3], l2 = sp[2] + l3, l1 = sp[1] + l2, l0 = sp[0] + l1;
                    const float To = __shfl_xor(l0, 32);
                    const float off = h ? R : R + To;
                    a[4 * G + 0] = ok[0] ? __expf(z[0] - (off + l0)) : 0.f; a[4 * G + 1] = ok[1] ? __expf(z[1] - (off + l1)) : 0.f;
                    a[4 * G + 2] = ok[2] ? __expf(z[2] - (off + l2)) : 0.f; a[4 * G + 3] = ok[3] ? __expf(z[3] - (off + l3)) : 0.f;
                    R = R + (l0 + To);
                }
                bf16x8 pb[2];
#pragma unroll
                for (int s2 = 0; s2 < 2; ++s2) pb[s2] = pack8(a[8 * s2], a[8 * s2 + 1], a[8 * s2 + 2], a[8 * s2 + 3], a[8 * s2 + 4], a[8 * s2 + 5], a[8 * s2 + 6], a[8 * s2 + 7]);
#pragma unroll
                for (int dt = 0; dt < 4; ++dt)
#pragma unroll
                    for (int s2 = 0; s2 < 2; ++s2) O[dt] = MFMA32(tr_frag(VT, VSTR, 32 * st + 16 * s2, 32 * dt, lane), pb[s2], O[dt]);
            }
        }
        const bool done = __all(R > SB_EXIT);
        if (lane == 0) FL[w] = done ? 1u : 0u;
    }
    float ss = 0.f;
#pragma unroll
    for (int dt = 0; dt < 4; ++dt)
#pragma unroll
        for (int i = 0; i < 16; ++i) ss += O[dt][i] * O[dt][i];
    ss += __shfl_xor(ss, 32);
    const float rstd = rsqrtf(ss * (1.0f / 128.0f) + EPSN);
    bf16* orow = PROJ + qrow * INW + C_SQ + 128 * hd;
#pragma unroll
    for (int dt = 0; dt < 4; ++dt)
#pragma unroll
        for (int G = 0; G < 4; ++G) {
            const int d = 32 * dt + 8 * G + 4 * h; const f32x4 g = *(const f32x4*)(gout + d);
            v2u wv; wv.x = pk_bf16(O[dt][4 * G] * rstd * g[0], O[dt][4 * G + 1] * rstd * g[1]); wv.y = pk_bf16(O[dt][4 * G + 2] * rstd * g[2], O[dt][4 * G + 3] * rstd * g[3]);
            *(GAS v2u*)(orow + d) = wv;
        }
}
DI void cross_stage(LAS unsigned char* lds, const float* CKV, const float* gk, LAS float* RKc, int b, int ch, int kh, bool withV, int tid) {
    for (int chn = tid; chn < 128 * 16; chn += NWAVES * 64) {
        const int rr = chn >> 4, c = chn & 15; const float* src = CKV + (size_t)(b * NMEM + 128 * kh + rr) * (2 * CW) + 128 * ch + 8 * c;
        const f32x4 a0 = *(const GAS f32x4*)src, a1 = *(const GAS f32x4*)(src + 4); const f32x4 g0 = *(const f32x4*)(gk + 8 * c), g1 = *(const f32x4*)(gk + 8 * c + 4); const float rs = RKc[128 * kh + rr];
        v4u o; o.x = pk_bf16(a0[0] * rs * g0[0], a0[1] * rs * g0[1]); o.y = pk_bf16(a0[2] * rs * g0[2], a0[3] * rs * g0[3]); o.z = pk_bf16(a1[0] * rs * g1[0], a1[1] * rs * g1[1]); o.w = pk_bf16(a1[2] * rs * g1[2], a1[3] * rs * g1[3]);
        *(LAS v4u*)(lds + L_KT + rr * KSTR + c * 16) = o;
        if (withV) { const f32x4 v0 = *(const GAS f32x4*)(src + CW), v1 = *(const GAS f32x4*)(src + CW + 4);
            v4u ov; ov.x = pk_bf16(v0[0], v0[1]); ov.y = pk_bf16(v0[2], v0[3]); ov.z = pk_bf16(v1[0], v1[1]); ov.w = pk_bf16(v1[2], v1[3]);
            *(LAS v4u*)(lds + L_VT + rr * VSTR + c * 16) = ov; }
    }
}
DI void cross_unit(LAS unsigned char* lds, const float* CQ, const float* CKV, const float* gq, const float* gk, bf16* CO, int unit, int tid) {
    const int lane = tid & 63, w = __builtin_amdgcn_readfirstlane(tid >> 6), r = lane & 31, h = lane >> 5;
    const int qb = unit & 31, ch = (unit >> 5) & 3, b = unit >> 7;
    LAS unsigned char* KT = lds + L_KT; LAS unsigned char* VT = lds + L_VT; LAS float* RKc = (LAS float*)(lds + L_RK);
    const size_t qrow = (size_t)b * SEQ + 256 * qb + 32 * w + r;
    __syncthreads();
    {
        const int key = tid >> 1, half = tid & 1; const float* src = CKV + (size_t)(b * NMEM + key) * (2 * CW) + 128 * ch + 64 * half; float s = 0.f;
#pragma unroll
        for (int j = 0; j < 16; ++j) { const f32x4 v = *(const GAS f32x4*)(src + 4 * j); s += (v.x * v.x + v.y * v.y) + (v.z * v.z + v.w * v.w); }
        s += __shfl_xor(s, 1);
        if (half == 0) RKc[key] = rsqrtf(s * (1.0f / 128.0f) + EPSN);
    }
    bf16x8 qf[8];
    {
        const float* qp = CQ + qrow * CW + 128 * ch; f32x4 qv[8][2]; float s = 0.f;
#pragma unroll
        for (int ks = 0; ks < 8; ++ks) { qv[ks][0] = *(const GAS f32x4*)(qp + 16 * ks + 8 * h); qv[ks][1] = *(const GAS f32x4*)(qp + 16 * ks + 8 * h + 4);
            s += (qv[ks][0].x * qv[ks][0].x + qv[ks][0].y * qv[ks][0].y) + (qv[ks][0].z * qv[ks][0].z + qv[ks][0].w * qv[ks][0].w) + (qv[ks][1].x * qv[ks][1].x + qv[ks][1].y * qv[ks][1].y) + (qv[ks][1].z * qv[ks][1].z + qv[ks][1].w * qv[ks][1].w); }
        s += __shfl_xor(s, 32);
        const float rs = rsqrtf(s * (1.0f / 128.0f) + EPSN) * 0.08838834764831845f;
#pragma unroll
        for (int ks = 0; ks < 8; ++ks) { const f32x4 g0 = *(const f32x4*)(gq + 16 * ks + 8 * h), g1 = *(const f32x4*)(gq + 16 * ks + 8 * h + 4); const f32x4 a0 = qv[ks][0] * g0 * rs, a1 = qv[ks][1] * g1 * rs;
            qf[ks] = pack8(a0[0], a0[1], a0[2], a0[3], a1[0], a1[1], a1[2], a1[3]); }
    }
    __syncthreads();
    float mx = -3.0e38f;
    for (int kh = 0; kh < 2; ++kh) {
        if (kh) __syncthreads();
        cross_stage(lds, CKV, gk, RKc, b, ch, kh, false, tid);
        __syncthreads();
#pragma unroll 1
        for (int st = 0; st < 4; ++st) { const f32x16 s = st_tile(KT, 32 * st, qf, r, h);
#pragma unroll
            for (int i = 0; i < 16; ++i) mx = fmaxf(mx, s[i]); }
    }
    mx = fmaxf(mx, __shfl_xor(mx, 32));
    f32x16 O[4]; float lsum = 0.f;
#pragma unroll
    for (int dt = 0; dt < 4; ++dt)
#pragma unroll
        for (int i = 0; i < 16; ++i) O[dt][i] = 0.f;
    for (int kh = 0; kh < 2; ++kh) {
        __syncthreads();
        cross_stage(lds, CKV, gk, RKc, b, ch, kh, true, tid);
        __syncthreads();
#pragma unroll 1
        for (int st = 0; st < 4; ++st) {
            const f32x16 s = st_tile(KT, 32 * st, qf, r, h); float p[16];
#pragma unroll
            for (int i = 0; i < 16; ++i) { p[i] = __expf(s[i] - mx); lsum += p[i]; }
            bf16x8 pb[2];
#pragma unroll
            for (int s2 = 0; s2 < 2; ++s2) pb[s2] = pack8(p[8 * s2], p[8 * s2 + 1], p[8 * s2 + 2], p[8 * s2 + 3], p[8 * s2 + 4], p[8 * s2 + 5], p[8 * s2 + 6], p[8 * s2 + 7]);
#pragma unroll
            for (int dt = 0; dt < 4; ++dt)
#pragma unroll
                for (int s2 = 0; s2 < 2; ++s2) O[dt] = MFMA32(tr_frag(VT, VSTR, 32 * st + 16 * s2, 32 * dt, lane), pb[s2], O[dt]);
        }
    }
    lsum += __shfl_xor(lsum, 32);
    const float inv = 1.0f / lsum;
    bf16* orow = CO + qrow * CW + 128 * ch;
#pragma unroll
    for (int dt = 0; dt < 4; ++dt)
#pragma unroll
        for (int G = 0; G < 4; ++G) { const int d = 32 * dt + 8 * G + 4 * h;
            v2u wv; wv.x = pk_bf16(O[dt][4 * G] * inv, O[dt][4 * G + 1] * inv); wv.y = pk_bf16(O[dt][4 * G + 2] * inv, O[dt][4 * G + 3] * inv); *(GAS v2u*)(orow + d) = wv; }
}
DI void ld8(const bf16* p, float (&o)[8]) { const v4u a = *(const GAS v4u*)p; const unsigned aw[4] = {a.x, a.y, a.z, a.w};
#pragma unroll
    for (int e = 0; e < 4; ++e) { o[2 * e] = bf2f((unsigned short)(aw[e] & 0xffff)); o[2 * e + 1] = bf2f((unsigned short)(aw[e] >> 16)); } }
DI void ffn_fix(const bf16* UB, bf16* ACT, const float* cw, const float* cb, int gt, int NT) {
    constexpr int NC = DFF / 8;
    for (int it = gt; it < (M / 64) * 2 * NC; it += NT) {
        const int cc = it % NC, rr = it / NC, rho = rr & 1, blk = rr >> 1, n0 = 8 * cc; const bool first = (blk & 127) == 0;
        const bf16* cur = UB + ((size_t)blk * 4 + rho) * DFF2; const bf16* prv = UB + ((size_t)(blk - 1) * 4) * DFF2;
        const bf16* p1 = rho ? UB + ((size_t)blk * 4) * DFF2 : prv + 3 * (size_t)DFF2;
        const bf16* p2 = rho ? prv + 3 * (size_t)DFF2 : prv + 2 * (size_t)DFF2;
        const bool z1 = (rho == 0) && first, z2 = first;
        float o[2][8];
#pragma unroll
        for (int hf = 0; hf < 2; ++hf) {
            const int col = hf * DFF + n0; float x0[8], x1[8], x2[8];
            ld8(cur + col, x0);
            if (!z1) ld8(p1 + col, x1); else {
#pragma unroll
                for (int e = 0; e < 8; ++e) x1[e] = 0.f; }
            if (!z2) ld8(p2 + col, x2); else {
#pragma unroll
                for (int e = 0; e < 8; ++e) x2[e] = 0.f; }
#pragma unroll
            for (int e = 0; e < 8; ++e) o[hf][e] = cb[col + e] + cw[col + e] * x2[e] + cw[(size_t)DFF2 + col + e] * x1[e] + cw[2 * (size_t)DFF2 + col + e] * x0[e];
        }
        float a[8];
#pragma unroll
        for (int e = 0; e < 8; ++e) a[e] = o[0][e] * __builtin_amdgcn_rcpf(1.0f + __expf(-o[0][e])) * o[1][e];
        v4u ov; ov.x = pk_bf16(a[0], a[1]); ov.y = pk_bf16(a[2], a[3]); ov.z = pk_bf16(a[4], a[5]); ov.w = pk_bf16(a[6], a[7]);
        *(GAS v4u*)(ACT + ((size_t)blk * 64 + rho) * DFF + n0) = ov;
    }
}
struct Args { Ptrs p; int ph_lo, ph_hi; };
constexpr int N_PHASES = 12;
__global__ void __launch_bounds__(NWAVES * 64, 2) mk_fwd(Args args) {
    extern __shared__ __attribute__((aligned(16))) unsigned char lds_raw[];
    LAS unsigned char* lds = (LAS unsigned char*)lds_raw;
    volatile LAS unsigned* MISC = (volatile LAS unsigned*)(lds + MISC_OFF);
    const int tid = threadIdx.x, lane = tid & 63, wave = __builtin_amdgcn_readfirstlane(tid >> 6);
    const int G = gridDim.x, bx = blockIdx.x;
    const Ptrs& P = args.p; unsigned char* ws = P.ws;
    gu32* ctl = (gu32*)(ws + WS_CTL);
    for (int u = tid; u < (LDS_BYTES - LDSCTL_OFF) / 4; u += NWAVES * 64) ((LAS unsigned*)(lds + LDSCTL_OFF))[u] = 0u;
    __syncthreads();
    XcdBarrier bar = xcd_barrier_post((unsigned*)(ctl + CW_BAR), MISC + 8);
    const int lo = args.ph_lo, hi = args.ph_hi;
#ifndef PHMASK
#define PHMASK 0xffff
#endif
#define IN(k) (((PHMASK >> (k)) & 1) && lo <= (k) && (k) < hi)
#define SEAM(k) do { if (IN(k) && IN((k) + 1)) xcd_barrier(bar); } while (0)
    bf16* HB = (bf16*)(ws + WS_HB); bf16* PROJ = (bf16*)(ws + WS_PROJ);
    const int gw = bx * NWAVES + wave, NGW = G * NWAVES, gt = bx * NWAVES * 64 + tid, NT = G * NWAVES * 64;

    if (IN(0)) { p0_prologue(P, lds, gw, NGW, wave, lane); }
    SEAM(0);
    if (IN(1)) {
        pg8::Gemm g{HB, (const bf16*)(ws + WS_WIN), M, INW, DM, DM}; pg8::StaticOrder S; S.init(M, INW, G, bx);
        pg8::EpiProj E{PROJ, (const float*)(ws + WS_SSQ0), (const float*)(ws + WS_COS), (const float*)(ws + WS_SIN), P.sbq_norm, P.sbk_norm, (float*)(ws + WS_SSQSB)};
        pg8::gemm_phase<pg8::EpiProj, pg8::StaticOrder, true, true>(lds, g, S, E);
    }
    SEAM(1);
    if (IN(2)) { for (int u = bx; u < 2048; u += G) ret_kv_unit(lds, PROJ, (float*)(ws + WS_KV), u, tid); }
    SEAM(2);
    if (IN(3)) { ret_scan((const float*)(ws + WS_KV), (bf16*)(ws + WS_ST), gt, NT); }
    SEAM(3);
    if (IN(4)) {
        for (int u = bx; u < 1024; u += G) sb_unit(lds, PROJ, (const float*)(ws + WS_SSQSB), P.sbo_norm, u, tid);
        for (int u = bx; u < 2048; u += G) ret_out_unit(lds, PROJ, (const bf16*)(ws + WS_ST), P.ret_norm, u, tid);
        __syncthreads();
    }
    SEAM(4);
    if (IN(5)) {
        pg8::Gemm g{PROJ, (const bf16*)(ws + WS_WOUT), M, DM, DM, INW}; pg8::StaticOrder S; S.init(M, DM, G, bx);
        pg8::EpiRes<true> E{P.x, P.out, HB, (float*)(ws + WS_SSQ1)};
        pg8::gemm_phase<pg8::EpiRes<true>, pg8::StaticOrder, true, true>(lds, g, S, E);
    }
    SEAM(5);
    if (IN(6)) {
        { pg8::Gemm g{HB, (const bf16*)(ws + WS_WQKV), M, CW, DM, DM}; pg8::StaticOrder S; S.init(M, CW, G, bx);
          pg8::EpiScaleF32 E{(float*)(ws + WS_CQ), CW, (const float*)(ws + WS_SSQ1)};
          pg8::gemm_phase<pg8::EpiScaleF32, pg8::StaticOrder, true, true>(lds, g, S, E); }
        __syncthreads();
        { pg8::Gemm g{(const bf16*)(ws + WS_MB), (const bf16*)(ws + WS_WQKV) + (size_t)CW * DM, BATCH * NMEM, 2 * CW, DM, DM}; pg8::StaticOrder S; S.init(BATCH * NMEM, 2 * CW, G, (bx + G / 2) % G);
          pg8::EpiScaleF32 E{(float*)(ws + WS_CKV), 2 * CW, (const float*)(ws + WS_SSQM)};
          pg8::gemm_phase<pg8::EpiScaleF32, pg8::StaticOrder, true, true>(lds, g, S, E); }
    }
    SEAM(6);
    if (IN(7)) { for (int u = bx; u < 256; u += G) cross_unit(lds, (const float*)(ws + WS_CQ), (const float*)(ws + WS_CKV), P.cq_norm, P.ck_norm, (bf16*)(ws + WS_CO), u, tid); __syncthreads(); }
    SEAM(7);
    if (IN(8)) {
        pg8::Gemm g{(const bf16*)(ws + WS_CO), (const bf16*)(ws + WS_WO), M, DM, CW, CW}; pg8::StaticOrder S; S.init(M, DM, G, bx);
        pg8::EpiRes<true> E{P.out, P.out, HB, (float*)(ws + WS_SSQ2)};
        pg8::gemm_phase<pg8::EpiRes<true>, pg8::StaticOrder, true, true>(lds, g, S, E);
    }
    SEAM(8);
    if (IN(9)) {
        pg8::Gemm g{HB, (const bf16*)(ws + WS_WUP), M, DFF2, DM, DM}; pg8::StaticOrder S; S.init(M, DFF2, G, bx);
        pg8::EpiFfn E{(bf16*)(ws + WS_ACT), (bf16*)(ws + WS_UB), (const float*)(ws + WS_SSQ2), P.conv_w, P.conv_b, (LAS float*)(lds + L_EPIW + wave * 1024)};
        pg8::gemm_phase<pg8::EpiFfn, pg8::StaticOrder, true, true>(lds, g, S, E);
    }
    SEAM(9);
    if (IN(10)) { ffn_fix((const bf16*)(ws + WS_UB), (bf16*)(ws + WS_ACT), P.conv_w, P.conv_b, gt, NT); }
    SEAM(10);
    if (IN(11)) {
        pg8::Gemm g{(const bf16*)(ws + WS_ACT), (const bf16*)(ws + WS_WDOWN), M, DM, DFF, DFF}; pg8::StaticOrder S; S.init(M, DM, G, bx);
        pg8::EpiRes<false> E{P.out, P.out, nullptr, nullptr};
        pg8::gemm_phase<pg8::EpiRes<false>, pg8::StaticOrder, true, true>(lds, g, S, E);
    }
#undef IN
#undef SEAM
}

#ifndef MK_CUTS
#define MK_CUTS 0
#endif
extern "C" void kernel_launch(void* const* d_in, const int* in_sizes, int n_in, void* d_out, int out_size, void* d_ws, size_t ws_size, hipStream_t stream) {
    static int grid = 0;
    if (grid == 0) {
        if (n_in != 21 || in_sizes[0] != M * DM || out_size != M * DM || ws_size < WS_END) { fprintf(stderr, "kernel_launch: unexpected shapes (n_in %d, in0 %d, out %d, ws %zu < %zu); nothing launched\n", n_in, n_in > 0 ? in_sizes[0] : -1, out_size, ws_size, (size_t)WS_END); grid = -1; return; }
        int dev = 0, cus = 0, per_cu = 0;
        if (hipGetDevice(&dev) != hipSuccess || hipDeviceGetAttribute(&cus, hipDeviceAttributeMultiprocessorCount, dev) != hipSuccess) { grid = -1; return; }
        if (hipFuncSetAttribute((const void*)mk_fwd, hipFuncAttributeMaxDynamicSharedMemorySize, LDS_BYTES) != hipSuccess) { fprintf(stderr, "kernel_launch: hipFuncSetAttribute failed\n"); grid = -1; return; }
        if (hipOccupancyMaxActiveBlocksPerMultiprocessor(&per_cu, (const void*)mk_fwd, NWAVES * 64, LDS_BYTES) != hipSuccess || per_cu < 1) fprintf(stderr, "kernel_launch: note: occupancy query reports %d\n", per_cu);
        (void)hipGetLastError();
        grid = cus;
    }
    if (grid < 0) return;
    if (hipMemsetAsync((char*)d_ws + WS_CTL, 0, CTL_ZERO_BYTES, stream) != hipSuccess) return;
    Args a{};
    const float** pp = (const float**)&a.p;
    for (int i = 0; i < 21; ++i) pp[i] = (const float*)d_in[i];
    a.p.out = (float*)d_out; a.p.ws = (unsigned char*)d_ws;
#if MK_CUTS
    for (int ph = 0; ph < N_PHASES; ++ph) { a.ph_lo = ph; a.ph_hi = ph + 1; hipLaunchKernelGGL(mk_fwd, dim3(grid), dim3(NWAVES * 64), LDS_BYTES, stream, a); }
#else
    a.ph_lo = 0; a.ph_hi = N_PHASES;
    hipLaunchKernelGGL(mk_fwd, dim3(grid), dim3(NWAVES * 64), LDS_BYTES, stream, a);
#endif
    const hipError_t le = hipPeekAtLastError();
    if (le != hipSuccess) fprintf(stderr, "kernel_launch: launch failed: %s\n", hipGetErrorName(le));
}
```

```cpp
#include <hip/hip_runtime.h>
#include <cstdio>
#include <cstdint>
namespace pg8 {
#define PG8_LAS __attribute__((address_space(3)))
typedef unsigned short bf16_t;
typedef short bf16x8 __attribute__((ext_vector_type(8)));
typedef float f32x4 __attribute__((ext_vector_type(4)));
typedef unsigned u32x4 __attribute__((ext_vector_type(4)));
typedef unsigned u32x2 __attribute__((ext_vector_type(2)));
constexpr int BM = 256, BK = 64, HALF = 128, HTB = HALF * BK * 2  , STAGE_BYTES = 8 * HTB, NXCD = 8, WGM = 8;

__host__ __device__ __forceinline__ int lds_byte(int r, int c) { const int st = (r >> 4) * 2 + (c >> 5), rr = r & 15, cc = c & 31, ob = rr * 64 + cc * 2; return st * 1024 + (ob ^ (((ob >> 9) & 1) << 5)); }
__host__ __device__ __forceinline__ void stage_rc(int b, int& R, int& C) { const int st = b / 1024, sb = b % 1024, swz = sb ^ (((sb >> 9) & 1) << 5); R = (st >> 1) * 16 + swz / 64; C = (st & 1) * 32 + (swz % 64) / 2; }
__host__ __device__ __forceinline__ int perm32(int rho) { const int n = rho >> 4, i = rho & 15; return 8 * (i >> 2) + 4 * n + (i & 3); }
template <int PERM> __host__ __device__ __forceinline__ int permrow(int R) {
    if (PERM == 1) return (R & ~31) + perm32(R & 31);
    if (PERM == 2) return 64 * ((R >> 4) & 1) + 16 * (R >> 5) + (R & 15);
    return R;
}

template <int PERM> __host__ __device__ __forceinline__ int invpermrow(int d) {
    if (PERM == 1) { const int c = d & 31; return (d & ~31) + 16 * ((c >> 2) & 1) + 4 * (c >> 3) + (c & 3); }
    if (PERM == 2) return 32 * ((d >> 4) & 3) + 16 * (d >> 6) + (d & 15);
    return d;
}
__host__ __device__ __forceinline__ size_t blk_elem(int row, int col, int C) {
    return ((size_t)((row >> 8) * (C >> 6) + (col >> 6)) * 32768 + (size_t)(((row >> 7) & 1) * 16384 + lds_byte(row & 127, col & 63))) >> 1;
}

struct Unit { int pm, pn; };
struct Gemm { const bf16_t* A; const bf16_t* Bt; int M, N, K, lda; };

struct StaticOrder {
    int nM, nN, nwg, G, c, pm0;
    __host__ __device__ void init(int M, int N, int G_, int c_, int pm0_ = 0) { nM = M / BM; nN = N / BM; nwg = nM * nN; G = G_; c = c_; pm0 = pm0_; }
    __host__ __device__ bool next(int i, Unit& u) const {
        const long L = (long)i * G + c; if (L >= nwg) return false;
        int wgid = (int)L; { const int q = nwg / NXCD, r = nwg % NXCD, xcd = wgid % NXCD, off = wgid / NXCD; wgid = (xcd < r ? xcd * (q + 1) : r * (q + 1) + (xcd - r) * q) + off; }
        const int nig = WGM * nN, gid = wgid / nig, fm = gid * WGM, gsz = (nM - fm) < WGM ? (nM - fm) : WGM;
        u.pm = pm0 + fm + ((wgid % nig) % gsz); u.pn = (wgid % nig) / gsz; return true;
    }
    __device__ __forceinline__ void a_ready(const Unit&) const {}
    __device__ __forceinline__ void done(const Unit&) const {}
};

typedef float f32x2 __attribute__((ext_vector_type(2)));
typedef __bf16 bf16v2 __attribute__((ext_vector_type(2)));
__device__ __forceinline__ unsigned pk_bf16(float lo, float hi) { const f32x2 f = {lo, hi}; const bf16v2 r = __builtin_convertvector(f, bf16v2); return __builtin_bit_cast(unsigned, r); }
constexpr float EPSN = 1e-6f;
__constant__ float LOGG[16] = { -3.174869716e-02f, -1.574835740e-02f, -7.843177766e-03f, -3.913899418e-03f, -1.955034910e-03f, -9.770396864e-04f, -4.884005175e-04f, -2.441704273e-04f,
                                -1.220777631e-04f, -6.103701890e-05f, -3.051804379e-05f, -1.525890548e-05f, -7.629423635e-06f, -3.814704542e-06f, -1.907350452e-06f, -9.536747712e-07f };
__device__ __forceinline__ float hsum4(const f32x4 v) { return (v[0] + v[1]) + (v[2] + v[3]); }
__device__ __forceinline__ float dot4(const f32x4 a, const f32x4 b) { return (a[0] * b[0] + a[1] * b[1]) + (a[2] * b[2] + a[3] * b[3]); }
__device__ __forceinline__ float row_rstd64(const float* part, int row, int fq, float invn) {
    const f32x4* p = (const f32x4*)(part + (size_t)row * 64 + fq * 16);
    float s = (hsum4(p[0]) + hsum4(p[1])) + (hsum4(p[2]) + hsum4(p[3]));
    s += __shfl_xor(s, 16); s += __shfl_xor(s, 32);
    return rsqrtf(s * invn + EPSN);
}

#define EPI_FENCE() asm volatile("" ::: "memory")
struct EpiProj {
    static constexpr int PERM = 2; static constexpr bool AFTER_DRAIN = false;
    bf16_t* P; const float* ssq0; const float* cosT; const float* sinT; const float* gq; const float* gk; float* ssqsb;
    template <int REG> __device__ __forceinline__ void body(const f32x4 (&acc)[2][2][4][2], const Unit& u, int wr, int wc, int fr, int fq) const {
        constexpr bool ROPE = (REG == 0 || REG == 2);
        const int pnr = u.pn & 7, d0 = 16 * wc + 4 * fq, rowb = u.pm * BM + wr * 64 + fr;
        float lg[2] = {0.f, 0.f}; f32x4 g0 = {1.f, 1.f, 1.f, 1.f}, g1 = g0;
        if (ROPE) { lg[0] = LOGG[2 * pnr]; lg[1] = LOGG[2 * pnr + 1]; }
        if (REG == 1 || REG == 5) { const float* g = (REG == 1) ? gq : gk; g0 = *(const f32x4*)(g + d0); g1 = *(const f32x4*)(g + 64 + d0); }
        float rsv[8];
#pragma unroll
        for (int g = 0; g < 8; ++g) rsv[g] = ssq0[rowb + (g >> 2) * HALF + (g & 3) * 16];
        f32x4 csn = {0.f, 0.f, 0.f, 0.f}, snn = csn;
        if (ROPE) { const int t = rowb & 8191; csn = *(const f32x4*)(cosT + (size_t)t * 64 + d0); snn = *(const f32x4*)(sinT + (size_t)t * 64 + d0); }
        EPI_FENCE();
#pragma unroll
        for (int g = 0; g < 8; ++g) {
            const int ai = g >> 2, m = g & 3;
            const int row = rowb + ai * HALF + m * 16;
            const float rs = rsqrtf(rsv[g] * (1.0f / 4096.0f) + EPSN);
            const int t = row & 8191; const float cpos = (float)(t & 127);
            const f32x4 cs = csn, sn = snn;
            if (ROPE && g < 7) { const int tn = (rowb + ((g + 1) >> 2) * HALF + ((g + 1) & 3) * 16) & 8191; csn = *(const f32x4*)(cosT + (size_t)tn * 64 + d0); snn = *(const f32x4*)(sinT + (size_t)tn * 64 + d0); }
            EPI_FENCE();
            bf16_t* rowp = P + (size_t)row * 14336 + u.pn * BM + d0;
#pragma unroll
            for (int bj = 0; bj < 2; ++bj) {
                const f32x4 v0 = acc[ai][bj][m][0] * rs, v1 = acc[ai][bj][m][1] * rs;
                f32x4 o0 = v0, o1 = v1;
                if (REG == 0) { const float sc = 0.08838834764831845f * __expf(cpos * lg[bj]); o0 = (v0 * cs - v1 * sn) * sc; o1 = (v1 * cs + v0 * sn) * sc; }
                if (REG == 2) { const float sc = __expf(-cpos * lg[bj]); o0 = (v0 * cs - v1 * sn) * sc; o1 = (v1 * cs + v0 * sn) * sc; }
                if (REG == 4) {
#pragma unroll
                    for (int j = 0; j < 4; ++j) { o0[j] = v0[j] * __builtin_amdgcn_rcpf(1.0f + __expf(-v0[j])); o1[j] = v1[j] * __builtin_amdgcn_rcpf(1.0f + __expf(-v1[j])); } }
                if (REG == 1 || REG == 5) {
                    float s = dot4(v0, v0) + dot4(v1, v1); s += __shfl_xor(s, 16); s += __shfl_xor(s, 32);
                    if (fq == 0) ssqsb[((size_t)row * 32 + (REG == 1 ? 0 : 16) + 2 * pnr + bj) * 4 + wc] = s;
                    o0 = v0 * g0; o1 = v1 * g1; }
                u32x2 w0, w1; w0.x = pk_bf16(o0[0], o0[1]); w0.y = pk_bf16(o0[2], o0[3]); w1.x = pk_bf16(o1[0], o1[1]); w1.y = pk_bf16(o1[2], o1[3]);
                *(u32x2*)(rowp + bj * HALF) = w0; *(u32x2*)(rowp + bj * HALF + 64) = w1;
            }
        }
    }
    __device__ __forceinline__ void operator()(const f32x4 (&acc)[2][2][4][2], const Unit& u, int wr, int wc, int fr, int fq) const {
        const int reg = u.pn >> 3;
        if (reg == 0) body<0>(acc, u, wr, wc, fr, fq); else if (reg == 1) body<1>(acc, u, wr, wc, fr, fq); else if (reg == 2) body<2>(acc, u, wr, wc, fr, fq);
        else if (reg == 4) body<4>(acc, u, wr, wc, fr, fq); else if (reg == 5) body<5>(acc, u, wr, wc, fr, fq); else body<3>(acc, u, wr, wc, fr, fq);
    }
};

template <bool WITH_HB> struct EpiRes {
    static constexpr int PERM = 1; static constexpr bool AFTER_DRAIN = false;
    const float* base; float* out; bf16_t* hb; float* ssq;
    __device__ __forceinline__ void operator()(const f32x4 (&acc)[2][2][4][2], const Unit& u, int wr, int wc, int fr, int fq) const {
        const int col0 = u.pn * BM + wc * 32 + 8 * fq, rowb = u.pm * BM + wr * 64 + fr;
        f32x4 bn[2][2];
#pragma unroll
        for (int bj = 0; bj < 2; ++bj) { const size_t off = (size_t)rowb * 4096 + col0 + bj * HALF; bn[bj][0] = *(const f32x4*)(base + off); bn[bj][1] = *(const f32x4*)(base + off + 4); }
#pragma unroll
        for (int g = 0; g < 8; ++g) {
            const int ai = g >> 2, m = g & 3, row = rowb + ai * HALF + m * 16; float s = 0.f;
            f32x4 b[2][2];
#pragma unroll
            for (int bj = 0; bj < 2; ++bj) { b[bj][0] = bn[bj][0]; b[bj][1] = bn[bj][1]; }
            if (g < 7) { const int rown = rowb + ((g + 1) >> 2) * HALF + ((g + 1) & 3) * 16;
#pragma unroll
                for (int bj = 0; bj < 2; ++bj) { const size_t off = (size_t)rown * 4096 + col0 + bj * HALF; bn[bj][0] = *(const f32x4*)(base + off); bn[bj][1] = *(const f32x4*)(base + off + 4); } }
            EPI_FENCE();
#pragma unroll
            for (int bj = 0; bj < 2; ++bj) {
                const size_t off = (size_t)row * 4096 + col0 + bj * HALF;
                const f32x4 o0 = b[bj][0] + acc[ai][bj][m][0], o1 = b[bj][1] + acc[ai][bj][m][1];
                *(f32x4*)(out + off) = o0; *(f32x4*)(out + off + 4) = o1;
                if (WITH_HB) { u32x4 w; w.x = pk_bf16(o0[0], o0[1]); w.y = pk_bf16(o0[2], o0[3]); w.z = pk_bf16(o1[0], o1[1]); w.w = pk_bf16(o1[2], o1[3]); *(u32x4*)(hb + blk_elem(row, col0 + bj * HALF, 4096)) = w; s += dot4(o0, o0) + dot4(o1, o1); }
            }
            if (WITH_HB) { s += __shfl_xor(s, 16); s += __shfl_xor(s, 32); if (fq == 0) __hip_atomic_fetch_add(ssq + row, s, __ATOMIC_RELAXED, __HIP_MEMORY_SCOPE_AGENT); }
            EPI_FENCE();
        }
    }
};

struct EpiScaleF32 {
    static constexpr int PERM = 1; static constexpr bool AFTER_DRAIN = false;
    float* C; int ldc; const float* ssq;
    __device__ __forceinline__ void operator()(const f32x4 (&acc)[2][2][4][2], const Unit& u, int wr, int wc, int fr, int fq) const {
        const int col0 = u.pn * BM + wc * 32 + 8 * fq, rowb = u.pm * BM + wr * 64 + fr;
        float rsv[8];
#pragma unroll
        for (int g = 0; g < 8; ++g) rsv[g] = ssq[rowb + (g >> 2) * HALF + (g & 3) * 16];
        EPI_FENCE();
#pragma unroll
        for (int g = 0; g < 8; ++g) {
            const int ai = g >> 2, m = g & 3, row = rowb + ai * HALF + m * 16; const float rs = rsqrtf(rsv[g] * (1.0f / 4096.0f) + EPSN);
#pragma unroll
            for (int bj = 0; bj < 2; ++bj) { float* p = C + (size_t)row * ldc + col0 + bj * HALF; *(f32x4*)p = acc[ai][bj][m][0] * rs; *(f32x4*)(p + 4) = acc[ai][bj][m][1] * rs; }
        }
    }
};
struct EpiScaleBf16 {
    static constexpr int PERM = 1; static constexpr bool AFTER_DRAIN = false;
    bf16_t* O; int ldc; const float* ssq;
    __device__ __forceinline__ void operator()(const f32x4 (&acc)[2][2][4][2], const Unit& u, int wr, int wc, int fr, int fq) const {
        const int col0 = u.pn * BM + wc * 32 + 8 * fq, rowb = u.pm * BM + wr * 64 + fr;
        float rsv[8];
#pragma unroll
        for (int g = 0; g < 8; ++g) rsv[g] = ssq[rowb + (g >> 2) * HALF + (g & 3) * 16];
        EPI_FENCE();
#pragma unroll
        for (int g = 0; g < 8; ++g) {
            const int ai = g >> 2, m = g & 3, row = rowb + ai * HALF + m * 16; const float rs = rsqrtf(rsv[g] * (1.0f / 4096.0f) + EPSN);
#pragma unroll
            for (int bj = 0; bj < 2; ++bj) { const f32x4 v0 = acc[ai][bj][m][0] * rs, v1 = acc[ai][bj][m][1] * rs;
                u32x4 w; w.x = pk_bf16(v0[0], v0[1]); w.y = pk_bf16(v0[2], v0[3]); w.z = pk_bf16(v1[0], v1[1]); w.w = pk_bf16(v1[2], v1[3]);
                *(u32x4*)(O + (size_t)row * ldc + col0 + bj * HALF) = w; }
        }
    }
};

__device__ __forceinline__ float dpp_ror1(float x) { return __builtin_bit_cast(float, __builtin_amdgcn_update_dpp(0, __builtin_bit_cast(int, x), 0x121, 0xf, 0xf, false)); }
__device__ __forceinline__ float dpp_ror2(float x) { return __builtin_bit_cast(float, __builtin_amdgcn_update_dpp(0, __builtin_bit_cast(int, x), 0x122, 0xf, 0xf, false)); }
struct EpiFfn {
    static constexpr int PERM = 1; static constexpr bool AFTER_DRAIN = false;
    bf16_t* ACT; bf16_t* UB; const float* ssq; const float* cw; const float* cb; PG8_LAS float* wl;
    static constexpr int DFF = 11008;
    __device__ __forceinline__ void operator()(const f32x4 (&acc)[2][2][4][2], const Unit& u, int wr, int wc, int fr, int fq) const {
        const int cc0 = 32 * wc + 8 * fq, colg = u.pn * HALF + cc0, rowb = u.pm * BM + wr * 64 + fr;
        float rs[8];
#pragma unroll
        for (int g = 0; g < 8; ++g) rs[g] = ssq[rowb + (g >> 2) * HALF + (g & 3) * 16];
        {
            f32x4 wv[2][4][2];
#pragma unroll
            for (int bj = 0; bj < 2; ++bj)
#pragma unroll
                for (int t = 0; t < 4; ++t)
#pragma unroll
                    for (int n = 0; n < 2; ++n) { const int col = bj * DFF + colg + 4 * n; wv[bj][t][n] = (t < 3) ? *(const f32x4*)(cw + (size_t)t * (2 * DFF) + col) : *(const f32x4*)(cb + col); }
            EPI_FENCE();
#pragma unroll
            for (int bj = 0; bj < 2; ++bj)
#pragma unroll
                for (int t = 0; t < 4; ++t)
#pragma unroll
                    for (int n = 0; n < 2; ++n) *(PG8_LAS f32x4*)(wl + (bj * 4 + t) * 32 + 8 * fq + 4 * n) = wv[bj][t][n];
        }
#pragma unroll
        for (int g = 0; g < 8; ++g) rs[g] = rsqrtf(rs[g] * (1.0f / 4096.0f) + EPSN);
        asm volatile("s_waitcnt lgkmcnt(0)" ::: "memory");
#pragma unroll
        for (int n = 0; n < 2; ++n) {
#pragma unroll
            for (int ai = 0; ai < 2; ++ai) {
                const int row0 = rowb + ai * HALF, blk = (u.pm * BM + ai * HALF + wr * 64) >> 6;
                f32x4 sg[4];
#pragma unroll
                for (int bj = 0; bj < 2; ++bj) {
                    const PG8_LAS float* wp = wl + (bj * 4) * 32 + 8 * fq + 4 * n;
                    const f32x4 w0 = *(const PG8_LAS f32x4*)(wp), w1 = *(const PG8_LAS f32x4*)(wp + 32), w2 = *(const PG8_LAS f32x4*)(wp + 64), bb = *(const PG8_LAS f32x4*)(wp + 96);
                    f32x4 pr1 = {0.f, 0.f, 0.f, 0.f}, pr2 = pr1;
#pragma unroll
                    for (int m = 0; m < 4; ++m) {
                        const f32x4 x = acc[ai][bj][m][n] * rs[ai * 4 + m]; f32x4 r1, r2;
#pragma unroll
                        for (int j = 0; j < 4; ++j) { r1[j] = dpp_ror1(x[j]); r2[j] = dpp_ror2(x[j]); }
                        const f32x4 p1 = (m == 0) ? r1 : ((fr == 0) ? pr1 : r1);
                        const f32x4 p2 = (m == 0) ? r2 : ((fr < 2) ? pr2 : r2);
                        const f32x4 c = bb + w2 * x + w1 * p1 + w0 * p2;
                        pr1 = r1; pr2 = r2;
                        if (bj == 0) {
#pragma unroll
                            for (int j = 0; j < 4; ++j) sg[m][j] = c[j] * __builtin_amdgcn_rcpf(1.0f + __expf(-c[j])); }
                        else {
                            const f32x4 o = sg[m] * c; u32x2 pkd; pkd.x = pk_bf16(o[0], o[1]); pkd.y = pk_bf16(o[2], o[3]);
                            if (m > 0 || fr >= 2) *(u32x2*)(ACT + blk_elem(row0 + 16 * m, colg + 4 * n, DFF)) = pkd;
                        }
                        if (m == 0 || m == 3) {
                            const bool sel = (m == 0) ? (fr < 2) : (fr >= 14); const int slot = (m == 0) ? fr : 2 + (fr - 14);
                            if (sel) { u32x2 rw; rw.x = pk_bf16(x[0], x[1]); rw.y = pk_bf16(x[2], x[3]); *(u32x2*)(UB + ((size_t)blk * 4 + slot) * (2 * DFF) + bj * DFF + colg + 4 * n) = rw; }
                        }
                        __builtin_amdgcn_sched_barrier(0);
                    }
                }
            }
        }
    }
};

template <class Epi, class Sched, bool ALIGN_EPI = false, bool SP2 = false>
__device__ __forceinline__ void gemm_phase(PG8_LAS unsigned char* lds, const Gemm g, const Sched& S, const Epi& E) {
    const int tid = threadIdx.x, wid = __builtin_amdgcn_readfirstlane(tid >> 6), lane = tid & 63, wr = wid >> 2, wc = wid & 3, fr = lane & 15, fq = lane >> 4;
    const int K = g.K, nt = K / BK;
    unsigned voffA[2], voffB[2];
#pragma unroll
    for (int i = 0; i < 2; ++i) { voffA[i] = (unsigned)(tid * 16 + i * 8192); voffB[i] = voffA[i]; }
    const size_t kstep = 32768;
    const size_t hstep = 16384, hstepA = 16384;
    const size_t tstep = (size_t)K * 512, tstepA = (size_t)g.lda * 512;
    const unsigned ldsw = (unsigned)wid * 1024u;
    const int aoff = lds_byte(wr * 64 + fr, fq * 8), boff = lds_byte(wc * 32 + fr, fq * 8);
#define PG8_SA(b, h) (((b) * 2 + (h)) * HTB)
#define PG8_SB(b, h) ((4 + (b) * 2 + (h)) * HTB)
#define PG8_STAGE(bufoff, gbase, voff) do { _Pragma("unroll") for (int _i = 0; _i < 2; ++_i) \
        __builtin_amdgcn_global_load_lds((const unsigned*)((const char*)(gbase) + (voff)[_i]), (PG8_LAS unsigned*)(lds + (bufoff) + ldsw + _i * 8192), 16, 0, 0); } while (0)
#define PG8_LDA(dst, b, h) do { _Pragma("unroll") for (int m = 0; m < 4; ++m) _Pragma("unroll") for (int k = 0; k < 2; ++k) dst[m][k] = *(const PG8_LAS bf16x8*)(lds + PG8_SA(b, h) + aoff + m * 2048 + k * 1024); } while (0)
#define PG8_LDB(dst, b, h) do { _Pragma("unroll") for (int n = 0; n < 2; ++n) _Pragma("unroll") for (int k = 0; k < 2; ++k) dst[n][k] = *(const PG8_LAS bf16x8*)(lds + PG8_SB(b, h) + boff + n * 2048 + k * 1024); } while (0)
#define PG8_MMA(ai, bj, At, Bt) do { __builtin_amdgcn_s_setprio(1); _Pragma("unroll") for (int m = 0; m < 4; ++m) _Pragma("unroll") for (int n = 0; n < 2; ++n) _Pragma("unroll") for (int k = 0; k < 2; ++k) \
        acc[ai][bj][m][n] = __builtin_amdgcn_mfma_f32_16x16x32_bf16(Bt[n][k], At[m][k], acc[ai][bj][m][n], 0, 0, 0); __builtin_amdgcn_s_setprio(0); } while (0)
#define PG8_WAIT_V(n) asm volatile("s_waitcnt vmcnt(" #n ")" ::: "memory")
#define PG8_WAIT_L(n) asm volatile("s_waitcnt lgkmcnt(" #n ")" ::: "memory")
#define PG8_BAR __builtin_amdgcn_s_barrier()
#define PG8_SCHED __builtin_amdgcn_sched_barrier(0)
    Unit cur, nxt; int ui = 0;
    if (!S.next(0, cur)) return;
    f32x4 acc[2][2][4][2];
#pragma unroll
    for (int a = 0; a < 2; ++a)
#pragma unroll
        for (int b = 0; b < 2; ++b)
#pragma unroll
            for (int m = 0; m < 4; ++m)
#pragma unroll
                for (int n = 0; n < 2; ++n) acc[a][b][m][n] = (f32x4){0.f, 0.f, 0.f, 0.f};
    bf16x8 At[4][2], B0[2][2], B1[2][2];
    const char* cA = (const char*)g.A + (size_t)cur.pm * tstepA; const char* cB = (const char*)g.Bt + (size_t)cur.pn * tstep;
    S.a_ready(cur);
    if constexpr (SP2) {
        PG8_STAGE(PG8_SB(0, 0), cB, voffB); PG8_STAGE(PG8_SB(0, 1), cB + hstep, voffB); PG8_STAGE(PG8_SA(0, 0), cA, voffA); PG8_STAGE(PG8_SA(0, 1), cA + hstepA, voffA);
        if (wr == 1) PG8_BAR;
        PG8_WAIT_V(2); PG8_BAR;
        PG8_STAGE(PG8_SB(1, 0), cB + kstep, voffB); PG8_STAGE(PG8_SA(1, 0), cA + kstep, voffA); PG8_STAGE(PG8_SB(1, 1), cB + hstep + kstep, voffB);
        PG8_WAIT_V(6); PG8_BAR;
    } else {
        PG8_STAGE(PG8_SB(0, 0), cB, voffB); PG8_STAGE(PG8_SA(0, 0), cA, voffA); PG8_STAGE(PG8_SB(0, 1), cB + hstep, voffB); PG8_STAGE(PG8_SA(0, 1), cA + hstepA, voffA);
        if (wr == 1) PG8_BAR;
        PG8_WAIT_V(4); PG8_BAR;
        PG8_STAGE(PG8_SB(1, 0), cB + kstep, voffB); PG8_STAGE(PG8_SA(1, 0), cA + kstep, voffA); PG8_STAGE(PG8_SB(1, 1), cB + hstep + kstep, voffB);
        PG8_WAIT_V(6); PG8_BAR;
    }
    for (;;) {
        const bool has_next = S.next(ui + 1, nxt);
        const char* nA = has_next ? (const char*)g.A + (size_t)nxt.pm * tstepA : cA; const char* nB = has_next ? (const char*)g.Bt + (size_t)nxt.pn * tstep : cB;
        for (int t = 0; t < nt; t += 2) {
            const bool last = (t == nt - 2);
            const char* a1 = cA + (size_t)(t + 1) * kstep;
            const char* a2 = last ? nA : cA + (size_t)(t + 2) * kstep; const char* b2 = last ? nB : cB + (size_t)(t + 2) * kstep;
            const char* a3 = a2 + kstep; const char* b3 = b2 + kstep;
            if (last && has_next) S.a_ready(nxt);
            if constexpr (SP2) {
            PG8_LDB(B0, 0, 0); PG8_LDB(B1, 0, 1); PG8_SCHED; PG8_LDA(At, 0, 0); PG8_STAGE(PG8_SA(1, 1), a1 + hstepA, voffA);
            PG8_WAIT_V(8); PG8_WAIT_L(0); PG8_BAR; PG8_MMA(0, 0, At, B0); PG8_MMA(0, 1, At, B1); PG8_BAR; PG8_SCHED;
            PG8_LDA(At, 0, 1); PG8_STAGE(PG8_SB(0, 0), b2, voffB); PG8_STAGE(PG8_SB(0, 1), b2 + hstep, voffB); PG8_STAGE(PG8_SA(0, 0), a2, voffA);
            PG8_WAIT_V(8); PG8_WAIT_L(0); PG8_BAR; PG8_MMA(1, 0, At, B0); PG8_MMA(1, 1, At, B1); PG8_BAR; PG8_SCHED;
            PG8_LDB(B0, 1, 0); PG8_LDB(B1, 1, 1); PG8_SCHED; PG8_LDA(At, 1, 0); PG8_STAGE(PG8_SA(0, 1), a2 + hstepA, voffA);
            PG8_WAIT_V(8); PG8_WAIT_L(0); PG8_BAR; PG8_MMA(0, 0, At, B0); PG8_MMA(0, 1, At, B1); PG8_BAR; PG8_SCHED;
            PG8_LDA(At, 1, 1); PG8_STAGE(PG8_SB(1, 0), b3, voffB); PG8_STAGE(PG8_SB(1, 1), b3 + hstep, voffB); PG8_STAGE(PG8_SA(1, 0), a3, voffA);
            PG8_WAIT_V(8); PG8_WAIT_L(0); PG8_BAR; PG8_MMA(1, 0, At, B0); PG8_MMA(1, 1, At, B1); PG8_BAR; PG8_SCHED;
            } else {
            PG8_LDB(B0, 0, 0); PG8_SCHED; PG8_LDA(At, 0, 0); PG8_STAGE(PG8_SA(1, 1), a1 + hstepA, voffA);
            PG8_WAIT_L(8); PG8_BAR; PG8_WAIT_L(0); PG8_MMA(0, 0, At, B0); PG8_BAR; PG8_SCHED;
            PG8_LDB(B1, 0, 1); PG8_STAGE(PG8_SB(0, 0), b2, voffB);
            PG8_BAR; PG8_WAIT_L(0); PG8_MMA(0, 1, At, B1); PG8_BAR;
            PG8_LDA(At, 0, 1); PG8_STAGE(PG8_SA(0, 0), a2, voffA);
            PG8_BAR; PG8_WAIT_L(0); PG8_MMA(1, 0, At, B0); PG8_BAR; PG8_SCHED;
            PG8_STAGE(PG8_SB(0, 1), b2 + hstep, voffB);
            PG8_WAIT_V(6); PG8_BAR; PG8_MMA(1, 1, At, B1); PG8_BAR;
            PG8_LDB(B0, 1, 0); PG8_SCHED; PG8_LDA(At, 1, 0); PG8_STAGE(PG8_SA(0, 1), a2 + hstepA, voffA);
            PG8_WAIT_L(8); PG8_BAR; PG8_WAIT_L(0); PG8_MMA(0, 0, At, B0); PG8_BAR; PG8_SCHED;
            PG8_LDB(B1, 1, 1); PG8_STAGE(PG8_SB(1, 0), b3, voffB);
            PG8_BAR; PG8_WAIT_L(0); PG8_MMA(0, 1, At, B1); PG8_BAR;
            PG8_LDA(At, 1, 1); PG8_STAGE(PG8_SA(1, 0), a3, voffA);
            PG8_BAR; PG8_WAIT_L(0); PG8_MMA(1, 0, At, B0); PG8_BAR; PG8_SCHED;
            PG8_STAGE(PG8_SB(1, 1), b3 + hstep, voffB);
            PG8_WAIT_V(6); PG8_BAR; PG8_MMA(1, 1, At, B1); PG8_BAR;
            }
        }
        if constexpr (ALIGN_EPI) { if (wr == 0) PG8_BAR; }
        if constexpr (!Epi::AFTER_DRAIN) { E(acc, cur, wr, wc, fr, fq); S.done(cur); }
        if (!has_next) break;
#pragma unroll
        for (int a = 0; a < 2; ++a)
#pragma unroll
            for (int b = 0; b < 2; ++b)
#pragma unroll
                for (int m = 0; m < 4; ++m)
#pragma unroll
                    for (int n = 0; n < 2; ++n) acc[a][b][m][n] = (f32x4){0.f, 0.f, 0.f, 0.f};
        cur = nxt; cA = nA; cB = nB; ++ui;
        if constexpr (ALIGN_EPI) { if (wr == 1) PG8_BAR; }
    }
    PG8_WAIT_V(0);
    if constexpr (!ALIGN_EPI) { if (wr == 0) PG8_BAR; }
    PG8_BAR;
    if constexpr (Epi::AFTER_DRAIN) { E.fused(acc, cur, wr, wc, fr, fq, lds, wid, lane); S.done(cur); }
#undef PG8_SA
#undef PG8_SB
#undef PG8_STAGE
#undef PG8_LDA
#undef PG8_LDB
#undef PG8_MMA
#undef PG8_WAIT_V
#undef PG8_WAIT_L
#undef PG8_BAR
#undef PG8_SCHED
}
}
#define LAS __attribute__((address_space(3)))
#define XB_TMO      128
#define XB_XCNT(j)  (256  + 64 * (j))
#define XB_XSUB(j)  (1280 + 64 * (j))
#define XB_XGEN(j)  (2304 + 64 * (j))
#define XB_TOP      3328
#define XB_TOPGEN   3392
#define XCD_BAR_WORDS 3456
#define XB_SPIN_CAP (1u << 18)

__device__ __forceinline__ unsigned xb_ld(unsigned* p)              { return __hip_atomic_load(p, __ATOMIC_RELAXED, __HIP_MEMORY_SCOPE_AGENT); }
__device__ __forceinline__ unsigned xb_add(unsigned* p, unsigned v) { return __hip_atomic_fetch_add(p, v, __ATOMIC_RELAXED, __HIP_MEMORY_SCOPE_AGENT); }
__device__ __forceinline__ unsigned xb_xcc_id() { return (unsigned)__builtin_amdgcn_s_getreg((3 << 11) | 20) & 0xFu; }
#define XB_SPIN(cond, bar) do { unsigned _sp = 0; while (cond) { __builtin_amdgcn_s_sleep(1); \
    if ((++_sp & 255u) == 0u) { if (xb_ld(&(bar)[XB_TMO])) break; if (_sp > XB_SPIN_CAP) { atomicAdd(&(bar)[XB_TMO], 1u); break; } } } } while (0)

struct XcdBarrier {
    unsigned* bar; unsigned x;
    volatile LAS unsigned* st;
};

__device__ __forceinline__ XcdBarrier xcd_barrier_post(unsigned* bar, volatile LAS unsigned* st) {
    XcdBarrier b; b.bar = bar; b.x = xb_xcc_id(); b.st = st;
    if (threadIdx.x == 0) (void)xb_add(&bar[XB_XCNT(b.x)], 1u);
    return b;
}
__device__ __forceinline__ void xcd_barrier_complete(unsigned* bar, unsigned x, unsigned& nloc, unsigned& nx) {
    const unsigned G = gridDim.x * gridDim.y * gridDim.z;
    unsigned sum, cnt, mine, sp = 0u;
    for (;;) {
        sum = 0u; cnt = 0u; mine = 0u;
#pragma unroll
        for (unsigned j = 0; j < 16; ++j) { const unsigned c = xb_ld(&bar[XB_XCNT(j)]); sum += c; cnt += (c > 0u) ? 1u : 0u; mine = (j == x) ? c : mine; }
        if (sum == G) break;
        __builtin_amdgcn_s_sleep(1);
        if ((++sp & 255u) == 0u) { if (xb_ld(&bar[XB_TMO])) break; if (sp > XB_SPIN_CAP) { atomicAdd(&bar[XB_TMO], 1u); break; } }
    }
    nloc = mine > 0u ? mine : 1u; nx = cnt > 0u ? cnt : 1u;
}

__device__ __forceinline__ void xcd_barrier(const XcdBarrier& b) {
    asm volatile("s_waitcnt vmcnt(0)" ::: "memory");
    __syncthreads();
    if (threadIdx.x == 0) {
        unsigned* bar = b.bar;
        __builtin_amdgcn_s_waitcnt(0);
        unsigned nloc = b.st[0], nx = b.st[1];
        if (nloc == 0u) { xcd_barrier_complete(bar, b.x, nloc, nx); b.st[0] = nloc; b.st[1] = nx; }
        const unsigned old = xb_add(&bar[XB_XSUB(b.x)], 1u);
        const unsigned gen = old / nloc;
        if (old + 1u == (gen + 1u) * nloc) {
            __builtin_amdgcn_fence(__ATOMIC_RELEASE, "agent");
            asm volatile("s_waitcnt vmcnt(0)" ::: "memory");
            const unsigned og = xb_add(&bar[XB_TOP], 1u);
            const unsigned tg = og / nx;
            if (og + 1u == (tg + 1u) * nx) xb_add(&bar[XB_TOPGEN], 1u);
            else XB_SPIN(xb_ld(&bar[XB_TOPGEN]) == tg, bar);
            __builtin_amdgcn_fence(__ATOMIC_ACQUIRE, "agent");
            xb_add(&bar[XB_XGEN(b.x)], 1u);
            asm volatile("s_waitcnt vmcnt(0)" ::: "memory");
        } else {
            XB_SPIN(xb_ld(&bar[XB_XGEN(b.x)]) == gen, bar);
            __builtin_amdgcn_fence(__ATOMIC_ACQUIRE, "agent");
            asm volatile("s_waitcnt vmcnt(0)" ::: "memory");
        }
    }
    __syncthreads();
}
constexpr int NWAVES = 8;
constexpr int SEQ = 8192, BATCH = 2, M = BATCH * SEQ, DM = 4096, HD = 128, NH = 16, INW = 14336, NMEM = 256, CW = 512, DFF = 11008, DFF2 = 2 * DFF;
constexpr int C_RQ = 0, C_SQ = 2048, C_RK = 4096, C_RV = 6144, C_RG = 8192, C_SK = 10240, C_SV = 12288;
constexpr float SB_EXIT = 110.0f;
constexpr size_t MiB = 1u << 20;
constexpr size_t WS_CTL = 0, CTL_ZERO_BYTES = 1 * MiB;
constexpr size_t WS_COS = 1 * MiB, WS_SIN = 3 * MiB, WS_SSQ0 = 5 * MiB, WS_SSQM = 5 * MiB + 256 * 1024, WS_SSQ1 = 256 * 1024, WS_SSQ2 = 512 * 1024  , WS_SSQSB = 14 * MiB;
constexpr size_t WS_MB = 22 * MiB, WS_CQ = 26 * MiB, WS_CKV = 58 * MiB, WS_CO = 60 * MiB;
constexpr size_t WS_WQKV = 76 * MiB, WS_WO = 88 * MiB, WS_WUP = 92 * MiB, WS_WDOWN = 264 * MiB, WS_HB = 350 * MiB;
constexpr size_t WS_WIN = 478 * MiB, WS_WOUT = 590 * MiB, WS_PROJ = 622 * MiB, WS_KV = 1070 * MiB, WS_ST = 1198 * MiB, WS_END = 1262 * MiB;
constexpr size_t WS_MIX = WS_KV;
constexpr size_t WS_UB = 478 * MiB, WS_ACT = 822 * MiB;
static_assert(WS_UB + (size_t)(M / 64) * 4 * DFF2 * 2 <= WS_WOUT && WS_ACT + (size_t)M * DFF * 2 <= WS_END && WS_ACT >= WS_PROJ, "ffn overlays");
static_assert(WS_PROJ + (size_t)M * INW * 2 <= WS_KV && WS_KV + (size_t)2048 * 16384 * 4 <= WS_ST && WS_ST + (size_t)2048 * 16384 * 2 <= WS_END, "mixer map");
static_assert(WS_WIN + (size_t)INW * DM * 2 <= WS_WOUT && WS_WOUT + (size_t)DM * DM * 2 <= WS_PROJ && WS_WUP + (size_t)DFF2 * DM * 2 <= WS_WDOWN && WS_WDOWN + (size_t)DM * DFF * 2 <= WS_HB && WS_HB + (size_t)M * DM * 2 <= WS_WIN, "weights map");
constexpr int CW_BAR = 4096;
constexpr int RING_BYTES = 131072, LDSCTL_OFF = RING_BYTES, MISC_OFF = LDSCTL_OFF + 320, L_EPIW = RING_BYTES + 1024  , LDS_BYTES = 147456;
constexpr int L_KT = 0, L_VT = 40960, L_RK = 81920, L_FL = 82944, L_RED = 83200;
constexpr int KSTR = 272, VSTR = 320;

#define GAS __attribute__((address_space(1)))
#define LAS __attribute__((address_space(3)))
#define DI __device__ __forceinline__
typedef unsigned short bf16;
typedef unsigned v4u __attribute__((ext_vector_type(4)));
typedef unsigned v2u __attribute__((ext_vector_type(2)));
typedef float f32x4 __attribute__((ext_vector_type(4)));
typedef float f32x16 __attribute__((ext_vector_type(16)));
typedef short bf16x8 __attribute__((ext_vector_type(8)));
typedef short s16x4 __attribute__((ext_vector_type(4)));
typedef GAS unsigned gu32;
#define RLX_AGENT __ATOMIC_RELAXED, __HIP_MEMORY_SCOPE_AGENT
#define LDS_WAIT() asm volatile("s_waitcnt lgkmcnt(0)" ::: "memory")
using pg8::pk_bf16; using pg8::EPSN; using pg8::LOGG; using pg8::hsum4;
#define MFMA32(a, b, c) __builtin_amdgcn_mfma_f32_32x32x16_bf16((a), (b), (c), 0, 0, 0)
DI int crow(int i, int h) { return (i & 3) + 8 * (i >> 2) + 4 * h; }
DI bf16x8 pack8(float a0, float a1, float a2, float a3, float a4, float a5, float a6, float a7) { v4u p; p.x = pk_bf16(a0, a1); p.y = pk_bf16(a2, a3); p.z = pk_bf16(a4, a5); p.w = pk_bf16(a6, a7); return __builtin_bit_cast(bf16x8, p); }
DI float bf2f(unsigned short b) { return __builtin_bit_cast(float, (unsigned)b << 16); }
DI float wave_sum(float v) {
#pragma unroll
    for (int o = 1; o < 64; o <<= 1) v += __shfl_xor(v, o);
    return v;
}
__constant__ float INVF[64] = { 1.000000000e+00f, 8.639884591e-01f, 7.464760542e-01f, 6.449466348e-01f, 5.572264791e-01f, 4.814372361e-01f, 4.159561992e-01f, 3.593813479e-01f, 3.105013072e-01f, 2.682695389e-01f, 2.317818105e-01f, 2.002568096e-01f, 1.730195731e-01f, 1.494868994e-01f, 1.291549653e-01f, 1.115883961e-01f,
    9.641107172e-02f, 8.329805732e-02f, 7.196855545e-02f, 6.218000501e-02f, 5.372280627e-02f, 4.641588405e-02f, 4.010278732e-02f, 3.464834765e-02f, 2.993577160e-02f, 2.586415969e-02f, 2.234633639e-02f, 1.930697635e-02f, 1.668100432e-02f, 1.441219542e-02f, 1.245197095e-02f, 1.075835899e-02f,
    9.295094758e-03f, 8.030855097e-03f, 6.938565988e-03f, 5.994841456e-03f, 5.179473665e-03f, 4.475004971e-03f, 3.866352839e-03f, 3.340484342e-03f, 2.886140021e-03f, 2.493591513e-03f, 2.154434333e-03f, 1.861406374e-03f, 1.608233550e-03f, 1.389495214e-03f, 1.200507861e-03f, 1.037224894e-03f,
    8.961503627e-04f, 7.742635789e-04f, 6.689548027e-04f, 5.779691855e-04f, 4.993587499e-04f, 4.314401885e-04f, 3.727593576e-04f, 3.220597864e-04f, 2.782559022e-04f, 2.404099068e-04f, 2.077113895e-04f, 1.794602285e-04f, 1.550515735e-04f, 1.339627779e-04f, 1.157422885e-04f, 9.999999747e-05f };
typedef float f32x2g __attribute__((ext_vector_type(2)));
template <bool HASG, int PERM> DI void transpose_tile64(const float* __restrict__ W, int N, const float* __restrict__ gain, bf16* __restrict__ WT, int Kd, int dst_row0, int src_col0, int k0, LAS unsigned* scr, int lane) {
    const int n4 = lane & 15, kk = lane >> 4;
    f32x4 a[8], b[8]; f32x2g gg[8];
    const float* src = W + (size_t)(k0 + 2 * kk) * N + src_col0 + 4 * n4;
#pragma unroll
    for (int i = 0; i < 8; ++i) { a[i] = *(const GAS f32x4*)(src + (size_t)(8 * i) * N); b[i] = *(const GAS f32x4*)(src + (size_t)(8 * i + 1) * N); }
#pragma unroll
    for (int i = 0; i < 8; ++i) { if (HASG) gg[i] = *(const GAS f32x2g*)(gain + k0 + 8 * i + 2 * kk); else gg[i] = (f32x2g){1.f, 1.f}; }
    asm volatile("" ::: "memory");
#pragma unroll
    for (int i = 0; i < 8; ++i)
#pragma unroll
        for (int j = 0; j < 4; ++j) scr[(4 * n4 + j) * 33 + 4 * i + kk] = pk_bf16(a[i][j] * gg[i].x, b[i][j] * gg[i].y);
    LDS_WAIT(); asm volatile("" ::: "memory");
    const int c = lane & 7, nr = lane >> 3;
#pragma unroll
    for (int it = 0; it < 8; ++it) { const int n = 8 * it + nr; const LAS unsigned* sp = scr + n * 33 + 4 * c;
        v4u o; o.x = sp[0]; o.y = sp[1]; o.z = sp[2]; o.w = sp[3];
        const int drow = dst_row0 + n, srow = (drow & ~127) + pg8::invpermrow<PERM>(drow & 127);
        *(GAS v4u*)(WT + pg8::blk_elem(srow, k0 + 8 * c, Kd)) = o; }
    LDS_WAIT(); asm volatile("" ::: "memory");
}
DI void row_to_bf16(const float* __restrict__ xrow, bf16* __restrict__ obase, int m, float* __restrict__ ssq, int lane) {
    const GAS f32x4* xr = (const GAS f32x4*)xrow + lane; float s = 0.f; f32x4 v[16];
#pragma unroll
    for (int j = 0; j < 16; ++j) v[j] = xr[64 * j];
    asm volatile("" ::: "memory");
#pragma unroll
    for (int j = 0; j < 16; ++j) { s += (v[j].x * v[j].x + v[j].y * v[j].y) + (v[j].z * v[j].z + v[j].w * v[j].w); v2u w; w.x = pk_bf16(v[j].x, v[j].y); w.y = pk_bf16(v[j].z, v[j].w);
        *(GAS v2u*)(obase + pg8::blk_elem(m, 4 * lane + 256 * j, DM)) = w; }
    s = wave_sum(s); if (lane == 0) *ssq = s;
}
struct Ptrs {
    const float *x, *mem, *attn_norm, *w_in, *ret_norm, *sbq_norm, *sbk_norm, *sbo_norm, *w_out, *cross_norm, *mem_norm, *wq, *wkv, *cq_norm, *ck_norm, *wo, *ffn_norm, *w_up, *conv_w, *conv_b, *w_down;
    float* out; unsigned char* ws;
};
DI void p0_prologue(const Ptrs& P, LAS unsigned char* lds, int gw, int NGW, int wave, int lane) {
    unsigned char* ws = P.ws;
    LAS unsigned* scr = (LAS unsigned*)(lds + wave * 16384);
    constexpr int KB = DM / 64;
    constexpr int I_IN = KB * (INW / 64), I_OUT = KB * (DM / 64), I_Q = KB * (CW / 64), I_KV = KB * (2 * CW / 64), I_O = (CW / 64) * (DM / 64), I_UP = KB * (DFF2 / 64), I_DN = (DFF / 64) * (DM / 64);
    constexpr int NITEMS = I_IN + I_OUT + I_Q + I_KV + I_O + I_UP + I_DN;
    for (int it = gw; it < NITEMS; it += NGW) {
        int r = it;
        if (r < I_IN) { const int nb = r % (INW / 64), kb = r / (INW / 64), n0 = 64 * nb, reg = n0 >> 11;
            const int src = (reg == 0 ? 0 : reg == 1 ? 8192 : reg == 2 ? 2048 : reg == 3 ? 4096 : reg == 4 ? 6144 : reg == 5 ? 10240 : 12288) + (n0 & 2047);
            transpose_tile64<true, 2>(P.w_in, INW, P.attn_norm, (bf16*)(ws + WS_WIN), DM, n0, src, 64 * kb, scr, lane); continue; } r -= I_IN;
        if (r < I_OUT) { const int nb = r % (DM / 64), kb = r / (DM / 64); transpose_tile64<false, 1>(P.w_out, DM, nullptr, (bf16*)(ws + WS_WOUT), DM, 64 * nb, 64 * nb, 64 * kb, scr, lane); continue; } r -= I_OUT;
        if (r < I_Q) { const int nb = r % (CW / 64), kb = r / (CW / 64); transpose_tile64<true, 1>(P.wq, CW, P.cross_norm, (bf16*)(ws + WS_WQKV), DM, 64 * nb, 64 * nb, 64 * kb, scr, lane); continue; } r -= I_Q;
        if (r < I_KV) { const int nb = r % (2 * CW / 64), kb = r / (2 * CW / 64); transpose_tile64<true, 1>(P.wkv, 2 * CW, P.mem_norm, (bf16*)(ws + WS_WQKV), DM, CW + 64 * nb, 64 * nb, 64 * kb, scr, lane); continue; } r -= I_KV;
        if (r < I_O) { const int nb = r % (DM / 64), kb = r / (DM / 64); transpose_tile64<false, 1>(P.wo, DM, nullptr, (bf16*)(ws + WS_WO), CW, 64 * nb, 64 * nb, 64 * kb, scr, lane); continue; } r -= I_O;
        if (r < I_UP) { const int nb = r % (DFF2 / 64), kb = r / (DFF2 / 64), n0 = 64 * nb, src = ((n0 >> 7) & 1) * DFF + 128 * (n0 >> 8) + (n0 & 127);
            transpose_tile64<true, 1>(P.w_up, DFF2, P.ffn_norm, (bf16*)(ws + WS_WUP), DM, n0, src, 64 * kb, scr, lane); continue; } r -= I_UP;
        { const int nb = r % (DM / 64), kb = r / (DM / 64); transpose_tile64<false, 1>(P.w_down, DM, nullptr, (bf16*)(ws + WS_WDOWN), DFF, 64 * nb, 64 * nb, 64 * kb, scr, lane); }
    }
    for (int m = gw; m < M; m += NGW) row_to_bf16(P.x + (size_t)m * DM, (bf16*)(ws + WS_HB), m, (float*)(ws + WS_SSQ0) + m, lane);
    for (int m = gw; m < BATCH * NMEM; m += NGW) row_to_bf16(P.mem + (size_t)m * DM, (bf16*)(ws + WS_MB), m, (float*)(ws + WS_SSQM) + m, lane);
    for (int idx = gw * 64 + lane; idx < SEQ * 64; idx += NGW * 64) {
        const int t = idx >> 6, i = idx & 63; const float angf = (float)t * INVF[i]; const double ang = (double)angf;
        const double kq = __builtin_rint(ang * 0.15915494309189535); const double rr = __builtin_fma(-kq, 6.283185307179586, ang) - kq * 2.4492935982947064e-16;
        const double r2 = rr * rr; double sn = 0.0, cs = 0.0;
#pragma unroll
        for (int k = 13; k >= 0; --k) { cs = cs * (-r2 / (double)((2 * k + 1) * (2 * k + 2))) + 1.0; sn = sn * (-r2 / (double)((2 * k + 2) * (2 * k + 3))) + 1.0; }
        ((float*)(ws + WS_COS))[idx] = (float)cs; ((float*)(ws + WS_SIN))[idx] = (float)(sn * rr);
    }
}
DI void stage_tile(LAS unsigned char* dst, int stride, const bf16* src, size_t ld, int rows, int tid) {
    for (int ch = tid; ch < rows * 16; ch += NWAVES * 64) { const int r = ch >> 4, c = ch & 15; const v4u v = *(const GAS v4u*)(src + (size_t)r * ld + c * 8); *(LAS v4u*)(dst + r * stride + c * 16) = v; }
}
DI bf16x8 tr_frag(LAS unsigned char* tile, int stride, int row0, int col0, int lane) {
    const int g = lane >> 4, i16 = lane & 15, q = i16 >> 2, p = i16 & 3, h = lane >> 5;
    LAS unsigned char* a = tile + (row0 + 4 * h + q) * stride + (col0 + 16 * (g & 1) + 4 * p) * 2;
    const s16x4 lo = __builtin_amdgcn_ds_read_tr16_b64_v4i16((LAS s16x4*)a);
    const s16x4 hi = __builtin_amdgcn_ds_read_tr16_b64_v4i16((LAS s16x4*)(a + 8 * stride));
    return __builtin_shufflevector(lo, hi, 0, 1, 2, 3, 4, 5, 6, 7);
}
DI f32x16 st_tile(LAS unsigned char* KT, int krow0, const bf16x8 (&qf)[8], int r, int h) {
    f32x16 acc;
#pragma unroll
    for (int i = 0; i < 16; ++i) acc[i] = 0.f;
#pragma unroll
    for (int ks = 0; ks < 8; ++ks) { const bf16x8 a = *(const LAS bf16x8*)(KT + (krow0 + r) * KSTR + (16 * ks + 8 * h) * 2); acc = MFMA32(a, qf[ks], acc); }
    return acc;
}
DI void load_qf(bf16x8 (&qf)[8], const bf16* qrowp, int h) {
#pragma unroll
    for (int ks = 0; ks < 8; ++ks) qf[ks] = *(const GAS bf16x8*)(qrowp + 16 * ks + 8 * h);
}

DI void ret_kv_unit(LAS unsigned char* lds, const bf16* PROJ, float* KVB, int unit, int tid) {
    const int lane = tid & 63, w = __builtin_amdgcn_readfirstlane(tid >> 6), r = lane & 31, h = lane >> 5;
    const int n = unit & 63, hd = (unit >> 6) & 15, b = unit >> 10;
    LAS unsigned char* KT = lds + L_KT; LAS unsigned char* VT = lds + L_VT;
    const size_t m0 = (size_t)b * SEQ + 128 * n;
    __syncthreads();
    stage_tile(KT, VSTR, PROJ + m0 * INW + C_RK + 128 * hd, INW, 128, tid);
    stage_tile(VT, VSTR, PROJ + m0 * INW + C_RV + 128 * hd, INW, 128, tid);
    __syncthreads();
    const int te = w >> 1, td0 = 2 * (w & 1);
    f32x16 acc[2];
#pragma unroll
    for (int t = 0; t < 2; ++t)
#pragma unroll
        for (int i = 0; i < 16; ++i) acc[t][i] = 0.f;
#pragma unroll
    for (int ks = 0; ks < 8; ++ks) {
        const bf16x8 a = tr_frag(VT, VSTR, 16 * ks, 32 * te, lane);
#pragma unroll
        for (int t = 0; t < 2; ++t) { const bf16x8 bb = tr_frag(KT, VSTR, 16 * ks, 32 * (td0 + t), lane); acc[t] = MFMA32(a, bb, acc[t]); }
    }
    const float sc = __expf(127.0f * LOGG[hd]);
    float* o = KVB + (size_t)unit * 16384;
#pragma unroll
    for (int t = 0; t < 2; ++t)
#pragma unroll
        for (int i = 0; i < 16; ++i) o[(32 * te + crow(i, h)) * 128 + 32 * (td0 + t) + r] = acc[t][i] * sc;
}
DI void ret_scan(const float* KVB, bf16* ST, int gt, int NT) {
    for (int idx = gt; idx < 32 * 4096; idx += NT) {
        const int bh = idx >> 12, e4 = idx & 4095; const float dec = __expf(128.0f * LOGG[bh & 15]);
        f32x4 S = {0.f, 0.f, 0.f, 0.f};
        for (int n = 0; n < 64; ++n) {
            const size_t off = ((size_t)(bh * 64 + n) * 4096 + e4) * 4;
            v2u w; w.x = pk_bf16(S[0], S[1]); w.y = pk_bf16(S[2], S[3]); *(GAS v2u*)(ST + off) = w;
            const f32x4 kv = *(const GAS f32x4*)(KVB + off); S = S * dec + kv;
        }
    }
}
DI void ret_out_unit(LAS unsigned char* lds, const bf16* PROJ, bf16* MIX, const bf16* ST, const float* gret, int unit, int tid) {
    const int lane = tid & 63, w = __builtin_amdgcn_readfirstlane(tid >> 6), r = lane & 31, h = lane >> 5, qg = w & 3, eh = w >> 2;
    const int n = unit & 63, hd = (unit >> 6) & 15, b = unit >> 10;
    LAS unsigned char* KT = lds + L_KT; LAS unsigned char* VT = lds + L_VT; LAS float* RED = (LAS float*)(lds + L_RED);
    const size_t m0 = (size_t)b * SEQ + 128 * n, qrow = m0 + 32 * qg + r;
    __syncthreads();
    stage_tile(KT, KSTR, PROJ + m0 * INW + C_RK + 128 * hd, INW, 128, tid);
    stage_tile(VT, VSTR, PROJ + m0 * INW + C_RV + 128 * hd, INW, 128, tid);
    bf16x8 qf[8]; load_qf(qf, PROJ + qrow * INW + C_RQ + 128 * hd, h);
    const bf16* st = ST + (size_t)unit * 16384;
    f32x16 O[2];
#pragma unroll
    for (int et = 0; et < 2; ++et) {
#pragma unroll
        for (int i = 0; i < 16; ++i) O[et][i] = 0.f;
#pragma unroll
        for (int ks = 0; ks < 8; ++ks) { const bf16x8 a = *(const GAS bf16x8*)(st + (32 * (2 * eh + et) + r) * 128 + 16 * ks + 8 * h); O[et] = MFMA32(a, qf[ks], O[et]); }
    }
    const float g1 = __expf(LOGG[hd]);
#pragma unroll
    for (int et = 0; et < 2; ++et) O[et] = O[et] * g1;
    __syncthreads();
    for (int kt = 0; kt <= qg; ++kt) {
        f32x16 s = st_tile(KT, 32 * kt, qf, r, h);
        if (kt == qg) {
#pragma unroll
            for (int i = 0; i < 16; ++i) s[i] = (crow(i, h) <= r) ? s[i] : 0.f;
        }
        bf16x8 pb[2];
#pragma unroll
        for (int s2 = 0; s2 < 2; ++s2) pb[s2] = pack8(s[8 * s2], s[8 * s2 + 1], s[8 * s2 + 2], s[8 * s2 + 3], s[8 * s2 + 4], s[8 * s2 + 5], s[8 * s2 + 6], s[8 * s2 + 7]);
#pragma unroll
        for (int et = 0; et < 2; ++et)
#pragma unroll
            for (int s2 = 0; s2 < 2; ++s2) O[et] = MFMA32(tr_frag(VT, VSTR, 32 * kt + 16 * s2, 32 * (2 * eh + et), lane), pb[s2], O[et]);
    }
    float ss = 0.f;
#pragma unroll
    for (int et = 0; et < 2; ++et)
#pragma unroll
        for (int i = 0; i < 16; ++i) ss += O[et][i] * O[et][i];
    ss += __shfl_xor(ss, 32);
    if (h == 0) RED[w * 32 + r] = ss;
    __syncthreads();
    const float rstd = rsqrtf((RED[w * 32 + r] + RED[(w ^ 4) * 32 + r]) * (1.0f / 128.0f) + EPSN);
    const bf16* orow = PROJ + qrow * INW + 128 * hd;
#pragma unroll
    for (int et = 0; et < 2; ++et)
#pragma unroll
        for (int G = 0; G < 4; ++G) {
            const int e = 32 * (2 * eh + et) + 8 * G + 4 * h;
            const f32x4 g = *(const f32x4*)(gret + e); const v2u gt = *(const GAS v2u*)(orow + C_RG + e);
            const float o0 = O[et][4 * G + 0] * rstd * g[0] * bf2f((unsigned short)(gt.x & 0xffff)), o1 = O[et][4 * G + 1] * rstd * g[1] * bf2f((unsigned short)(gt.x >> 16));
            const float o2 = O[et][4 * G + 2] * rstd * g[2] * bf2f((unsigned short)(gt.y & 0xffff)), o3 = O[et][4 * G + 3] * rstd * g[3] * bf2f((unsigned short)(gt.y >> 16));
            v2u wv; wv.x = pk_bf16(o0, o1); wv.y = pk_bf16(o2, o3); *(GAS v2u*)(MIX + pg8::blk_elem((int)qrow, 128 * hd + e, DM)) = wv;
        }
}
DI void sb_unit(LAS unsigned char* lds, const bf16* PROJ, bf16* MIX, const float* ssqsb, const float* gout, int unit, int tid) {
    const int lane = tid & 63, w = __builtin_amdgcn_readfirstlane(tid >> 6), r = lane & 31, h = lane >> 5;
    const int qb = unit & 31, hd = (unit >> 5) & 15, b = unit >> 9;
    LAS unsigned char* KT = lds + L_KT; LAS unsigned char* VT = lds + L_VT; LAS float* RK = (LAS float*)(lds + L_RK); LAS unsigned* FL = (LAS unsigned*)(lds + L_FL);
    const size_t m0 = (size_t)b * SEQ + 256 * qb, qrow = m0 + 32 * w + r;
    const int qlo = 256 * qb + 32 * w, qhi = qlo + 31, tq = qlo + r;
    bf16x8 qf[8]; load_qf(qf, PROJ + qrow * INW + C_SQ + 128 * hd, h);
    const f32x4 pq = *(const GAS f32x4*)(ssqsb + (qrow * 32 + hd) * 4);
    const float qscale = rsqrtf(hsum4(pq) * (1.0f / 128.0f) + EPSN) * 0.08838834764831845f;
    f32x16 O[4];
#pragma unroll
    for (int dt = 0; dt < 4; ++dt)
#pragma unroll
        for (int i = 0; i < 16; ++i) O[dt][i] = 0.f;
    float R = 0.f;
    for (int kb = 2 * qb + 1; kb >= 0; --kb) {
        __syncthreads();
        if (kb != 2 * qb + 1) { const unsigned all = FL[0] & FL[1] & FL[2] & FL[3] & FL[4] & FL[5] & FL[6] & FL[7]; if (all) break; }
        const size_t k0row = (size_t)b * SEQ + 128 * kb;
        stage_tile(KT, KSTR, PROJ + k0row * INW + C_SK + 128 * hd, INW, 128, tid);
        stage_tile(VT, VSTR, PROJ + k0row * INW + C_SV + 128 * hd, INW, 128, tid);
        if (tid < 128) { const f32x4 pk = *(const GAS f32x4*)(ssqsb + ((k0row + tid) * 32 + 16 + hd) * 4); RK[tid] = rsqrtf(hsum4(pk) * (1.0f / 128.0f) + EPSN); }
        __syncthreads();
        const int k0b = 128 * kb;
        if (k0b < qhi) {
            for (int st = 3; st >= 0; --st) {
                const int k0 = k0b + 32 * st;
                if (k0 >= qhi) continue;
                const f32x16 s = st_tile(KT, 32 * st, qf, r, h);
                const bool need_mask = (k0 + 31 >= qlo);
                float a[16];
#pragma unroll
                for (int G = 3; G >= 0; --G) {
                    const f32x4 rk = *(const LAS f32x4*)(RK + 32 * st + 8 * G + 4 * h);
                    float z[4], sp[4]; bool ok[4];
#pragma unroll
                    for (int j = 0; j < 4; ++j) {
                        z[j] = s[4 * G + j] * qscale * rk[j];
                        ok[j] = !need_mask || (k0 + 8 * G + 4 * h + j < tq);
                        const float spv = fmaxf(z[j], 0.f) + __logf(1.0f + __expf(-fabsf(z[j])));
                        sp[j] = ok[j] ? spv : 0.f;
                    }
                    const float l3 = sp[3], l2 = sp[2] + l3, l1 = sp[1] + l2, l0 = sp[0] + l1;
                    const float To = __shfl_xor(l0, 32);
                    const float off = h ? R : R + To;
                    a[4 * G + 0] = ok[0] ? __expf(z[0] - (off + l0)) : 0.f; a[4 * G + 1] = ok[1] ? __expf(z[1] - (off + l1)) : 0.f;
                    a[4 * G + 2] = ok[2] ? __expf(z[2] - (off + l2)) : 0.f; a[4 * G + 3] = ok[3] ? __expf(z[3] - (off + l3)) : 0.f;
                    R = R + (l0 + To);
                }
                bf16x8 pb[2];
#pragma unroll
                for (int s2 = 0; s2 < 2; ++s2) pb[s2] = pack8(a[8 * s2], a[8 * s2 + 1], a[8 * s2 + 2], a[8 * s2 + 3], a[8 * s2 + 4], a[8 * s2 + 5], a[8 * s2 + 6], a[8 * s2 + 7]);
#pragma unroll
                for (int dt = 0; dt < 4; ++dt)
#pragma unroll
                    for (int s2 = 0; s2 < 2; ++s2) O[dt] = MFMA32(tr_frag(VT, VSTR, 32 * st + 16 * s2, 32 * dt, lane), pb[s2], O[dt]);
            }
        }
        const bool done = __all(R > SB_EXIT);
        if (lane == 0) FL[w] = done ? 1u : 0u;
    }
    float ss = 0.f;
#pragma unroll
    for (int dt = 0; dt < 4; ++dt)
#pragma unroll
        for (int i = 0; i < 16; ++i) ss += O[dt][i] * O[dt][i];
    ss += __shfl_xor(ss, 32);
    const float rstd = rsqrtf(ss * (1.0f / 128.0f) + EPSN);
#pragma unroll
    for (int dt = 0; dt < 4; ++dt)
#pragma unroll
        for (int G = 0; G < 4; ++G) {
            const int d = 32 * dt + 8 * G + 4 * h; const f32x4 g = *(const f32x4*)(gout + d);
            v2u wv; wv.x = pk_bf16(O[dt][4 * G] * rstd * g[0], O[dt][4 * G + 1] * rstd * g[1]); wv.y = pk_bf16(O[dt][4 * G + 2] * rstd * g[2], O[dt][4 * G + 3] * rstd * g[3]);
            *(GAS v2u*)(MIX + pg8::blk_elem((int)qrow, 2048 + 128 * hd + d, DM)) = wv;
        }
}
DI void cross_stage(LAS unsigned char* lds, const float* CKV, const float* gk, LAS float* RKc, int b, int ch, int kh, bool withV, int tid) {
    for (int chn = tid; chn < 128 * 16; chn += NWAVES * 64) {
        const int rr = chn >> 4, c = chn & 15; const float* src = CKV + (size_t)(b * NMEM + 128 * kh + rr) * (2 * CW) + 128 * ch + 8 * c;
        const f32x4 a0 = *(const GAS f32x4*)src, a1 = *(const GAS f32x4*)(src + 4); const f32x4 g0 = *(const f32x4*)(gk + 8 * c), g1 = *(const f32x4*)(gk + 8 * c + 4); const float rs = RKc[128 * kh + rr];
        v4u o; o.x = pk_bf16(a0[0] * rs * g0[0], a0[1] * rs * g0[1]); o.y = pk_bf16(a0[2] * rs * g0[2], a0[3] * rs * g0[3]); o.z = pk_bf16(a1[0] * rs * g1[0], a1[1] * rs * g1[1]); o.w = pk_bf16(a1[2] * rs * g1[2], a1[3] * rs * g1[3]);
        *(LAS v4u*)(lds + L_KT + rr * KSTR + c * 16) = o;
        if (withV) { const f32x4 v0 = *(const GAS f32x4*)(src + CW), v1 = *(const GAS f32x4*)(src + CW + 4);
            v4u ov; ov.x = pk_bf16(v0[0], v0[1]); ov.y = pk_bf16(v0[2], v0[3]); ov.z = pk_bf16(v1[0], v1[1]); ov.w = pk_bf16(v1[2], v1[3]);
            *(LAS v4u*)(lds + L_VT + rr * VSTR + c * 16) = ov; }
    }
}
DI void cross_unit(LAS unsigned char* lds, const float* CQ, const float* CKV, const float* gq, const float* gk, bf16* CO, int unit, int tid) {
    const int lane = tid & 63, w = __builtin_amdgcn_readfirstlane(tid >> 6), r = lane & 31, h = lane >> 5;
    const int qb = unit & 31, ch = (unit >> 5) & 3, b = unit >> 7;
    LAS unsigned char* KT = lds + L_KT; LAS unsigned char* VT = lds + L_VT; LAS float* RKc = (LAS float*)(lds + L_RK);
    const size_t qrow = (size_t)b * SEQ + 256 * qb + 32 * w + r;
    __syncthreads();
    {
        const int key = tid >> 1, half = tid & 1; const float* src = CKV + (size_t)(b * NMEM + key) * (2 * CW) + 128 * ch + 64 * half; float s = 0.f;
#pragma unroll
        for (int j = 0; j < 16; ++j) { const f32x4 v = *(const GAS f32x4*)(src + 4 * j); s += (v.x * v.x + v.y * v.y) + (v.z * v.z + v.w * v.w); }
        s += __shfl_xor(s, 1);
        if (half == 0) RKc[key] = rsqrtf(s * (1.0f / 128.0f) + EPSN);
    }
    bf16x8 qf[8];
    {
        const float* qp = CQ + qrow * CW + 128 * ch; f32x4 qv[8][2]; float s = 0.f;
#pragma unroll
        for (int ks = 0; ks < 8; ++ks) { qv[ks][0] = *(const GAS f32x4*)(qp + 16 * ks + 8 * h); qv[ks][1] = *(const GAS f32x4*)(qp + 16 * ks + 8 * h + 4);
            s += (qv[ks][0].x * qv[ks][0].x + qv[ks][0].y * qv[ks][0].y) + (qv[ks][0].z * qv[ks][0].z + qv[ks][0].w * qv[ks][0].w) + (qv[ks][1].x * qv[ks][1].x + qv[ks][1].y * qv[ks][1].y) + (qv[ks][1].z * qv[ks][1].z + qv[ks][1].w * qv[ks][1].w); }
        s += __shfl_xor(s, 32);
        const float rs = rsqrtf(s * (1.0f / 128.0f) + EPSN) * 0.08838834764831845f;
#pragma unroll
        for (int ks = 0; ks < 8; ++ks) { const f32x4 g0 = *(const f32x4*)(gq + 16 * ks + 8 * h), g1 = *(const f32x4*)(gq + 16 * ks + 8 * h + 4); const f32x4 a0 = qv[ks][0] * g0 * rs, a1 = qv[ks][1] * g1 * rs;
            qf[ks] = pack8(a0[0], a0[1], a0[2], a0[3], a1[0], a1[1], a1[2], a1[3]); }
    }
    __syncthreads();
    float mx = -3.0e38f;
    for (int kh = 0; kh < 2; ++kh) {
        if (kh) __syncthreads();
        cross_stage(lds, CKV, gk, RKc, b, ch, kh, false, tid);
        __syncthreads();
#pragma unroll 1
        for (int st = 0; st < 4; ++st) { const f32x16 s = st_tile(KT, 32 * st, qf, r, h);
#pragma unroll
            for (int i = 0; i < 16; ++i) mx = fmaxf(mx, s[i]); }
    }
    mx = fmaxf(mx, __shfl_xor(mx, 32));
    f32x16 O[4]; float lsum = 0.f;
#pragma unroll
    for (int dt = 0; dt < 4; ++dt)
#pragma unroll
        for (int i = 0; i < 16; ++i) O[dt][i] = 0.f;
    for (int kh = 0; kh < 2; ++kh) {
        __syncthreads();
        cross_stage(lds, CKV, gk, RKc, b, ch, kh, true, tid);
        __syncthreads();
#pragma unroll 1
        for (int st = 0; st < 4; ++st) {
            const f32x16 s = st_tile(KT, 32 * st, qf, r, h); float p[16];
#pragma unroll
            for (int i = 0; i < 16; ++i) { p[i] = __expf(s[i] - mx); lsum += p[i]; }
            bf16x8 pb[2];
#pragma unroll
            for (int s2 = 0; s2 < 2; ++s2) pb[s2] = pack8(p[8 * s2], p[8 * s2 + 1], p[8 * s2 + 2], p[8 * s2 + 3], p[8 * s2 + 4], p[8 * s2 + 5], p[8 * s2 + 6], p[8 * s2 + 7]);
#pragma unroll
            for (int dt = 0; dt < 4; ++dt)
#pragma unroll
                for (int s2 = 0; s2 < 2; ++s2) O[dt] = MFMA32(tr_frag(VT, VSTR, 32 * st + 16 * s2, 32 * dt, lane), pb[s2], O[dt]);
        }
    }
    lsum += __shfl_xor(lsum, 32);
    const float inv = 1.0f / lsum;
#pragma unroll
    for (int dt = 0; dt < 4; ++dt)
#pragma unroll
        for (int G = 0; G < 4; ++G) { const int d = 32 * dt + 8 * G + 4 * h;
            v2u wv; wv.x = pk_bf16(O[dt][4 * G] * inv, O[dt][4 * G + 1] * inv); wv.y = pk_bf16(O[dt][4 * G + 2] * inv, O[dt][4 * G + 3] * inv); *(GAS v2u*)(CO + pg8::blk_elem((int)qrow, 128 * ch + d, CW)) = wv; }
}
DI void ld8(const bf16* p, float (&o)[8]) { const v4u a = *(const GAS v4u*)p; const unsigned aw[4] = {a.x, a.y, a.z, a.w};
#pragma unroll
    for (int e = 0; e < 4; ++e) { o[2 * e] = bf2f((unsigned short)(aw[e] & 0xffff)); o[2 * e + 1] = bf2f((unsigned short)(aw[e] >> 16)); } }
DI void ffn_fix(const bf16* UB, bf16* ACT, const float* cw, const float* cb, int gt, int NT) {
    constexpr int NC = DFF / 8;
    for (int it = gt; it < (M / 64) * 2 * NC; it += NT) {
        const int cc = it % NC, rr = it / NC, rho = rr & 1, blk = rr >> 1, n0 = 8 * cc; const bool first = (blk & 127) == 0;
        const bf16* cur = UB + ((size_t)blk * 4 + rho) * DFF2; const bf16* prv = UB + ((size_t)(blk - 1) * 4) * DFF2;
        const bf16* p1 = rho ? UB + ((size_t)blk * 4) * DFF2 : prv + 3 * (size_t)DFF2;
        const bf16* p2 = rho ? prv + 3 * (size_t)DFF2 : prv + 2 * (size_t)DFF2;
        const bool z1 = (rho == 0) && first, z2 = first;
        float o[2][8];
#pragma unroll
        for (int hf = 0; hf < 2; ++hf) {
            const int col = hf * DFF + n0; float x0[8], x1[8], x2[8];
            ld8(cur + col, x0);
            if (!z1) ld8(p1 + col, x1); else {
#pragma unroll
                for (int e = 0; e < 8; ++e) x1[e] = 0.f; }
            if (!z2) ld8(p2 + col, x2); else {
#pragma unroll
                for (int e = 0; e < 8; ++e) x2[e] = 0.f; }
#pragma unroll
            for (int e = 0; e < 8; ++e) o[hf][e] = cb[col + e] + cw[col + e] * x2[e] + cw[(size_t)DFF2 + col + e] * x1[e] + cw[2 * (size_t)DFF2 + col + e] * x0[e];
        }
        float a[8];
#pragma unroll
        for (int e = 0; e < 8; ++e) a[e] = o[0][e] * __builtin_amdgcn_rcpf(1.0f + __expf(-o[0][e])) * o[1][e];
        v4u ov; ov.x = pk_bf16(a[0], a[1]); ov.y = pk_bf16(a[2], a[3]); ov.z = pk_bf16(a[4], a[5]); ov.w = pk_bf16(a[6], a[7]);
        *(GAS v4u*)(ACT + pg8::blk_elem(blk * 64 + rho, n0, DFF)) = ov;
    }
}
struct Args { Ptrs p; int ph_lo, ph_hi; };
constexpr int N_PHASES = 12;
__global__ void __launch_bounds__(NWAVES * 64, 2) mk_fwd(Args args) {
    extern __shared__ __attribute__((aligned(16))) unsigned char lds_raw[];
    LAS unsigned char* lds = (LAS unsigned char*)lds_raw;
    volatile LAS unsigned* MISC = (volatile LAS unsigned*)(lds + MISC_OFF);
    const int tid = threadIdx.x, lane = tid & 63, wave = __builtin_amdgcn_readfirstlane(tid >> 6);
    const int G = gridDim.x, bx = blockIdx.x;
    const Ptrs& P = args.p; unsigned char* ws = P.ws;
    gu32* ctl = (gu32*)(ws + WS_CTL);
    for (int u = tid; u < (LDS_BYTES - LDSCTL_OFF) / 4; u += NWAVES * 64) ((LAS unsigned*)(lds + LDSCTL_OFF))[u] = 0u;
    __syncthreads();
    XcdBarrier bar = xcd_barrier_post((unsigned*)(ctl + CW_BAR), MISC + 8);
    const int lo = args.ph_lo, hi = args.ph_hi;
#ifndef PHMASK
#define PHMASK 0xffff
#endif
#define IN(k) (((PHMASK >> (k)) & 1) && lo <= (k) && (k) < hi)
#define SEAM(k) do { if (IN(k) && IN((k) + 1)) xcd_barrier(bar); } while (0)
    bf16* HB = (bf16*)(ws + WS_HB); bf16* PROJ = (bf16*)(ws + WS_PROJ);
    const int gw = bx * NWAVES + wave, NGW = G * NWAVES, gt = bx * NWAVES * 64 + tid, NT = G * NWAVES * 64;

    if (IN(0)) { p0_prologue(P, lds, gw, NGW, wave, lane); }
    SEAM(0);
    if (IN(1)) {
        pg8::Gemm g{HB, (const bf16*)(ws + WS_WIN), M, INW, DM, DM}; pg8::StaticOrder S; S.init(M, INW, G, bx);
        pg8::EpiProj E{PROJ, (const float*)(ws + WS_SSQ0), (const float*)(ws + WS_COS), (const float*)(ws + WS_SIN), P.sbq_norm, P.sbk_norm, (float*)(ws + WS_SSQSB)};
        pg8::gemm_phase<pg8::EpiProj, pg8::StaticOrder, true, true>(lds, g, S, E);
    }
    SEAM(1);
    if (IN(2)) { for (int u = bx; u < 2048; u += G) ret_kv_unit(lds, PROJ, (float*)(ws + WS_KV), u, tid); }
    SEAM(2);
    if (IN(3)) { ret_scan((const float*)(ws + WS_KV), (bf16*)(ws + WS_ST), gt, NT); }
    SEAM(3);
    if (IN(4)) {
        for (int u = bx; u < 1024; u += G) sb_unit(lds, PROJ, (bf16*)(ws + WS_MIX), (const float*)(ws + WS_SSQSB), P.sbo_norm, u, tid);
        for (int u = bx; u < 2048; u += G) ret_out_unit(lds, PROJ, (bf16*)(ws + WS_MIX), (const bf16*)(ws + WS_ST), P.ret_norm, u, tid);
        __syncthreads();
    }
    SEAM(4);
    if (IN(5)) {
        pg8::Gemm g{(const bf16*)(ws + WS_MIX), (const bf16*)(ws + WS_WOUT), M, DM, DM, DM}; pg8::StaticOrder S; S.init(M, DM, G, bx);
        pg8::EpiRes<true> E{P.x, P.out, HB, (float*)(ws + WS_SSQ1)};
        pg8::gemm_phase<pg8::EpiRes<true>, pg8::StaticOrder, true, true>(lds, g, S, E);
    }
    SEAM(5);
    if (IN(6)) {
        { pg8::Gemm g{HB, (const bf16*)(ws + WS_WQKV), M, CW, DM, DM}; pg8::StaticOrder S; S.init(M, CW, G, bx);
          pg8::EpiScaleF32 E{(float*)(ws + WS_CQ), CW, (const float*)(ws + WS_SSQ1)};
          pg8::gemm_phase<pg8::EpiScaleF32, pg8::StaticOrder, true, true>(lds, g, S, E); }
        __syncthreads();
        { pg8::Gemm g{(const bf16*)(ws + WS_MB), (const bf16*)(ws + WS_WQKV) + (size_t)CW * DM, BATCH * NMEM, 2 * CW, DM, DM}; pg8::StaticOrder S; S.init(BATCH * NMEM, 2 * CW, G, (bx + G / 2) % G);
          pg8::EpiScaleF32 E{(float*)(ws + WS_CKV), 2 * CW, (const float*)(ws + WS_SSQM)};
          pg8::gemm_phase<pg8::EpiScaleF32, pg8::StaticOrder, true, true>(lds, g, S, E); }
    }
    SEAM(6);
    if (IN(7)) { for (int u = bx; u < 256; u += G) cross_unit(lds, (const float*)(ws + WS_CQ), (const float*)(ws + WS_CKV), P.cq_norm, P.ck_norm, (bf16*)(ws + WS_CO), u, tid); __syncthreads(); }
    SEAM(7);
    if (IN(8)) {
        pg8::Gemm g{(const bf16*)(ws + WS_CO), (const bf16*)(ws + WS_WO), M, DM, CW, CW}; pg8::StaticOrder S; S.init(M, DM, G, bx);
        pg8::EpiRes<true> E{P.out, P.out, HB, (float*)(ws + WS_SSQ2)};
        pg8::gemm_phase<pg8::EpiRes<true>, pg8::StaticOrder, true, true>(lds, g, S, E);
    }
    SEAM(8);
    if (IN(9)) {
        pg8::Gemm g{HB, (const bf16*)(ws + WS_WUP), M, DFF2, DM, DM}; pg8::StaticOrder S; S.init(M, DFF2, G, bx);
        pg8::EpiFfn E{(bf16*)(ws + WS_ACT), (bf16*)(ws + WS_UB), (const float*)(ws + WS_SSQ2), P.conv_w, P.conv_b, (LAS float*)(lds + L_EPIW + wave * 1024)};
        pg8::gemm_phase<pg8::EpiFfn, pg8::StaticOrder, true, true>(lds, g, S, E);
    }
    SEAM(9);
    if (IN(10)) { ffn_fix((const bf16*)(ws + WS_UB), (bf16*)(ws + WS_ACT), P.conv_w, P.conv_b, gt, NT); }
    SEAM(10);
    if (IN(11)) {
        pg8::Gemm g{(const bf16*)(ws + WS_ACT), (const bf16*)(ws + WS_WDOWN), M, DM, DFF, DFF}; pg8::StaticOrder S; S.init(M, DM, G, bx);
        pg8::EpiRes<false> E{P.out, P.out, nullptr, nullptr};
        pg8::gemm_phase<pg8::EpiRes<false>, pg8::StaticOrder, true, true>(lds, g, S, E);
    }
#undef IN
#undef SEAM
}

#ifndef MK_CUTS
#define MK_CUTS 0
#endif
extern "C" void kernel_launch(void* const* d_in, const int* in_sizes, int n_in, void* d_out, int out_size, void* d_ws, size_t ws_size, hipStream_t stream) {
    static int grid = 0;
    if (grid == 0) {
        if (n_in != 21 || in_sizes[0] != M * DM || out_size != M * DM || ws_size < WS_END) { fprintf(stderr, "kernel_launch: unexpected shapes (n_in %d, in0 %d, out %d, ws %zu < %zu); nothing launched\n", n_in, n_in > 0 ? in_sizes[0] : -1, out_size, ws_size, (size_t)WS_END); grid = -1; return; }
        int dev = 0, cus = 0, per_cu = 0;
        if (hipGetDevice(&dev) != hipSuccess || hipDeviceGetAttribute(&cus, hipDeviceAttributeMultiprocessorCount, dev) != hipSuccess) { grid = -1; return; }
        if (hipFuncSetAttribute((const void*)mk_fwd, hipFuncAttributeMaxDynamicSharedMemorySize, LDS_BYTES) != hipSuccess) { fprintf(stderr, "kernel_launch: hipFuncSetAttribute failed\n"); grid = -1; return; }
        if (hipOccupancyMaxActiveBlocksPerMultiprocessor(&per_cu, (const void*)mk_fwd, NWAVES * 64, LDS_BYTES) != hipSuccess || per_cu < 1) fprintf(stderr, "kernel_launch: note: occupancy query reports %d\n", per_cu);
        (void)hipGetLastError();
        grid = cus;
    }
    if (grid < 0) return;
    if (hipMemsetAsync((char*)d_ws + WS_CTL, 0, CTL_ZERO_BYTES, stream) != hipSuccess) return;
    Args a{};
    const float** pp = (const float**)&a.p;
    for (int i = 0; i < 21; ++i) pp[i] = (const float*)d_in[i];
    a.p.out = (float*)d_out; a.p.ws = (unsigned char*)d_ws;
#if MK_CUTS
    for (int ph = 0; ph < N_PHASES; ++ph) { a.ph_lo = ph; a.ph_hi = ph + 1; hipLaunchKernelGGL(mk_fwd, dim3(grid), dim3(NWAVES * 64), LDS_BYTES, stream, a); }
#else
    a.ph_lo = 0; a.ph_hi = N_PHASES;
    hipLaunchKernelGGL(mk_fwd, dim3(grid), dim3(NWAVES * 64), LDS_BYTES, stream, a);
#endif
    const hipError_t le = hipPeekAtLastError();
    if (le != hipSuccess) fprintf(stderr, "kernel_launch: launch failed: %s\n", hipGetErrorName(le));
}
```

```cpp
#include <hip/hip_runtime.h>
#include <cstdio>
#include <cstdint>
namespace pg8 {
#define PG8_LAS __attribute__((address_space(3)))
typedef unsigned short bf16_t;
typedef short bf16x8 __attribute__((ext_vector_type(8)));
typedef float f32x4 __attribute__((ext_vector_type(4)));
typedef unsigned u32x4 __attribute__((ext_vector_type(4)));
typedef unsigned u32x2 __attribute__((ext_vector_type(2)));
constexpr int BM = 256, BK = 64, HALF = 128, HTB = HALF * BK * 2  , STAGE_BYTES = 8 * HTB, NXCD = 8, WGM = 8;

__host__ __device__ __forceinline__ int lds_byte(int r, int c) { const int st = (r >> 4) * 2 + (c >> 5), rr = r & 15, cc = c & 31, ob = rr * 64 + cc * 2; return st * 1024 + (ob ^ (((ob >> 9) & 1) << 5)); }
__host__ __device__ __forceinline__ void stage_rc(int b, int& R, int& C) { const int st = b / 1024, sb = b % 1024, swz = sb ^ (((sb >> 9) & 1) << 5); R = (st >> 1) * 16 + swz / 64; C = (st & 1) * 32 + (swz % 64) / 2; }
__host__ __device__ __forceinline__ int perm32(int rho) { const int n = rho >> 4, i = rho & 15; return 8 * (i >> 2) + 4 * n + (i & 3); }
template <int PERM> __host__ __device__ __forceinline__ int permrow(int R) {
    if (PERM == 1) return (R & ~31) + perm32(R & 31);
    if (PERM == 2) return 64 * ((R >> 4) & 1) + 16 * (R >> 5) + (R & 15);
    return R;
}

template <int PERM> __host__ __device__ __forceinline__ int invpermrow(int d) {
    if (PERM == 1) { const int c = d & 31; return (d & ~31) + 16 * ((c >> 2) & 1) + 4 * (c >> 3) + (c & 3); }
    if (PERM == 2) return 32 * ((d >> 4) & 3) + 16 * (d >> 6) + (d & 15);
    return d;
}
__host__ __device__ __forceinline__ size_t blk_elem(int row, int col, int C) {
    return ((size_t)((row >> 8) * (C >> 6) + (col >> 6)) * 32768 + (size_t)(((row >> 7) & 1) * 16384 + lds_byte(row & 127, col & 63))) >> 1;
}

struct Unit { int pm, pn; };
struct Gemm { const bf16_t* A; const bf16_t* Bt; int M, N, K, lda; };

struct StaticOrder {
    int nM, nN, nwg, G, c, pm0;
    __host__ __device__ void init(int M, int N, int G_, int c_, int pm0_ = 0) { nM = M / BM; nN = N / BM; nwg = nM * nN; G = G_; c = c_; pm0 = pm0_; }
    __host__ __device__ bool next(int i, Unit& u) const {
        const long L = (long)i * G + c; if (L >= nwg) return false;
        int wgid = (int)L; { const int q = nwg / NXCD, r = nwg % NXCD, xcd = wgid % NXCD, off = wgid / NXCD; wgid = (xcd < r ? xcd * (q + 1) : r * (q + 1) + (xcd - r) * q) + off; }
        const int nig = WGM * nN, gid = wgid / nig, fm = gid * WGM, gsz = (nM - fm) < WGM ? (nM - fm) : WGM;
        u.pm = pm0 + fm + ((wgid % nig) % gsz); u.pn = (wgid % nig) / gsz; return true;
    }
    __device__ __forceinline__ void a_ready(const Unit&) const {}
    __device__ __forceinline__ void done(const Unit&) const {}
};

typedef float f32x2 __attribute__((ext_vector_type(2)));
typedef __bf16 bf16v2 __attribute__((ext_vector_type(2)));
__device__ __forceinline__ unsigned pk_bf16(float lo, float hi) { const f32x2 f = {lo, hi}; const bf16v2 r = __builtin_convertvector(f, bf16v2); return __builtin_bit_cast(unsigned, r); }
constexpr float EPSN = 1e-6f;
__constant__ float LOGG[16] = { -3.174869716e-02f, -1.574835740e-02f, -7.843177766e-03f, -3.913899418e-03f, -1.955034910e-03f, -9.770396864e-04f, -4.884005175e-04f, -2.441704273e-04f,
                                -1.220777631e-04f, -6.103701890e-05f, -3.051804379e-05f, -1.525890548e-05f, -7.629423635e-06f, -3.814704542e-06f, -1.907350452e-06f, -9.536747712e-07f };
__device__ __forceinline__ float hsum4(const f32x4 v) { return (v[0] + v[1]) + (v[2] + v[3]); }
__device__ __forceinline__ float dot4(const f32x4 a, const f32x4 b) { return (a[0] * b[0] + a[1] * b[1]) + (a[2] * b[2] + a[3] * b[3]); }
__device__ __forceinline__ float row_rstd64(const float* part, int row, int fq, float invn) {
    const f32x4* p = (const f32x4*)(part + (size_t)row * 64 + fq * 16);
    float s = (hsum4(p[0]) + hsum4(p[1])) + (hsum4(p[2]) + hsum4(p[3]));
    s += __shfl_xor(s, 16); s += __shfl_xor(s, 32);
    return rsqrtf(s * invn + EPSN);
}

#define EPI_FENCE() asm volatile("" ::: "memory")
struct EpiProj {
    static constexpr int PERM = 2; static constexpr bool AFTER_DRAIN = false;
    bf16_t* P; const float* ssq0; const float* cosT; const float* sinT; const float* gq; const float* gk; float* ssqsb;
    template <int REG> __device__ __forceinline__ void body(const f32x4 (&acc)[2][2][4][2], const Unit& u, int wr, int wc, int fr, int fq) const {
        constexpr bool ROPE = (REG == 0 || REG == 2);
        const int pnr = u.pn & 7, d0 = 16 * wc + 4 * fq, rowb = u.pm * BM + wr * 64 + fr;
        float lg[2] = {0.f, 0.f}; f32x4 g0 = {1.f, 1.f, 1.f, 1.f}, g1 = g0;
        if (ROPE) { lg[0] = LOGG[2 * pnr]; lg[1] = LOGG[2 * pnr + 1]; }
        if (REG == 1 || REG == 5) { const float* g = (REG == 1) ? gq : gk; g0 = *(const f32x4*)(g + d0); g1 = *(const f32x4*)(g + 64 + d0); }
        float rsv[8];
#pragma unroll
        for (int g = 0; g < 8; ++g) rsv[g] = ssq0[rowb + (g >> 2) * HALF + (g & 3) * 16];
        f32x4 csn = {0.f, 0.f, 0.f, 0.f}, snn = csn;
        if (ROPE) { const int t = rowb & 8191; csn = *(const f32x4*)(cosT + (size_t)t * 64 + d0); snn = *(const f32x4*)(sinT + (size_t)t * 64 + d0); }
        EPI_FENCE();
#pragma unroll
        for (int g = 0; g < 8; ++g) {
            const int ai = g >> 2, m = g & 3;
            const int row = rowb + ai * HALF + m * 16;
            const float rs = rsqrtf(rsv[g] * (1.0f / 4096.0f) + EPSN);
            const int t = row & 8191; const float cpos = (float)(t & 127);
            const f32x4 cs = csn, sn = snn;
            if (ROPE && g < 7) { const int tn = (rowb + ((g + 1) >> 2) * HALF + ((g + 1) & 3) * 16) & 8191; csn = *(const f32x4*)(cosT + (size_t)tn * 64 + d0); snn = *(const f32x4*)(sinT + (size_t)tn * 64 + d0); }
            EPI_FENCE();
            bf16_t* rowp = P + (size_t)row * 14336 + u.pn * BM + d0;
#pragma unroll
            for (int bj = 0; bj < 2; ++bj) {
                const f32x4 v0 = acc[ai][bj][m][0] * rs, v1 = acc[ai][bj][m][1] * rs;
                f32x4 o0 = v0, o1 = v1;
                if (REG == 0) { const float sc = 0.08838834764831845f * __expf(cpos * lg[bj]); o0 = (v0 * cs - v1 * sn) * sc; o1 = (v1 * cs + v0 * sn) * sc; }
                if (REG == 2) { const float sc = __expf(-cpos * lg[bj]); o0 = (v0 * cs - v1 * sn) * sc; o1 = (v1 * cs + v0 * sn) * sc; }
                if (REG == 4) {
#pragma unroll
                    for (int j = 0; j < 4; ++j) { o0[j] = v0[j] * __builtin_amdgcn_rcpf(1.0f + __expf(-v0[j])); o1[j] = v1[j] * __builtin_amdgcn_rcpf(1.0f + __expf(-v1[j])); } }
                if (REG == 1 || REG == 5) {
                    float s = dot4(v0, v0) + dot4(v1, v1); s += __shfl_xor(s, 16); s += __shfl_xor(s, 32);
                    if (fq == 0) ssqsb[((size_t)row * 32 + (REG == 1 ? 0 : 16) + 2 * pnr + bj) * 4 + wc] = s;
                    o0 = v0 * g0; o1 = v1 * g1; }
                u32x2 w0, w1; w0.x = pk_bf16(o0[0], o0[1]); w0.y = pk_bf16(o0[2], o0[3]); w1.x = pk_bf16(o1[0], o1[1]); w1.y = pk_bf16(o1[2], o1[3]);
                *(u32x2*)(rowp + bj * HALF) = w0; *(u32x2*)(rowp + bj * HALF + 64) = w1;
            }
        }
    }
    __device__ __forceinline__ void operator()(const f32x4 (&acc)[2][2][4][2], const Unit& u, int wr, int wc, int fr, int fq) const {
        const int reg = u.pn >> 3;
        if (reg == 0) body<0>(acc, u, wr, wc, fr, fq); else if (reg == 1) body<1>(acc, u, wr, wc, fr, fq); else if (reg == 2) body<2>(acc, u, wr, wc, fr, fq);
        else if (reg == 4) body<4>(acc, u, wr, wc, fr, fq); else if (reg == 5) body<5>(acc, u, wr, wc, fr, fq); else body<3>(acc, u, wr, wc, fr, fq);
    }
};

template <bool WITH_HB> struct EpiRes {
    static constexpr int PERM = 1; static constexpr bool AFTER_DRAIN = false;
    const float* base; float* out; bf16_t* hb; float* ssq;
    __device__ __forceinline__ void operator()(const f32x4 (&acc)[2][2][4][2], const Unit& u, int wr, int wc, int fr, int fq) const {
        const int col0 = u.pn * BM + wc * 32 + 8 * fq, rowb = u.pm * BM + wr * 64 + fr;
        f32x4 bn[2][2];
#pragma unroll
        for (int bj = 0; bj < 2; ++bj) { const size_t off = (size_t)rowb * 4096 + col0 + bj * HALF; bn[bj][0] = *(const f32x4*)(base + off); bn[bj][1] = *(const f32x4*)(base + off + 4); }
#pragma unroll
        for (int g = 0; g < 8; ++g) {
            const int ai = g >> 2, m = g & 3, row = rowb + ai * HALF + m * 16; float s = 0.f;
            f32x4 b[2][2];
#pragma unroll
            for (int bj = 0; bj < 2; ++bj) { b[bj][0] = bn[bj][0]; b[bj][1] = bn[bj][1]; }
            if (g < 7) { const int rown = rowb + ((g + 1) >> 2) * HALF + ((g + 1) & 3) * 16;
#pragma unroll
                for (int bj = 0; bj < 2; ++bj) { const size_t off = (size_t)rown * 4096 + col0 + bj * HALF; bn[bj][0] = *(const f32x4*)(base + off); bn[bj][1] = *(const f32x4*)(base + off + 4); } }
            EPI_FENCE();
#pragma unroll
            for (int bj = 0; bj < 2; ++bj) {
                const size_t off = (size_t)row * 4096 + col0 + bj * HALF;
                const f32x4 o0 = b[bj][0] + acc[ai][bj][m][0], o1 = b[bj][1] + acc[ai][bj][m][1];
                *(f32x4*)(out + off) = o0; *(f32x4*)(out + off + 4) = o1;
                if (WITH_HB) { u32x4 w; w.x = pk_bf16(o0[0], o0[1]); w.y = pk_bf16(o0[2], o0[3]); w.z = pk_bf16(o1[0], o1[1]); w.w = pk_bf16(o1[2], o1[3]); *(u32x4*)(hb + blk_elem(row, col0 + bj * HALF, 4096)) = w; s += dot4(o0, o0) + dot4(o1, o1); }
            }
            if (WITH_HB) { s += __shfl_xor(s, 16); s += __shfl_xor(s, 32); if (fq == 0) __hip_atomic_fetch_add(ssq + row, s, __ATOMIC_RELAXED, __HIP_MEMORY_SCOPE_AGENT); }
            EPI_FENCE();
        }
    }
};

struct EpiScaleF32 {
    static constexpr int PERM = 1; static constexpr bool AFTER_DRAIN = false;
    float* C; int ldc; const float* ssq;
    __device__ __forceinline__ void operator()(const f32x4 (&acc)[2][2][4][2], const Unit& u, int wr, int wc, int fr, int fq) const {
        const int col0 = u.pn * BM + wc * 32 + 8 * fq, rowb = u.pm * BM + wr * 64 + fr;
        float rsv[8];
#pragma unroll
        for (int g = 0; g < 8; ++g) rsv[g] = ssq[rowb + (g >> 2) * HALF + (g & 3) * 16];
        EPI_FENCE();
#pragma unroll
        for (int g = 0; g < 8; ++g) {
            const int ai = g >> 2, m = g & 3, row = rowb + ai * HALF + m * 16; const float rs = rsqrtf(rsv[g] * (1.0f / 4096.0f) + EPSN);
#pragma unroll
            for (int bj = 0; bj < 2; ++bj) { float* p = C + (size_t)row * ldc + col0 + bj * HALF; *(f32x4*)p = acc[ai][bj][m][0] * rs; *(f32x4*)(p + 4) = acc[ai][bj][m][1] * rs; }
        }
    }
};
struct EpiScaleBf16 {
    static constexpr int PERM = 1; static constexpr bool AFTER_DRAIN = false;
    bf16_t* O; int ldc; const float* ssq;
    __device__ __forceinline__ void operator()(const f32x4 (&acc)[2][2][4][2], const Unit& u, int wr, int wc, int fr, int fq) const {
        const int col0 = u.pn * BM + wc * 32 + 8 * fq, rowb = u.pm * BM + wr * 64 + fr;
        float rsv[8];
#pragma unroll
        for (int g = 0; g < 8; ++g) rsv[g] = ssq[rowb + (g >> 2) * HALF + (g & 3) * 16];
        EPI_FENCE();
#pragma unroll
        for (int g = 0; g < 8; ++g) {
            const int ai = g >> 2, m = g & 3, row = rowb + ai * HALF + m * 16; const float rs = rsqrtf(rsv[g] * (1.0f / 4096.0f) + EPSN);
#pragma unroll
            for (int bj = 0; bj < 2; ++bj) { const f32x4 v0 = acc[ai][bj][m][0] * rs, v1 = acc[ai][bj][m][1] * rs;
                u32x4 w; w.x = pk_bf16(v0[0], v0[1]); w.y = pk_bf16(v0[2], v0[3]); w.z = pk_bf16(v1[0], v1[1]); w.w = pk_bf16(v1[2], v1[3]);
                *(u32x4*)(O + (size_t)row * ldc + col0 + bj * HALF) = w; }
        }
    }
};

__device__ __forceinline__ float dpp_ror1(float x) { return __builtin_bit_cast(float, __builtin_amdgcn_update_dpp(0, __builtin_bit_cast(int, x), 0x121, 0xf, 0xf, false)); }
__device__ __forceinline__ float dpp_ror2(float x) { return __builtin_bit_cast(float, __builtin_amdgcn_update_dpp(0, __builtin_bit_cast(int, x), 0x122, 0xf, 0xf, false)); }
struct EpiFfn {
    static constexpr int PERM = 1; static constexpr bool AFTER_DRAIN = false;
    bf16_t* ACT; bf16_t* UB; const float* ssq; const float* cw; const float* cb; PG8_LAS float* wl;
    static constexpr int DFF = 11008;
    __device__ __forceinline__ void operator()(const f32x4 (&acc)[2][2][4][2], const Unit& u, int wr, int wc, int fr, int fq) const {
        const int cc0 = 32 * wc + 8 * fq, colg = u.pn * HALF + cc0, rowb = u.pm * BM + wr * 64 + fr;
        float rs[8];
#pragma unroll
        for (int g = 0; g < 8; ++g) rs[g] = ssq[rowb + (g >> 2) * HALF + (g & 3) * 16];
        {
            f32x4 wv[2][4][2];
#pragma unroll
            for (int bj = 0; bj < 2; ++bj)
#pragma unroll
                for (int t = 0; t < 4; ++t)
#pragma unroll
                    for (int n = 0; n < 2; ++n) { const int col = bj * DFF + colg + 4 * n; wv[bj][t][n] = (t < 3) ? *(const f32x4*)(cw + (size_t)t * (2 * DFF) + col) : *(const f32x4*)(cb + col); }
            EPI_FENCE();
#pragma unroll
            for (int bj = 0; bj < 2; ++bj)
#pragma unroll
                for (int t = 0; t < 4; ++t)
#pragma unroll
                    for (int n = 0; n < 2; ++n) *(PG8_LAS f32x4*)(wl + (bj * 4 + t) * 32 + 8 * fq + 4 * n) = wv[bj][t][n];
        }
#pragma unroll
        for (int g = 0; g < 8; ++g) rs[g] = rsqrtf(rs[g] * (1.0f / 4096.0f) + EPSN);
        asm volatile("s_waitcnt lgkmcnt(0)" ::: "memory");
#pragma unroll
        for (int n = 0; n < 2; ++n) {
#pragma unroll
            for (int ai = 0; ai < 2; ++ai) {
                const int row0 = rowb + ai * HALF, blk = (u.pm * BM + ai * HALF + wr * 64) >> 6;
                f32x4 sg[4];
#pragma unroll
                for (int bj = 0; bj < 2; ++bj) {
                    const PG8_LAS float* wp = wl + (bj * 4) * 32 + 8 * fq + 4 * n;
                    const f32x4 w0 = *(const PG8_LAS f32x4*)(wp), w1 = *(const PG8_LAS f32x4*)(wp + 32), w2 = *(const PG8_LAS f32x4*)(wp + 64), bb = *(const PG8_LAS f32x4*)(wp + 96);
                    f32x4 pr1 = {0.f, 0.f, 0.f, 0.f}, pr2 = pr1;
#pragma unroll
                    for (int m = 0; m < 4; ++m) {
                        const f32x4 x = acc[ai][bj][m][n] * rs[ai * 4 + m]; f32x4 r1, r2;
#pragma unroll
                        for (int j = 0; j < 4; ++j) { r1[j] = dpp_ror1(x[j]); r2[j] = dpp_ror2(x[j]); }
                        const f32x4 p1 = (m == 0) ? r1 : ((fr == 0) ? pr1 : r1);
                        const f32x4 p2 = (m == 0) ? r2 : ((fr < 2) ? pr2 : r2);
                        const f32x4 c = bb + w2 * x + w1 * p1 + w0 * p2;
                        pr1 = r1; pr2 = r2;
                        if (bj == 0) {
#pragma unroll
                            for (int j = 0; j < 4; ++j) sg[m][j] = c[j] * __builtin_amdgcn_rcpf(1.0f + __expf(-c[j])); }
                        else {
                            const f32x4 o = sg[m] * c; u32x2 pkd; pkd.x = pk_bf16(o[0], o[1]); pkd.y = pk_bf16(o[2], o[3]);
                            if (m > 0 || fr >= 2) *(u32x2*)(ACT + blk_elem(row0 + 16 * m, colg + 4 * n, DFF)) = pkd;
                        }
                        if (m == 0 || m == 3) {
                            const bool sel = (m == 0) ? (fr < 2) : (fr >= 14); const int slot = (m == 0) ? fr : 2 + (fr - 14);
                            if (sel) { u32x2 rw; rw.x = pk_bf16(x[0], x[1]); rw.y = pk_bf16(x[2], x[3]); *(u32x2*)(UB + ((size_t)blk * 4 + slot) * (2 * DFF) + bj * DFF + colg + 4 * n) = rw; }
                        }
                        __builtin_amdgcn_sched_barrier(0);
                    }
                }
            }
        }
    }
};

template <class Epi, class Sched, bool ALIGN_EPI = false, bool SP2 = false>
__device__ __forceinline__ void gemm_phase(PG8_LAS unsigned char* lds, const Gemm g, const Sched& S, const Epi& E) {
    const int tid = threadIdx.x, wid = __builtin_amdgcn_readfirstlane(tid >> 6), lane = tid & 63, wr = wid >> 2, wc = wid & 3, fr = lane & 15, fq = lane >> 4;
    const int K = g.K, nt = K / BK;
    unsigned voffA[2], voffB[2];
#pragma unroll
    for (int i = 0; i < 2; ++i) { voffA[i] = (unsigned)(tid * 16 + i * 8192); voffB[i] = voffA[i]; }
    const size_t kstep = 32768;
    const size_t hstep = 16384, hstepA = 16384;
    const size_t tstep = (size_t)K * 512, tstepA = (size_t)g.lda * 512;
    const unsigned ldsw = (unsigned)wid * 1024u;
    const int aoff = lds_byte(wr * 64 + fr, fq * 8), boff = lds_byte(wc * 32 + fr, fq * 8);
#define PG8_SA(b, h) (((b) * 2 + (h)) * HTB)
#define PG8_SB(b, h) ((4 + (b) * 2 + (h)) * HTB)
#define PG8_STAGE(bufoff, gbase, voff) do { _Pragma("unroll") for (int _i = 0; _i < 2; ++_i) \
        __builtin_amdgcn_global_load_lds((const unsigned*)((const char*)(gbase) + (voff)[_i]), (PG8_LAS unsigned*)(lds + (bufoff) + ldsw + _i * 8192), 16, 0, 0); } while (0)
#define PG8_LDA(dst, b, h) do { _Pragma("unroll") for (int m = 0; m < 4; ++m) _Pragma("unroll") for (int k = 0; k < 2; ++k) dst[m][k] = *(const PG8_LAS bf16x8*)(lds + PG8_SA(b, h) + aoff + m * 2048 + k * 1024); } while (0)
#define PG8_LDB(dst, b, h) do { _Pragma("unroll") for (int n = 0; n < 2; ++n) _Pragma("unroll") for (int k = 0; k < 2; ++k) dst[n][k] = *(const PG8_LAS bf16x8*)(lds + PG8_SB(b, h) + boff + n * 2048 + k * 1024); } while (0)
#define PG8_MMA(ai, bj, At, Bt) do { __builtin_amdgcn_s_setprio(1); _Pragma("unroll") for (int m = 0; m < 4; ++m) _Pragma("unroll") for (int n = 0; n < 2; ++n) _Pragma("unroll") for (int k = 0; k < 2; ++k) \
        acc[ai][bj][m][n] = __builtin_amdgcn_mfma_f32_16x16x32_bf16(Bt[n][k], At[m][k], acc[ai][bj][m][n], 0, 0, 0); __builtin_amdgcn_s_setprio(0); } while (0)
#define PG8_WAIT_V(n) asm volatile("s_waitcnt vmcnt(" #n ")" ::: "memory")
#define PG8_WAIT_L(n) asm volatile("s_waitcnt lgkmcnt(" #n ")" ::: "memory")
#define PG8_BAR __builtin_amdgcn_s_barrier()
#define PG8_SCHED __builtin_amdgcn_sched_barrier(0)
    Unit cur, nxt; int ui = 0;
    if (!S.next(0, cur)) return;
    f32x4 acc[2][2][4][2];
#pragma unroll
    for (int a = 0; a < 2; ++a)
#pragma unroll
        for (int b = 0; b < 2; ++b)
#pragma unroll
            for (int m = 0; m < 4; ++m)
#pragma unroll
                for (int n = 0; n < 2; ++n) acc[a][b][m][n] = (f32x4){0.f, 0.f, 0.f, 0.f};
    bf16x8 At[4][2], B0[2][2], B1[2][2];
    const char* cA = (const char*)g.A + (size_t)cur.pm * tstepA; const char* cB = (const char*)g.Bt + (size_t)cur.pn * tstep;
    S.a_ready(cur);
    if constexpr (SP2) {
        PG8_STAGE(PG8_SB(0, 0), cB, voffB); PG8_STAGE(PG8_SB(0, 1), cB + hstep, voffB); PG8_STAGE(PG8_SA(0, 0), cA, voffA); PG8_STAGE(PG8_SA(0, 1), cA + hstepA, voffA);
        if (wr == 1) PG8_BAR;
        PG8_WAIT_V(2); PG8_BAR;
        PG8_STAGE(PG8_SB(1, 0), cB + kstep, voffB); PG8_STAGE(PG8_SA(1, 0), cA + kstep, voffA); PG8_STAGE(PG8_SB(1, 1), cB + hstep + kstep, voffB);
        PG8_WAIT_V(6); PG8_BAR;
    } else {
        PG8_STAGE(PG8_SB(0, 0), cB, voffB); PG8_STAGE(PG8_SA(0, 0), cA, voffA); PG8_STAGE(PG8_SB(0, 1), cB + hstep, voffB); PG8_STAGE(PG8_SA(0, 1), cA + hstepA, voffA);
        if (wr == 1) PG8_BAR;
        PG8_WAIT_V(4); PG8_BAR;
        PG8_STAGE(PG8_SB(1, 0), cB + kstep, voffB); PG8_STAGE(PG8_SA(1, 0), cA + kstep, voffA); PG8_STAGE(PG8_SB(1, 1), cB + hstep + kstep, voffB);
        PG8_WAIT_V(6); PG8_BAR;
    }
    for (;;) {
        const bool has_next = S.next(ui + 1, nxt);
        const char* nA = has_next ? (const char*)g.A + (size_t)nxt.pm * tstepA : cA; const char* nB = has_next ? (const char*)g.Bt + (size_t)nxt.pn * tstep : cB;
        for (int t = 0; t < nt; t += 2) {
            const bool last = (t == nt - 2);
            const char* a1 = cA + (size_t)(t + 1) * kstep;
            const char* a2 = last ? nA : cA + (size_t)(t + 2) * kstep; const char* b2 = last ? nB : cB + (size_t)(t + 2) * kstep;
            const char* a3 = a2 + kstep; const char* b3 = b2 + kstep;
            if (last && has_next) S.a_ready(nxt);
            if constexpr (SP2) {
            PG8_LDB(B0, 0, 0); PG8_LDB(B1, 0, 1); PG8_SCHED; PG8_LDA(At, 0, 0); PG8_STAGE(PG8_SA(1, 1), a1 + hstepA, voffA);
            PG8_WAIT_V(8); PG8_WAIT_L(0); PG8_BAR; PG8_MMA(0, 0, At, B0); PG8_MMA(0, 1, At, B1); PG8_BAR; PG8_SCHED;
            PG8_LDA(At, 0, 1); PG8_STAGE(PG8_SB(0, 0), b2, voffB); PG8_STAGE(PG8_SB(0, 1), b2 + hstep, voffB); PG8_STAGE(PG8_SA(0, 0), a2, voffA);
            PG8_WAIT_V(8); PG8_WAIT_L(0); PG8_BAR; PG8_MMA(1, 0, At, B0); PG8_MMA(1, 1, At, B1); PG8_BAR; PG8_SCHED;
            PG8_LDB(B0, 1, 0); PG8_LDB(B1, 1, 1); PG8_SCHED; PG8_LDA(At, 1, 0); PG8_STAGE(PG8_SA(0, 1), a2 + hstepA, voffA);
            PG8_WAIT_V(8); PG8_WAIT_L(0); PG8_BAR; PG8_MMA(0, 0, At, B0); PG8_MMA(0, 1, At, B1); PG8_BAR; PG8_SCHED;
            PG8_LDA(At, 1, 1); PG8_STAGE(PG8_SB(1, 0), b3, voffB); PG8_STAGE(PG8_SB(1, 1), b3 + hstep, voffB); PG8_STAGE(PG8_SA(1, 0), a3, voffA);
            PG8_WAIT_V(8); PG8_WAIT_L(0); PG8_BAR; PG8_MMA(1, 0, At, B0); PG8_MMA(1, 1, At, B1); PG8_BAR; PG8_SCHED;
            } else {
            PG8_LDB(B0, 0, 0); PG8_SCHED; PG8_LDA(At, 0, 0); PG8_STAGE(PG8_SA(1, 1), a1 + hstepA, voffA);
            PG8_WAIT_L(8); PG8_BAR; PG8_WAIT_L(0); PG8_MMA(0, 0, At, B0); PG8_BAR; PG8_SCHED;
            PG8_LDB(B1, 0, 1); PG8_STAGE(PG8_SB(0, 0), b2, voffB);
            PG8_BAR; PG8_WAIT_L(0); PG8_MMA(0, 1, At, B1); PG8_BAR;
            PG8_LDA(At, 0, 1); PG8_STAGE(PG8_SA(0, 0), a2, voffA);
            PG8_BAR; PG8_WAIT_L(0); PG8_MMA(1, 0, At, B0); PG8_BAR; PG8_SCHED;
            PG8_STAGE(PG8_SB(0, 1), b2 + hstep, voffB);
            PG8_WAIT_V(6); PG8_BAR; PG8_MMA(1, 1, At, B1); PG8_BAR;
            PG8_LDB(B0, 1, 0); PG8_SCHED; PG8_LDA(At, 1, 0); PG8_STAGE(PG8_SA(0, 1), a2 + hstepA, voffA);
            PG8_WAIT_L(8); PG8_BAR; PG8_WAIT_L(0); PG8_MMA(0, 0, At, B0); PG8_BAR; PG8_SCHED;
            PG8_LDB(B1, 1, 1); PG8_STAGE(PG8_SB(1, 0), b3, voffB);
            PG8_BAR; PG8_WAIT_L(0); PG8_MMA(0, 1, At, B1); PG8_BAR;
            PG8_LDA(At, 1, 1); PG8_STAGE(PG8_SA(1, 0), a3, voffA);
            PG8_BAR; PG8_WAIT_L(0); PG8_MMA(1, 0, At, B0); PG8_BAR; PG8_SCHED;
            PG8_STAGE(PG8_SB(1, 1), b3 + hstep, voffB);
            PG8_WAIT_V(6); PG8_BAR; PG8_MMA(1, 1, At, B1); PG8_BAR;
            }
        }
        if constexpr (ALIGN_EPI) { if (wr == 0) PG8_BAR; }
        if constexpr (!Epi::AFTER_DRAIN) { E(acc, cur, wr, wc, fr, fq); S.done(cur); }
        if (!has_next) break;
#pragma unroll
        for (int a = 0; a < 2; ++a)
#pragma unroll
            for (int b = 0; b < 2; ++b)
#pragma unroll
                for (int m = 0; m < 4; ++m)
#pragma unroll
                    for (int n = 0; n < 2; ++n) acc[a][b][m][n] = (f32x4){0.f, 0.f, 0.f, 0.f};
        cur = nxt; cA = nA; cB = nB; ++ui;
        if constexpr (ALIGN_EPI) { if (wr == 1) PG8_BAR; }
    }
    PG8_WAIT_V(0);
    if constexpr (!ALIGN_EPI) { if (wr == 0) PG8_BAR; }
    PG8_BAR;
    if constexpr (Epi::AFTER_DRAIN) { E.fused(acc, cur, wr, wc, fr, fq, lds, wid, lane); S.done(cur); }
#undef PG8_SA
#undef PG8_SB
#undef PG8_STAGE
#undef PG8_LDA
#undef PG8_LDB
#undef PG8_MMA
#undef PG8_WAIT_V
#undef PG8_WAIT_L
#undef PG8_BAR
#undef PG8_SCHED
}
}
#define LAS __attribute__((address_space(3)))
#define XB_TMO      128
#define XB_XCNT(j)  (256  + 64 * (j))
#define XB_XSUB(j)  (1280 + 64 * (j))
#define XB_XGEN(j)  (2304 + 64 * (j))
#define XB_TOP      3328
#define XB_TOPGEN   3392
#define XCD_BAR_WORDS 3456
#define XB_SPIN_CAP (1u << 18)

__device__ __forceinline__ unsigned xb_ld(unsigned* p)              { return __hip_atomic_load(p, __ATOMIC_RELAXED, __HIP_MEMORY_SCOPE_AGENT); }
__device__ __forceinline__ unsigned xb_add(unsigned* p, unsigned v) { return __hip_atomic_fetch_add(p, v, __ATOMIC_RELAXED, __HIP_MEMORY_SCOPE_AGENT); }
__device__ __forceinline__ unsigned xb_xcc_id() { return (unsigned)__builtin_amdgcn_s_getreg((3 << 11) | 20) & 0xFu; }
#define XB_SPIN(cond, bar) do { unsigned _sp = 0; while (cond) { __builtin_amdgcn_s_sleep(1); \
    if ((++_sp & 255u) == 0u) { if (xb_ld(&(bar)[XB_TMO])) break; if (_sp > XB_SPIN_CAP) { atomicAdd(&(bar)[XB_TMO], 1u); break; } } } } while (0)

struct XcdBarrier {
    unsigned* bar; unsigned x;
    volatile LAS unsigned* st;
};

__device__ __forceinline__ XcdBarrier xcd_barrier_post(unsigned* bar, volatile LAS unsigned* st) {
    XcdBarrier b; b.bar = bar; b.x = xb_xcc_id(); b.st = st;
    if (threadIdx.x == 0) (void)xb_add(&bar[XB_XCNT(b.x)], 1u);
    return b;
}
__device__ __forceinline__ void xcd_barrier_complete(unsigned* bar, unsigned x, unsigned& nloc, unsigned& nx) {
    const unsigned G = gridDim.x * gridDim.y * gridDim.z;
    unsigned sum, cnt, mine, sp = 0u;
    for (;;) {
        sum = 0u; cnt = 0u; mine = 0u;
#pragma unroll
        for (unsigned j = 0; j < 16; ++j) { const unsigned c = xb_ld(&bar[XB_XCNT(j)]); sum += c; cnt += (c > 0u) ? 1u : 0u; mine = (j == x) ? c : mine; }
        if (sum == G) break;
        __builtin_amdgcn_s_sleep(1);
        if ((++sp & 255u) == 0u) { if (xb_ld(&bar[XB_TMO])) break; if (sp > XB_SPIN_CAP) { atomicAdd(&bar[XB_TMO], 1u); break; } }
    }
    nloc = mine > 0u ? mine : 1u; nx = cnt > 0u ? cnt : 1u;
}

__device__ __forceinline__ void xcd_barrier(const XcdBarrier& b) {
    asm volatile("s_waitcnt vmcnt(0)" ::: "memory");
    __syncthreads();
    if (threadIdx.x == 0) {
        unsigned* bar = b.bar;
        __builtin_amdgcn_s_waitcnt(0);
        unsigned nloc = b.st[0], nx = b.st[1];
        if (nloc == 0u) { xcd_barrier_complete(bar, b.x, nloc, nx); b.st[0] = nloc; b.st[1] = nx; }
        const unsigned old = xb_add(&bar[XB_XSUB(b.x)], 1u);
        const unsigned gen = old / nloc;
        if (old + 1u == (gen + 1u) * nloc) {
            __builtin_amdgcn_fence(__ATOMIC_RELEASE, "agent");
            asm volatile("s_waitcnt vmcnt(0)" ::: "memory");
            const unsigned og = xb_add(&bar[XB_TOP], 1u);
            const unsigned tg = og / nx;
            if (og + 1u == (tg + 1u) * nx) xb_add(&bar[XB_TOPGEN], 1u);
            else XB_SPIN(xb_ld(&bar[XB_TOPGEN]) == tg, bar);
            __builtin_amdgcn_fence(__ATOMIC_ACQUIRE, "agent");
            xb_add(&bar[XB_XGEN(b.x)], 1u);
            asm volatile("s_waitcnt vmcnt(0)" ::: "memory");
        } else {
            XB_SPIN(xb_ld(&bar[XB_XGEN(b.x)]) == gen, bar);
            __builtin_amdgcn_fence(__ATOMIC_ACQUIRE, "agent");
            asm volatile("s_waitcnt vmcnt(0)" ::: "memory");
        }
    }
    __syncthreads();
}
constexpr int NWAVES = 8;
constexpr int SEQ = 8192, BATCH = 2, M = BATCH * SEQ, DM = 4096, HD = 128, NH = 16, INW = 14336, NMEM = 256, CW = 512, DFF = 11008, DFF2 = 2 * DFF;
constexpr int C_RQ = 0, C_SQ = 2048, C_RK = 4096, C_RV = 6144, C_RG = 8192, C_SK = 10240, C_SV = 12288;
constexpr float SB_EXIT = 110.0f;
constexpr size_t MiB = 1u << 20;
constexpr size_t WS_CTL = 0, CTL_ZERO_BYTES = 1 * MiB;
constexpr size_t WS_COS = 1 * MiB, WS_SIN = 3 * MiB, WS_SSQ0 = 5 * MiB, WS_SSQM = 5 * MiB + 256 * 1024, WS_SSQ1 = 256 * 1024, WS_SSQ2 = 512 * 1024  , WS_SSQSB = 14 * MiB;
constexpr size_t WS_MB = 22 * MiB, WS_CQ = 26 * MiB, WS_CKV = 58 * MiB, WS_CO = 60 * MiB;
constexpr size_t WS_WQKV = 76 * MiB, WS_WO = 88 * MiB, WS_WUP = 92 * MiB, WS_WDOWN = 264 * MiB, WS_HB = 350 * MiB;
constexpr size_t WS_WIN = 478 * MiB, WS_WOUT = 590 * MiB, WS_PROJ = 622 * MiB, WS_KV = 1070 * MiB, WS_ST = 1198 * MiB, WS_END = 1262 * MiB;
constexpr size_t WS_MIX = WS_KV;
constexpr size_t WS_UB = 478 * MiB, WS_ACT = 822 * MiB;
static_assert(WS_UB + (size_t)(M / 64) * 4 * DFF2 * 2 <= WS_WOUT && WS_ACT + (size_t)M * DFF * 2 <= WS_END && WS_ACT >= WS_PROJ, "ffn overlays");
static_assert(WS_PROJ + (size_t)M * INW * 2 <= WS_KV && WS_KV + (size_t)2048 * 16384 * 4 <= WS_ST && WS_ST + (size_t)2048 * 16384 * 2 <= WS_END, "mixer map");
static_assert(WS_WIN + (size_t)INW * DM * 2 <= WS_WOUT && WS_WOUT + (size_t)DM * DM * 2 <= WS_PROJ && WS_WUP + (size_t)DFF2 * DM * 2 <= WS_WDOWN && WS_WDOWN + (size_t)DM * DFF * 2 <= WS_HB && WS_HB + (size_t)M * DM * 2 <= WS_WIN, "weights map");
constexpr int CW_BAR = 4096;
constexpr int RING_BYTES = 131072, LDSCTL_OFF = RING_BYTES, MISC_OFF = LDSCTL_OFF + 320, L_EPIW = RING_BYTES + 1024  , LDS_BYTES = 147456;
constexpr int L_KT = 0, L_VT = 40960, L_RK = 81920, L_FL = 82944, L_RED = 83200;
constexpr int KSTR = 272, VSTR = 320;

#define GAS __attribute__((address_space(1)))
#define LAS __attribute__((address_space(3)))
#define DI __device__ __forceinline__
typedef unsigned short bf16;
typedef unsigned v4u __attribute__((ext_vector_type(4)));
typedef unsigned v2u __attribute__((ext_vector_type(2)));
typedef float f32x4 __attribute__((ext_vector_type(4)));
typedef float f32x16 __attribute__((ext_vector_type(16)));
typedef short bf16x8 __attribute__((ext_vector_type(8)));
typedef short s16x4 __attribute__((ext_vector_type(4)));
typedef GAS unsigned gu32;
#define RLX_AGENT __ATOMIC_RELAXED, __HIP_MEMORY_SCOPE_AGENT
#define LDS_WAIT() asm volatile("s_waitcnt lgkmcnt(0)" ::: "memory")
using pg8::pk_bf16; using pg8::EPSN; using pg8::LOGG; using pg8::hsum4;
#define MFMA32(a, b, c) __builtin_amdgcn_mfma_f32_32x32x16_bf16((a), (b), (c), 0, 0, 0)
DI int crow(int i, int h) { return (i & 3) + 8 * (i >> 2) + 4 * h; }
DI bf16x8 pack8(float a0, float a1, float a2, float a3, float a4, float a5, float a6, float a7) { v4u p; p.x = pk_bf16(a0, a1); p.y = pk_bf16(a2, a3); p.z = pk_bf16(a4, a5); p.w = pk_bf16(a6, a7); return __builtin_bit_cast(bf16x8, p); }
DI float bf2f(unsigned short b) { return __builtin_bit_cast(float, (unsigned)b << 16); }
DI float wave_sum(float v) {
#pragma unroll
    for (int o = 1; o < 64; o <<= 1) v += __shfl_xor(v, o);
    return v;
}
__constant__ float INVF[64] = { 1.000000000e+00f, 8.639884591e-01f, 7.464760542e-01f, 6.449466348e-01f, 5.572264791e-01f, 4.814372361e-01f, 4.159561992e-01f, 3.593813479e-01f, 3.105013072e-01f, 2.682695389e-01f, 2.317818105e-01f, 2.002568096e-01f, 1.730195731e-01f, 1.494868994e-01f, 1.291549653e-01f, 1.115883961e-01f,
    9.641107172e-02f, 8.329805732e-02f, 7.196855545e-02f, 6.218000501e-02f, 5.372280627e-02f, 4.641588405e-02f, 4.010278732e-02f, 3.464834765e-02f, 2.993577160e-02f, 2.586415969e-02f, 2.234633639e-02f, 1.930697635e-02f, 1.668100432e-02f, 1.441219542e-02f, 1.245197095e-02f, 1.075835899e-02f,
    9.295094758e-03f, 8.030855097e-03f, 6.938565988e-03f, 5.994841456e-03f, 5.179473665e-03f, 4.475004971e-03f, 3.866352839e-03f, 3.340484342e-03f, 2.886140021e-03f, 2.493591513e-03f, 2.154434333e-03f, 1.861406374e-03f, 1.608233550e-03f, 1.389495214e-03f, 1.200507861e-03f, 1.037224894e-03f,
    8.961503627e-04f, 7.742635789e-04f, 6.689548027e-04f, 5.779691855e-04f, 4.993587499e-04f, 4.314401885e-04f, 3.727593576e-04f, 3.220597864e-04f, 2.782559022e-04f, 2.404099068e-04f, 2.077113895e-04f, 1.794602285e-04f, 1.550515735e-04f, 1.339627779e-04f, 1.157422885e-04f, 9.999999747e-05f };
typedef float f32x2g __attribute__((ext_vector_type(2)));
template <bool HASG, int PERM> DI void transpose_tile64(const float* __restrict__ W, int N, const float* __restrict__ gain, bf16* __restrict__ WT, int Kd, int dst_row0, int src_col0, int k0, LAS unsigned* scr, int lane) {
    const int n4 = lane & 15, kk = lane >> 4;
    f32x4 a[8], b[8]; f32x2g gg[8];
    const float* src = W + (size_t)(k0 + 2 * kk) * N + src_col0 + 4 * n4;
#pragma unroll
    for (int i = 0; i < 8; ++i) { a[i] = *(const GAS f32x4*)(src + (size_t)(8 * i) * N); b[i] = *(const GAS f32x4*)(src + (size_t)(8 * i + 1) * N); }
#pragma unroll
    for (int i = 0; i < 8; ++i) { if (HASG) gg[i] = *(const GAS f32x2g*)(gain + k0 + 8 * i + 2 * kk); else gg[i] = (f32x2g){1.f, 1.f}; }
    asm volatile("" ::: "memory");
#pragma unroll
    for (int i = 0; i < 8; ++i)
#pragma unroll
        for (int j = 0; j < 4; ++j) scr[(4 * n4 + j) * 33 + 4 * i + kk] = pk_bf16(a[i][j] * gg[i].x, b[i][j] * gg[i].y);
    LDS_WAIT(); asm volatile("" ::: "memory");
    const int c = lane & 7, nr = lane >> 3;
#pragma unroll
    for (int it = 0; it < 8; ++it) { const int n = 8 * it + nr; const LAS unsigned* sp = scr + n * 33 + 4 * c;
        v4u o; o.x = sp[0]; o.y = sp[1]; o.z = sp[2]; o.w = sp[3];
        const int drow = dst_row0 + n, srow = (drow & ~127) + pg8::invpermrow<PERM>(drow & 127);
        *(GAS v4u*)(WT + pg8::blk_elem(srow, k0 + 8 * c, Kd)) = o; }
    LDS_WAIT(); asm volatile("" ::: "memory");
}
DI void row_to_bf16(const float* __restrict__ xrow, bf16* __restrict__ obase, int m, float* __restrict__ ssq, int lane) {
    const GAS f32x4* xr = (const GAS f32x4*)xrow + lane; float s = 0.f; f32x4 v[16];
#pragma unroll
    for (int j = 0; j < 16; ++j) v[j] = xr[64 * j];
    asm volatile("" ::: "memory");
#pragma unroll
    for (int j = 0; j < 16; ++j) { s += (v[j].x * v[j].x + v[j].y * v[j].y) + (v[j].z * v[j].z + v[j].w * v[j].w); v2u w; w.x = pk_bf16(v[j].x, v[j].y); w.y = pk_bf16(v[j].z, v[j].w);
        *(GAS v2u*)(obase + pg8::blk_elem(m, 4 * lane + 256 * j, DM)) = w; }
    s = wave_sum(s); if (lane == 0) *ssq = s;
}
struct Ptrs {
    const float *x, *mem, *attn_norm, *w_in, *ret_norm, *sbq_norm, *sbk_norm, *sbo_norm, *w_out, *cross_norm, *mem_norm, *wq, *wkv, *cq_norm, *ck_norm, *wo, *ffn_norm, *w_up, *conv_w, *conv_b, *w_down;
    float* out; unsigned char* ws;
};
DI void p0_prologue(const Ptrs& P, LAS unsigned char* lds, int gw, int NGW, int wave, int lane) {
    unsigned char* ws = P.ws;
    LAS unsigned* scr = (LAS unsigned*)(lds + wave * 16384);
    constexpr int KB = DM / 64;
    constexpr int I_IN = KB * (INW / 64), I_OUT = KB * (DM / 64), I_Q = KB * (CW / 64), I_KV = KB * (2 * CW / 64), I_O = (CW / 64) * (DM / 64), I_UP = KB * (DFF2 / 64), I_DN = (DFF / 64) * (DM / 64);
    constexpr int NITEMS = I_IN + I_OUT + I_Q + I_KV + I_O + I_UP + I_DN;
    for (int it = gw; it < NITEMS; it += NGW) {
        int r = it;
        if (r < I_IN) { const int nb = r % (INW / 64), kb = r / (INW / 64), n0 = 64 * nb, reg = n0 >> 11;
            const int src = (reg == 0 ? 0 : reg == 1 ? 8192 : reg == 2 ? 2048 : reg == 3 ? 4096 : reg == 4 ? 6144 : reg == 5 ? 10240 : 12288) + (n0 & 2047);
            transpose_tile64<true, 2>(P.w_in, INW, P.attn_norm, (bf16*)(ws + WS_WIN), DM, n0, src, 64 * kb, scr, lane); continue; } r -= I_IN;
        if (r < I_OUT) { const int nb = r % (DM / 64), kb = r / (DM / 64); transpose_tile64<false, 1>(P.w_out, DM, nullptr, (bf16*)(ws + WS_WOUT), DM, 64 * nb, 64 * nb, 64 * kb, scr, lane); continue; } r -= I_OUT;
        if (r < I_Q) { const int nb = r % (CW / 64), kb = r / (CW / 64); transpose_tile64<true, 1>(P.wq, CW, P.cross_norm, (bf16*)(ws + WS_WQKV), DM, 64 * nb, 64 * nb, 64 * kb, scr, lane); continue; } r -= I_Q;
        if (r < I_KV) { const int nb = r % (2 * CW / 64), kb = r / (2 * CW / 64); transpose_tile64<true, 1>(P.wkv, 2 * CW, P.mem_norm, (bf16*)(ws + WS_WQKV), DM, CW + 64 * nb, 64 * nb, 64 * kb, scr, lane); continue; } r -= I_KV;
        if (r < I_O) { const int nb = r % (DM / 64), kb = r / (DM / 64); transpose_tile64<false, 1>(P.wo, DM, nullptr, (bf16*)(ws + WS_WO), CW, 64 * nb, 64 * nb, 64 * kb, scr, lane); continue; } r -= I_O;
        if (r < I_UP) { const int nb = r % (DFF2 / 64), kb = r / (DFF2 / 64), n0 = 64 * nb, src = ((n0 >> 7) & 1) * DFF + 128 * (n0 >> 8) + (n0 & 127);
            transpose_tile64<true, 1>(P.w_up, DFF2, P.ffn_norm, (bf16*)(ws + WS_WUP), DM, n0, src, 64 * kb, scr, lane); continue; } r -= I_UP;
        { const int nb = r % (DM / 64), kb = r / (DM / 64); transpose_tile64<false, 1>(P.w_down, DM, nullptr, (bf16*)(ws + WS_WDOWN), DFF, 64 * nb, 64 * nb, 64 * kb, scr, lane); }
    }
    for (int m = gw; m < M; m += NGW) row_to_bf16(P.x + (size_t)m * DM, (bf16*)(ws + WS_HB), m, (float*)(ws + WS_SSQ0) + m, lane);
    for (int m = gw; m < BATCH * NMEM; m += NGW) row_to_bf16(P.mem + (size_t)m * DM, (bf16*)(ws + WS_MB), m, (float*)(ws + WS_SSQM) + m, lane);
    for (int idx = gw * 64 + lane; idx < SEQ * 64; idx += NGW * 64) {
        const int t = idx >> 6, i = idx & 63; const float angf = (float)t * INVF[i]; const double ang = (double)angf;
        const double kq = __builtin_rint(ang * 0.15915494309189535); const double rr = __builtin_fma(-kq, 6.283185307179586, ang) - kq * 2.4492935982947064e-16;
        const double r2 = rr * rr; double sn = 0.0, cs = 0.0;
#pragma unroll
        for (int k = 13; k >= 0; --k) { cs = cs * (-r2 / (double)((2 * k + 1) * (2 * k + 2))) + 1.0; sn = sn * (-r2 / (double)((2 * k + 2) * (2 * k + 3))) + 1.0; }
        ((float*)(ws + WS_COS))[idx] = (float)cs; ((float*)(ws + WS_SIN))[idx] = (float)(sn * rr);
    }
}
DI void stage_tile(LAS unsigned char* dst, int stride, const bf16* src, size_t ld, int rows, int tid) {
    for (int ch = tid; ch < rows * 16; ch += NWAVES * 64) { const int r = ch >> 4, c = ch & 15; const v4u v = *(const GAS v4u*)(src + (size_t)r * ld + c * 8); *(LAS v4u*)(dst + r * stride + c * 16) = v; }
}
DI bf16x8 tr_frag(LAS unsigned char* tile, int stride, int row0, int col0, int lane) {
    const int g = lane >> 4, i16 = lane & 15, q = i16 >> 2, p = i16 & 3, h = lane >> 5;
    LAS unsigned char* a = tile + (row0 + 4 * h + q) * stride + (col0 + 16 * (g & 1) + 4 * p) * 2;
    const s16x4 lo = __builtin_amdgcn_ds_read_tr16_b64_v4i16((LAS s16x4*)a);
    const s16x4 hi = __builtin_amdgcn_ds_read_tr16_b64_v4i16((LAS s16x4*)(a + 8 * stride));
    return __builtin_shufflevector(lo, hi, 0, 1, 2, 3, 4, 5, 6, 7);
}
DI f32x16 st_tile(LAS unsigned char* KT, int krow0, const bf16x8 (&qf)[8], int r, int h) {
    f32x16 acc;
#pragma unroll
    for (int i = 0; i < 16; ++i) acc[i] = 0.f;
#pragma unroll
    for (int ks = 0; ks < 8; ++ks) { const bf16x8 a = *(const LAS bf16x8*)(KT + (krow0 + r) * KSTR + (16 * ks + 8 * h) * 2); acc = MFMA32(a, qf[ks], acc); }
    return acc;
}
DI void load_qf(bf16x8 (&qf)[8], const bf16* qrowp, int h) {
#pragma unroll
    for (int ks = 0; ks < 8; ++ks) qf[ks] = *(const GAS bf16x8*)(qrowp + 16 * ks + 8 * h);
}

DI void ret_kv_unit(LAS unsigned char* lds, const bf16* PROJ, float* KVB, int unit, int tid) {
    const int lane = tid & 63, w = __builtin_amdgcn_readfirstlane(tid >> 6), r = lane & 31, h = lane >> 5;
    const int n = unit & 63, hd = (unit >> 6) & 15, b = unit >> 10;
    LAS unsigned char* KT = lds + L_KT; LAS unsigned char* VT = lds + L_VT;
    const size_t m0 = (size_t)b * SEQ + 128 * n;
    __syncthreads();
    stage_tile(KT, VSTR, PROJ + m0 * INW + C_RK + 128 * hd, INW, 128, tid);
    stage_tile(VT, VSTR, PROJ + m0 * INW + C_RV + 128 * hd, INW, 128, tid);
    __syncthreads();
    const int te = w >> 1, td0 = 2 * (w & 1);
    f32x16 acc[2];
#pragma unroll
    for (int t = 0; t < 2; ++t)
#pragma unroll
        for (int i = 0; i < 16; ++i) acc[t][i] = 0.f;
#pragma unroll
    for (int ks = 0; ks < 8; ++ks) {
        const bf16x8 a = tr_frag(VT, VSTR, 16 * ks, 32 * te, lane);
#pragma unroll
        for (int t = 0; t < 2; ++t) { const bf16x8 bb = tr_frag(KT, VSTR, 16 * ks, 32 * (td0 + t), lane); acc[t] = MFMA32(a, bb, acc[t]); }
    }
    const float sc = __expf(127.0f * LOGG[hd]);
    float* o = KVB + (size_t)unit * 16384;
#pragma unroll
    for (int t = 0; t < 2; ++t)
#pragma unroll
        for (int i = 0; i < 16; ++i) o[(32 * te + crow(i, h)) * 128 + 32 * (td0 + t) + r] = acc[t][i] * sc;
}
DI void ret_scan(const float* KVB, bf16* ST, int gt, int NT) {
    for (int idx = gt; idx < 32 * 4096; idx += NT) {
        const int bh = idx >> 12, e4 = idx & 4095; const float dec = __expf(128.0f * LOGG[bh & 15]);
        f32x4 S = {0.f, 0.f, 0.f, 0.f};
        for (int n = 0; n < 64; ++n) {
            const size_t off = ((size_t)(bh * 64 + n) * 4096 + e4) * 4;
            v2u w; w.x = pk_bf16(S[0], S[1]); w.y = pk_bf16(S[2], S[3]); *(GAS v2u*)(ST + off) = w;
            const f32x4 kv = *(const GAS f32x4*)(KVB + off); S = S * dec + kv;
        }
    }
}
DI float xor32(float x, int h) { const auto r = __builtin_amdgcn_permlane32_swap(__builtin_bit_cast(unsigned, x), __builtin_bit_cast(unsigned, x), false, false); return __builtin_bit_cast(float, h ? r[0] : r[1]); }
DI void tile_ld(v4u (&t)[4], const bf16* src, size_t ld, int tid) {
#pragma unroll
    for (int i = 0; i < 4; ++i) { const int ch = tid + i * (NWAVES * 64); t[i] = *(const GAS v4u*)(src + (size_t)(ch >> 4) * ld + (ch & 15) * 8); }
}
DI void tile_st(LAS unsigned char* dst, int stride, const v4u (&t)[4], int tid) {
#pragma unroll
    for (int i = 0; i < 4; ++i) { const int ch = tid + i * (NWAVES * 64); *(LAS v4u*)(dst + (ch >> 4) * stride + (ch & 15) * 16) = t[i]; }
}
DI void ret_out_phase(LAS unsigned char* lds, const bf16* PROJ, bf16* MIX, const bf16* ST, const float* gret, int bx, int G, int tid) {
    const int lane = tid & 63, w = __builtin_amdgcn_readfirstlane(tid >> 6), r = lane & 31, h = lane >> 5, qg = w & 3, eh = w >> 2;
    LAS unsigned char* KT = lds + L_KT; LAS unsigned char* VT = lds + L_VT; LAS float* RED = (LAS float*)(lds + L_RED);
    v4u kreg[4], vreg[4];
    if (bx < 2048) { const int n = bx & 63, hd = (bx >> 6) & 15, b = bx >> 10; const size_t m0 = (size_t)b * SEQ + 128 * n;
        tile_ld(kreg, PROJ + m0 * INW + C_RK + 128 * hd, INW, tid); tile_ld(vreg, PROJ + m0 * INW + C_RV + 128 * hd, INW, tid); }
    for (int unit = bx; unit < 2048; unit += G) {
        const int n = unit & 63, hd = (unit >> 6) & 15, b = unit >> 10;
        const size_t m0 = (size_t)b * SEQ + 128 * n, qrow = m0 + 32 * qg + r;
        __syncthreads();
        tile_st(KT, KSTR, kreg, tid); tile_st(VT, VSTR, vreg, tid);
        bf16x8 qf[8]; load_qf(qf, PROJ + qrow * INW + C_RQ + 128 * hd, h);
        const bf16* st = ST + (size_t)unit * 16384;
        f32x16 O[2];
#pragma unroll
        for (int et = 0; et < 2; ++et) {
            bf16x8 sa[8];
#pragma unroll
            for (int ks = 0; ks < 8; ++ks) sa[ks] = *(const GAS bf16x8*)(st + (32 * (2 * eh + et) + r) * 128 + 16 * ks + 8 * h);
#pragma unroll
            for (int i = 0; i < 16; ++i) O[et][i] = 0.f;
#pragma unroll
            for (int ks = 0; ks < 8; ++ks) O[et] = MFMA32(sa[ks], qf[ks], O[et]);
        }
        const float g1 = __builtin_amdgcn_exp2f(1.4426950408889634f * LOGG[hd]);
#pragma unroll
        for (int et = 0; et < 2; ++et) O[et] = O[et] * g1;
        const bf16* grow = PROJ + qrow * INW + C_RG + 128 * hd;
        v2u gt[2][4]; f32x4 gg[2][4];
#pragma unroll
        for (int et = 0; et < 2; ++et)
#pragma unroll
            for (int Gq = 0; Gq < 4; ++Gq) { const int e = 32 * (2 * eh + et) + 8 * Gq + 4 * h; gt[et][Gq] = *(const GAS v2u*)(grow + e); gg[et][Gq] = *(const f32x4*)(gret + e); }
        __syncthreads();
        if (unit + G < 2048) { const int u2 = unit + G, n2 = u2 & 63, hd2 = (u2 >> 6) & 15, b2 = u2 >> 10; const size_t m2 = (size_t)b2 * SEQ + 128 * n2;
            tile_ld(kreg, PROJ + m2 * INW + C_RK + 128 * hd2, INW, tid); tile_ld(vreg, PROJ + m2 * INW + C_RV + 128 * hd2, INW, tid); }
        for (int kt = 0; kt <= qg; ++kt) {
            f32x16 s = st_tile(KT, 32 * kt, qf, r, h);
            if (kt == qg) {
#pragma unroll
                for (int i = 0; i < 16; ++i) s[i] = (crow(i, h) <= r) ? s[i] : 0.f;
            }
            bf16x8 pb[2];
#pragma unroll
            for (int s2 = 0; s2 < 2; ++s2) pb[s2] = pack8(s[8 * s2], s[8 * s2 + 1], s[8 * s2 + 2], s[8 * s2 + 3], s[8 * s2 + 4], s[8 * s2 + 5], s[8 * s2 + 6], s[8 * s2 + 7]);
#pragma unroll
            for (int et = 0; et < 2; ++et)
#pragma unroll
                for (int s2 = 0; s2 < 2; ++s2) O[et] = MFMA32(tr_frag(VT, VSTR, 32 * kt + 16 * s2, 32 * (2 * eh + et), lane), pb[s2], O[et]);
        }
        float ss = 0.f;
#pragma unroll
        for (int et = 0; et < 2; ++et)
#pragma unroll
            for (int i = 0; i < 16; ++i) ss += O[et][i] * O[et][i];
        ss += xor32(ss, h);
        if (h == 0) RED[w * 32 + r] = ss;
        __syncthreads();
        const float rstd = rsqrtf((RED[w * 32 + r] + RED[(w ^ 4) * 32 + r]) * (1.0f / 128.0f) + EPSN);
#pragma unroll
        for (int et = 0; et < 2; ++et)
#pragma unroll
            for (int Gq = 0; Gq < 4; ++Gq) {
                const int e = 32 * (2 * eh + et) + 8 * Gq + 4 * h; const f32x4 g = gg[et][Gq]; const v2u gv = gt[et][Gq];
                const float o0 = O[et][4 * Gq + 0] * rstd * g[0] * bf2f((unsigned short)(gv.x & 0xffff)), o1 = O[et][4 * Gq + 1] * rstd * g[1] * bf2f((unsigned short)(gv.x >> 16));
                const float o2 = O[et][4 * Gq + 2] * rstd * g[2] * bf2f((unsigned short)(gv.y & 0xffff)), o3 = O[et][4 * Gq + 3] * rstd * g[3] * bf2f((unsigned short)(gv.y >> 16));
                v2u wv; wv.x = pk_bf16(o0, o1); wv.y = pk_bf16(o2, o3); *(GAS v2u*)(MIX + pg8::blk_elem((int)qrow, 128 * hd + e, DM)) = wv;
            }
    }
}
constexpr float SB_EXIT2 = SB_EXIT * 1.4426950408889634f;
template <bool MASK> DI void sb_subtile(const f32x16& s, const LAS float* RKp, float qscale, int kpos0, int tq, int h, float& R, bf16x8 (&pb)[2]) {
    float a[16], T[4], l[4][4], z[4][4]; bool ok[4][4];
#pragma unroll
    for (int Gq = 0; Gq < 4; ++Gq) {
        const f32x4 rk = *(const LAS f32x4*)(RKp + 8 * Gq + 4 * h);
#pragma unroll
        for (int j = 0; j < 4; ++j) {
            z[Gq][j] = s[4 * Gq + j] * qscale * rk[j];
            const float spv = fmaxf(z[Gq][j], 0.f) + __builtin_amdgcn_logf(1.0f + __builtin_amdgcn_exp2f(-fabsf(z[Gq][j])));
            if (MASK) { ok[Gq][j] = (kpos0 + 8 * Gq + 4 * h + j < tq); l[Gq][j] = ok[Gq][j] ? spv : 0.f; } else { ok[Gq][j] = true; l[Gq][j] = spv; }
        }
        l[Gq][2] += l[Gq][3]; l[Gq][1] += l[Gq][2]; l[Gq][0] += l[Gq][1];
        T[Gq] = l[Gq][0];
    }
    float To[4];
#pragma unroll
    for (int Gq = 0; Gq < 4; ++Gq) To[Gq] = xor32(T[Gq], h);
#pragma unroll
    for (int Gq = 3; Gq >= 0; --Gq) {
        const float off = h ? R : R + To[Gq];
#pragma unroll
        for (int j = 0; j < 4; ++j) { const float e = __builtin_amdgcn_exp2f(z[Gq][j] - (off + l[Gq][j])); a[4 * Gq + j] = (!MASK || ok[Gq][j]) ? e : 0.f; }
        R = R + (T[Gq] + To[Gq]);
    }
#pragma unroll
    for (int s2 = 0; s2 < 2; ++s2) pb[s2] = pack8(a[8 * s2], a[8 * s2 + 1], a[8 * s2 + 2], a[8 * s2 + 3], a[8 * s2 + 4], a[8 * s2 + 5], a[8 * s2 + 6], a[8 * s2 + 7]);
}
DI void sb_phase(LAS unsigned char* lds, const bf16* PROJ, bf16* MIX, const float* ssqsb, const float* gout, int bx, int G, int tid) {
    const int lane = tid & 63, w = __builtin_amdgcn_readfirstlane(tid >> 6), r = lane & 31, h = lane >> 5;
    LAS unsigned char* KT = lds + L_KT; LAS unsigned char* VT = lds + L_VT; LAS float* RK = (LAS float*)(lds + L_RK); LAS unsigned* FL = (LAS unsigned*)(lds + L_FL);
    for (int unit = bx; unit < 1024; unit += G) {
        const int qb = unit & 31, hd = (unit >> 5) & 15, b = unit >> 9;
        const size_t m0 = (size_t)b * SEQ + 256 * qb, qrow = m0 + 32 * w + r;
        const int qlo = 256 * qb + 32 * w, qhi = qlo + 31, tq = qlo + r;
        v4u kreg[4], vreg[4]; f32x4 rkreg = {0.f, 0.f, 0.f, 0.f};
        { const size_t k0row = (size_t)b * SEQ + 128 * (2 * qb + 1);
          tile_ld(kreg, PROJ + k0row * INW + C_SK + 128 * hd, INW, tid); tile_ld(vreg, PROJ + k0row * INW + C_SV + 128 * hd, INW, tid);
          if (tid < 128) rkreg = *(const GAS f32x4*)(ssqsb + ((k0row + tid) * 32 + 16 + hd) * 4); }
        bf16x8 qf[8]; load_qf(qf, PROJ + qrow * INW + C_SQ + 128 * hd, h);
        const f32x4 pq = *(const GAS f32x4*)(ssqsb + (qrow * 32 + hd) * 4);
        const float qscale = rsqrtf(hsum4(pq) * (1.0f / 128.0f) + EPSN) * (0.08838834764831845f * 1.4426950408889634f);
        f32x16 O[4];
#pragma unroll
        for (int dt = 0; dt < 4; ++dt)
#pragma unroll
            for (int i = 0; i < 16; ++i) O[dt][i] = 0.f;
        float R = 0.f; bool wdone = false;
        for (int kb = 2 * qb + 1; kb >= 0; --kb) {
            __syncthreads();
            if (kb != 2 * qb + 1) { const unsigned all = FL[0] & FL[1] & FL[2] & FL[3] & FL[4] & FL[5] & FL[6] & FL[7]; if (all) break; }
            tile_st(KT, KSTR, kreg, tid); tile_st(VT, VSTR, vreg, tid);
            if (tid < 128) RK[tid] = rsqrtf(hsum4(rkreg) * (1.0f / 128.0f) + EPSN);
            __syncthreads();
            if (kb > 0) { const size_t k0row = (size_t)b * SEQ + 128 * (kb - 1);
                tile_ld(kreg, PROJ + k0row * INW + C_SK + 128 * hd, INW, tid); tile_ld(vreg, PROJ + k0row * INW + C_SV + 128 * hd, INW, tid);
                if (tid < 128) rkreg = *(const GAS f32x4*)(ssqsb + ((k0row + tid) * 32 + 16 + hd) * 4); }
            const int k0b = 128 * kb;
            if (k0b < qhi && !wdone) {
                for (int st = 3; st >= 0; --st) {
                    const int k0 = k0b + 32 * st;
                    if (k0 >= qhi) continue;
                    const f32x16 s = st_tile(KT, 32 * st, qf, r, h);
                    bf16x8 pb[2];
                    if (k0 + 31 >= qlo) sb_subtile<true>(s, RK + 32 * st, qscale, k0, tq, h, R, pb); else sb_subtile<false>(s, RK + 32 * st, qscale, k0, tq, h, R, pb);
#pragma unroll
                    for (int dt = 0; dt < 4; ++dt)
#pragma unroll
                        for (int s2 = 0; s2 < 2; ++s2) O[dt] = MFMA32(tr_frag(VT, VSTR, 32 * st + 16 * s2, 32 * dt, lane), pb[s2], O[dt]);
                }
                wdone = __all(R > SB_EXIT2);
            }
            if (lane == 0) FL[w] = wdone ? 1u : 0u;
        }
        float ss = 0.f;
#pragma unroll
        for (int dt = 0; dt < 4; ++dt)
#pragma unroll
            for (int i = 0; i < 16; ++i) ss += O[dt][i] * O[dt][i];
        ss += xor32(ss, h);
        const float rstd = rsqrtf(ss * (1.0f / 128.0f) + EPSN);
#pragma unroll
        for (int dt = 0; dt < 4; ++dt)
#pragma unroll
            for (int Gq = 0; Gq < 4; ++Gq) {
                const int d = 32 * dt + 8 * Gq + 4 * h; const f32x4 g = *(const f32x4*)(gout + d);
                v2u wv; wv.x = pk_bf16(O[dt][4 * Gq] * rstd * g[0], O[dt][4 * Gq + 1] * rstd * g[1]); wv.y = pk_bf16(O[dt][4 * Gq + 2] * rstd * g[2], O[dt][4 * Gq + 3] * rstd * g[3]);
                *(GAS v2u*)(MIX + pg8::blk_elem((int)qrow, 2048 + 128 * hd + d, DM)) = wv;
            }
    }
}
DI void cross_stage(LAS unsigned char* lds, const float* CKV, const float* gk, LAS float* RKc, int b, int ch, int kh, bool withV, int tid) {
    for (int chn = tid; chn < 128 * 16; chn += NWAVES * 64) {
        const int rr = chn >> 4, c = chn & 15; const float* src = CKV + (size_t)(b * NMEM + 128 * kh + rr) * (2 * CW) + 128 * ch + 8 * c;
        const f32x4 a0 = *(const GAS f32x4*)src, a1 = *(const GAS f32x4*)(src + 4); const f32x4 g0 = *(const f32x4*)(gk + 8 * c), g1 = *(const f32x4*)(gk + 8 * c + 4); const float rs = RKc[128 * kh + rr];
        v4u o; o.x = pk_bf16(a0[0] * rs * g0[0], a0[1] * rs * g0[1]); o.y = pk_bf16(a0[2] * rs * g0[2], a0[3] * rs * g0[3]); o.z = pk_bf16(a1[0] * rs * g1[0], a1[1] * rs * g1[1]); o.w = pk_bf16(a1[2] * rs * g1[2], a1[3] * rs * g1[3]);
        *(LAS v4u*)(lds + L_KT + rr * KSTR + c * 16) = o;
        if (withV) { const f32x4 v0 = *(const GAS f32x4*)(src + CW), v1 = *(const GAS f32x4*)(src + CW + 4);
            v4u ov; ov.x = pk_bf16(v0[0], v0[1]); ov.y = pk_bf16(v0[2], v0[3]); ov.z = pk_bf16(v1[0], v1[1]); ov.w = pk_bf16(v1[2], v1[3]);
            *(LAS v4u*)(lds + L_VT + rr * VSTR + c * 16) = ov; }
    }
}
DI void cross_unit(LAS unsigned char* lds, const float* CQ, const float* CKV, const float* gq, const float* gk, bf16* CO, int unit, int tid) {
    const int lane = tid & 63, w = __builtin_amdgcn_readfirstlane(tid >> 6), r = lane & 31, h = lane >> 5;
    const int qb = unit & 31, ch = (unit >> 5) & 3, b = unit >> 7;
    LAS unsigned char* KT = lds + L_KT; LAS unsigned char* VT = lds + L_VT; LAS float* RKc = (LAS float*)(lds + L_RK);
    const size_t qrow = (size_t)b * SEQ + 256 * qb + 32 * w + r;
    __syncthreads();
    {
        const int key = tid >> 1, half = tid & 1; const float* src = CKV + (size_t)(b * NMEM + key) * (2 * CW) + 128 * ch + 64 * half; float s = 0.f;
#pragma unroll
        for (int j = 0; j < 16; ++j) { const f32x4 v = *(const GAS f32x4*)(src + 4 * j); s += (v.x * v.x + v.y * v.y) + (v.z * v.z + v.w * v.w); }
        s += __shfl_xor(s, 1);
        if (half == 0) RKc[key] = rsqrtf(s * (1.0f / 128.0f) + EPSN);
    }
    bf16x8 qf[8];
    {
        const float* qp = CQ + qrow * CW + 128 * ch; f32x4 qv[8][2]; float s = 0.f;
#pragma unroll
        for (int ks = 0; ks < 8; ++ks) { qv[ks][0] = *(const GAS f32x4*)(qp + 16 * ks + 8 * h); qv[ks][1] = *(const GAS f32x4*)(qp + 16 * ks + 8 * h + 4);
            s += (qv[ks][0].x * qv[ks][0].x + qv[ks][0].y * qv[ks][0].y) + (qv[ks][0].z * qv[ks][0].z + qv[ks][0].w * qv[ks][0].w) + (qv[ks][1].x * qv[ks][1].x + qv[ks][1].y * qv[ks][1].y) + (qv[ks][1].z * qv[ks][1].z + qv[ks][1].w * qv[ks][1].w); }
        s += __shfl_xor(s, 32);
        const float rs = rsqrtf(s * (1.0f / 128.0f) + EPSN) * 0.08838834764831845f;
#pragma unroll
        for (int ks = 0; ks < 8; ++ks) { const f32x4 g0 = *(const f32x4*)(gq + 16 * ks + 8 * h), g1 = *(const f32x4*)(gq + 16 * ks + 8 * h + 4); const f32x4 a0 = qv[ks][0] * g0 * rs, a1 = qv[ks][1] * g1 * rs;
            qf[ks] = pack8(a0[0], a0[1], a0[2], a0[3], a1[0], a1[1], a1[2], a1[3]); }
    }
    __syncthreads();
    float mx = -3.0e38f;
    for (int kh = 0; kh < 2; ++kh) {
        if (kh) __syncthreads();
        cross_stage(lds, CKV, gk, RKc, b, ch, kh, false, tid);
        __syncthreads();
#pragma unroll 1
        for (int st = 0; st < 4; ++st) { const f32x16 s = st_tile(KT, 32 * st, qf, r, h);
#pragma unroll
            for (int i = 0; i < 16; ++i) mx = fmaxf(mx, s[i]); }
    }
    mx = fmaxf(mx, __shfl_xor(mx, 32));
    f32x16 O[4]; float lsum = 0.f;
#pragma unroll
    for (int dt = 0; dt < 4; ++dt)
#pragma unroll
        for (int i = 0; i < 16; ++i) O[dt][i] = 0.f;
    for (int kh = 0; kh < 2; ++kh) {
        __syncthreads();
        cross_stage(lds, CKV, gk, RKc, b, ch, kh, true, tid);
        __syncthreads();
#pragma unroll 1
        for (int st = 0; st < 4; ++st) {
            const f32x16 s = st_tile(KT, 32 * st, qf, r, h); float p[16];
#pragma unroll
            for (int i = 0; i < 16; ++i) { p[i] = __expf(s[i] - mx); lsum += p[i]; }
            bf16x8 pb[2];
#pragma unroll
            for (int s2 = 0; s2 < 2; ++s2) pb[s2] = pack8(p[8 * s2], p[8 * s2 + 1], p[8 * s2 + 2], p[8 * s2 + 3], p[8 * s2 + 4], p[8 * s2 + 5], p[8 * s2 + 6], p[8 * s2 + 7]);
#pragma unroll
            for (int dt = 0; dt < 4; ++dt)
#pragma unroll
                for (int s2 = 0; s2 < 2; ++s2) O[dt] = MFMA32(tr_frag(VT, VSTR, 32 * st + 16 * s2, 32 * dt, lane), pb[s2], O[dt]);
        }
    }
    lsum += __shfl_xor(lsum, 32);
    const float inv = 1.0f / lsum;
#pragma unroll
    for (int dt = 0; dt < 4; ++dt)
#pragma unroll
        for (int G = 0; G < 4; ++G) { const int d = 32 * dt + 8 * G + 4 * h;
            v2u wv; wv.x = pk_bf16(O[dt][4 * G] * inv, O[dt][4 * G + 1] * inv); wv.y = pk_bf16(O[dt][4 * G + 2] * inv, O[dt][4 * G + 3] * inv); *(GAS v2u*)(CO + pg8::blk_elem((int)qrow, 128 * ch + d, CW)) = wv; }
}
DI void ld8(const bf16* p, float (&o)[8]) { const v4u a = *(const GAS v4u*)p; const unsigned aw[4] = {a.x, a.y, a.z, a.w};
#pragma unroll
    for (int e = 0; e < 4; ++e) { o[2 * e] = bf2f((unsigned short)(aw[e] & 0xffff)); o[2 * e + 1] = bf2f((unsigned short)(aw[e] >> 16)); } }
DI void ffn_fix(const bf16* UB, bf16* ACT, const float* cw, const float* cb, int gt, int NT) {
    constexpr int NC = DFF / 8;
    for (int it = gt; it < (M / 64) * 2 * NC; it += NT) {
        const int cc = it % NC, rr = it / NC, rho = rr & 1, blk = rr >> 1, n0 = 8 * cc; const bool first = (blk & 127) == 0;
        const bf16* cur = UB + ((size_t)blk * 4 + rho) * DFF2; const bf16* prv = UB + ((size_t)(blk - 1) * 4) * DFF2;
        const bf16* p1 = rho ? UB + ((size_t)blk * 4) * DFF2 : prv + 3 * (size_t)DFF2;
        const bf16* p2 = rho ? prv + 3 * (size_t)DFF2 : prv + 2 * (size_t)DFF2;
        const bool z1 = (rho == 0) && first, z2 = first;
        float o[2][8];
#pragma unroll
        for (int hf = 0; hf < 2; ++hf) {
            const int col = hf * DFF + n0; float x0[8], x1[8], x2[8];
            ld8(cur + col, x0);
            if (!z1) ld8(p1 + col, x1); else {
#pragma unroll
                for (int e = 0; e < 8; ++e) x1[e] = 0.f; }
            if (!z2) ld8(p2 + col, x2); else {
#pragma unroll
                for (int e = 0; e < 8; ++e) x2[e] = 0.f; }
#pragma unroll
            for (int e = 0; e < 8; ++e) o[hf][e] = cb[col + e] + cw[col + e] * x2[e] + cw[(size_t)DFF2 + col + e] * x1[e] + cw[2 * (size_t)DFF2 + col + e] * x0[e];
        }
        float a[8];
#pragma unroll
        for (int e = 0; e < 8; ++e) a[e] = o[0][e] * __builtin_amdgcn_rcpf(1.0f + __expf(-o[0][e])) * o[1][e];
        v4u ov; ov.x = pk_bf16(a[0], a[1]); ov.y = pk_bf16(a[2], a[3]); ov.z = pk_bf16(a[4], a[5]); ov.w = pk_bf16(a[6], a[7]);
        *(GAS v4u*)(ACT + pg8::blk_elem(blk * 64 + rho, n0, DFF)) = ov;
    }
}
struct Args { Ptrs p; int ph_lo, ph_hi; };
constexpr int N_PHASES = 12;
__global__ void __launch_bounds__(NWAVES * 64, 2) mk_fwd(Args args) {
    extern __shared__ __attribute__((aligned(16))) unsigned char lds_raw[];
    LAS unsigned char* lds = (LAS unsigned char*)lds_raw;
    volatile LAS unsigned* MISC = (volatile LAS unsigned*)(lds + MISC_OFF);
    const int tid = threadIdx.x, lane = tid & 63, wave = __builtin_amdgcn_readfirstlane(tid >> 6);
    const int G = gridDim.x, bx = blockIdx.x;
    const Ptrs& P = args.p; unsigned char* ws = P.ws;
    gu32* ctl = (gu32*)(ws + WS_CTL);
    for (int u = tid; u < (LDS_BYTES - LDSCTL_OFF) / 4; u += NWAVES * 64) ((LAS unsigned*)(lds + LDSCTL_OFF))[u] = 0u;
    __syncthreads();
    XcdBarrier bar = xcd_barrier_post((unsigned*)(ctl + CW_BAR), MISC + 8);
    const int lo = args.ph_lo, hi = args.ph_hi;
#ifndef PHMASK
#define PHMASK 0xffff
#endif
#define IN(k) (((PHMASK >> (k)) & 1) && lo <= (k) && (k) < hi)
#define SEAM(k) do { if (IN(k) && IN((k) + 1)) xcd_barrier(bar); } while (0)
    bf16* HB = (bf16*)(ws + WS_HB); bf16* PROJ = (bf16*)(ws + WS_PROJ);
    const int gw = bx * NWAVES + wave, NGW = G * NWAVES, gt = bx * NWAVES * 64 + tid, NT = G * NWAVES * 64;

    if (IN(0)) { p0_prologue(P, lds, gw, NGW, wave, lane); }
    SEAM(0);
    if (IN(1)) {
        pg8::Gemm g{HB, (const bf16*)(ws + WS_WIN), M, INW, DM, DM}; pg8::StaticOrder S; S.init(M, INW, G, bx);
        pg8::EpiProj E{PROJ, (const float*)(ws + WS_SSQ0), (const float*)(ws + WS_COS), (const float*)(ws + WS_SIN), P.sbq_norm, P.sbk_norm, (float*)(ws + WS_SSQSB)};
        pg8::gemm_phase<pg8::EpiProj, pg8::StaticOrder, true, true>(lds, g, S, E);
    }
    SEAM(1);
    if (IN(2)) { for (int u = bx; u < 2048; u += G) ret_kv_unit(lds, PROJ, (float*)(ws + WS_KV), u, tid); }
    SEAM(2);
    if (IN(3)) { ret_scan((const float*)(ws + WS_KV), (bf16*)(ws + WS_ST), gt, NT); }
    SEAM(3);
    if (IN(4)) {
        sb_phase(lds, PROJ, (bf16*)(ws + WS_MIX), (const float*)(ws + WS_SSQSB), P.sbo_norm, bx, G, tid);
        ret_out_phase(lds, PROJ, (bf16*)(ws + WS_MIX), (const bf16*)(ws + WS_ST), P.ret_norm, bx, G, tid);
        __syncthreads();
    }
    SEAM(4);
    if (IN(5)) {
        pg8::Gemm g{(const bf16*)(ws + WS_MIX), (const bf16*)(ws + WS_WOUT), M, DM, DM, DM}; pg8::StaticOrder S; S.init(M, DM, G, bx);
        pg8::EpiRes<true> E{P.x, P.out, HB, (float*)(ws + WS_SSQ1)};
        pg8::gemm_phase<pg8::EpiRes<true>, pg8::StaticOrder, true, true>(lds, g, S, E);
    }
    SEAM(5);
    if (IN(6)) {
        { pg8::Gemm g{HB, (const bf16*)(ws + WS_WQKV), M, CW, DM, DM}; pg8::StaticOrder S; S.init(M, CW, G, bx);
          pg8::EpiScaleF32 E{(float*)(ws + WS_CQ), CW, (const float*)(ws + WS_SSQ1)};
          pg8::gemm_phase<pg8::EpiScaleF32, pg8::StaticOrder, true, true>(lds, g, S, E); }
        __syncthreads();
        { pg8::Gemm g{(const bf16*)(ws + WS_MB), (const bf16*)(ws + WS_WQKV) + (size_t)CW * DM, BATCH * NMEM, 2 * CW, DM, DM}; pg8::StaticOrder S; S.init(BATCH * NMEM, 2 * CW, G, (bx + G / 2) % G);
          pg8::EpiScaleF32 E{(float*)(ws + WS_CKV), 2 * CW, (const float*)(ws + WS_SSQM)};
          pg8::gemm_phase<pg8::EpiScaleF32, pg8::StaticOrder, true, true>(lds, g, S, E); }
    }
    SEAM(6);
    if (IN(7)) { for (int u = bx; u < 256; u += G) cross_unit(lds, (const float*)(ws + WS_CQ), (const float*)(ws + WS_CKV), P.cq_norm, P.ck_norm, (bf16*)(ws + WS_CO), u, tid); __syncthreads(); }
    SEAM(7);
    if (IN(8)) {
        pg8::Gemm g{(const bf16*)(ws + WS_CO), (const bf16*)(ws + WS_WO), M, DM, CW, CW}; pg8::StaticOrder S; S.init(M, DM, G, bx);
        pg8::EpiRes<true> E{P.out, P.out, HB, (float*)(ws + WS_SSQ2)};
        pg8::gemm_phase<pg8::EpiRes<true>, pg8::StaticOrder, true, true>(lds, g, S, E);
    }
    SEAM(8);
    if (IN(9)) {
        pg8::Gemm g{HB, (const bf16*)(ws + WS_WUP), M, DFF2, DM, DM}; pg8::StaticOrder S; S.init(M, DFF2, G, bx);
        pg8::EpiFfn E{(bf16*)(ws + WS_ACT), (bf16*)(ws + WS_UB), (const float*)(ws + WS_SSQ2), P.conv_w, P.conv_b, (LAS float*)(lds + L_EPIW + wave * 1024)};
        pg8::gemm_phase<pg8::EpiFfn, pg8::StaticOrder, true, true>(lds, g, S, E);
    }
    SEAM(9);
    if (IN(10)) { ffn_fix((const bf16*)(ws + WS_UB), (bf16*)(ws + WS_ACT), P.conv_w, P.conv_b, gt, NT); }
    SEAM(10);
    if (IN(11)) {
        pg8::Gemm g{(const bf16*)(ws + WS_ACT), (const bf16*)(ws + WS_WDOWN), M, DM, DFF, DFF}; pg8::StaticOrder S; S.init(M, DM, G, bx);
        pg8::EpiRes<false> E{P.out, P.out, nullptr, nullptr};
        pg8::gemm_phase<pg8::EpiRes<false>, pg8::StaticOrder, true, true>(lds, g, S, E);
    }
#undef IN
#undef SEAM
}

#ifndef MK_CUTS
#define MK_CUTS 0
#endif
extern "C" void kernel_launch(void* const* d_in, const int* in_sizes, int n_in, void* d_out, int out_size, void* d_ws, size_t ws_size, hipStream_t stream) {
    static int grid = 0;
    if (grid == 0) {
        if (n_in != 21 || in_sizes[0] != M * DM || out_size != M * DM || ws_size < WS_END) { fprintf(stderr, "kernel_launch: unexpected shapes (n_in %d, in0 %d, out %d, ws %zu < %zu); nothing launched\n", n_in, n_in > 0 ? in_sizes[0] : -1, out_size, ws_size, (size_t)WS_END); grid = -1; return; }
        int dev = 0, cus = 0, per_cu = 0;
        if (hipGetDevice(&dev) != hipSuccess || hipDeviceGetAttribute(&cus, hipDeviceAttributeMultiprocessorCount, dev) != hipSuccess) { grid = -1; return; }
        if (hipFuncSetAttribute((const void*)mk_fwd, hipFuncAttributeMaxDynamicSharedMemorySize, LDS_BYTES) != hipSuccess) { fprintf(stderr, "kernel_launch: hipFuncSetAttribute failed\n"); grid = -1; return; }
        if (hipOccupancyMaxActiveBlocksPerMultiprocessor(&per_cu, (const void*)mk_fwd, NWAVES * 64, LDS_BYTES) != hipSuccess || per_cu < 1) fprintf(stderr, "kernel_launch: note: occupancy query reports %d\n", per_cu);
        (void)hipGetLastError();
        grid = cus;
    }
    if (grid < 0) return;
    if (hipMemsetAsync((char*)d_ws + WS_CTL, 0, CTL_ZERO_BYTES, stream) != hipSuccess) return;
    Args a{};
    const float** pp = (const float**)&a.p;
    for (int i = 0; i < 21; ++i) pp[i] = (const float*)d_in[i];
    a.p.out = (float*)d_out; a.p.ws = (unsigned char*)d_ws;
#if MK_CUTS
    for (int ph = 0; ph < N_PHASES; ++ph) { a.ph_lo = ph; a.ph_hi = ph + 1; hipLaunchKernelGGL(mk_fwd, dim3(grid), dim3(NWAVES * 64), LDS_BYTES, stream, a); }
#else
    a.ph_lo = 0; a.ph_hi = N_PHASES;
    hipLaunchKernelGGL(mk_fwd, dim3(grid), dim3(NWAVES * 64), LDS_BYTES, stream, a);
#endif
    const hipError_t le = hipPeekAtLastError();
    if (le != hipSuccess) fprintf(stderr, "kernel_launch: launch failed: %s\n", hipGetErrorName(le));
}
```

```cpp
#include <hip/hip_runtime.h>
#include <cstdio>
#include <cstdint>
namespace pg8 {
#define PG8_LAS __attribute__((address_space(3)))
typedef unsigned short bf16_t;
typedef short bf16x8 __attribute__((ext_vector_type(8)));
typedef float f32x4 __attribute__((ext_vector_type(4)));
typedef unsigned u32x4 __attribute__((ext_vector_type(4)));
typedef unsigned u32x2 __attribute__((ext_vector_type(2)));
constexpr int BM = 256, BK = 64, HALF = 128, HTB = HALF * BK * 2  , STAGE_BYTES = 8 * HTB, NXCD = 8, WGM = 8;

__host__ __device__ __forceinline__ int lds_byte(int r, int c) { const int st = (r >> 4) * 2 + (c >> 5), rr = r & 15, cc = c & 31, ob = rr * 64 + cc * 2; return st * 1024 + (ob ^ (((ob >> 9) & 1) << 5)); }
__host__ __device__ __forceinline__ void stage_rc(int b, int& R, int& C) { const int st = b / 1024, sb = b % 1024, swz = sb ^ (((sb >> 9) & 1) << 5); R = (st >> 1) * 16 + swz / 64; C = (st & 1) * 32 + (swz % 64) / 2; }
__host__ __device__ __forceinline__ int perm32(int rho) { const int n = rho >> 4, i = rho & 15; return 8 * (i >> 2) + 4 * n + (i & 3); }
template <int PERM> __host__ __device__ __forceinline__ int permrow(int R) {
    if (PERM == 1) return (R & ~31) + perm32(R & 31);
    if (PERM == 2) return 64 * ((R >> 4) & 1) + 16 * (R >> 5) + (R & 15);
    return R;
}

template <int PERM> __host__ __device__ __forceinline__ int invpermrow(int d) {
    if (PERM == 1) { const int c = d & 31; return (d & ~31) + 16 * ((c >> 2) & 1) + 4 * (c >> 3) + (c & 3); }
    if (PERM == 2) return 32 * ((d >> 4) & 3) + 16 * (d >> 6) + (d & 15);
    return d;
}
__host__ __device__ __forceinline__ size_t blk_elem(int row, int col, int C) {
    return ((size_t)((row >> 8) * (C >> 6) + (col >> 6)) * 32768 + (size_t)(((row >> 7) & 1) * 16384 + lds_byte(row & 127, col & 63))) >> 1;
}

struct Unit { int pm, pn; };
struct Gemm { const bf16_t* A; const bf16_t* Bt; int M, N, K, lda; };

struct StaticOrder {
    int nM, nN, nwg, G, c, pm0;
    __host__ __device__ void init(int M, int N, int G_, int c_, int pm0_ = 0) { nM = M / BM; nN = N / BM; nwg = nM * nN; G = G_; c = c_; pm0 = pm0_; }
    __host__ __device__ bool next(int i, Unit& u) const {
        const long L = (long)i * G + c; if (L >= nwg) return false;
        int wgid = (int)L; { const int q = nwg / NXCD, r = nwg % NXCD, xcd = wgid % NXCD, off = wgid / NXCD; wgid = (xcd < r ? xcd * (q + 1) : r * (q + 1) + (xcd - r) * q) + off; }
        const int nig = WGM * nN, gid = wgid / nig, fm = gid * WGM, gsz = (nM - fm) < WGM ? (nM - fm) : WGM;
        u.pm = pm0 + fm + ((wgid % nig) % gsz); u.pn = (wgid % nig) / gsz; return true;
    }
    __device__ __forceinline__ void a_ready(const Unit&) const {}
    __device__ __forceinline__ void done(const Unit&) const {}
};

typedef float f32x2 __attribute__((ext_vector_type(2)));
typedef __bf16 bf16v2 __attribute__((ext_vector_type(2)));
__device__ __forceinline__ unsigned pk_bf16(float lo, float hi) { const f32x2 f = {lo, hi}; const bf16v2 r = __builtin_convertvector(f, bf16v2); return __builtin_bit_cast(unsigned, r); }
constexpr float EPSN = 1e-6f;
__constant__ float LOGG[16] = { -3.174869716e-02f, -1.574835740e-02f, -7.843177766e-03f, -3.913899418e-03f, -1.955034910e-03f, -9.770396864e-04f, -4.884005175e-04f, -2.441704273e-04f,
                                -1.220777631e-04f, -6.103701890e-05f, -3.051804379e-05f, -1.525890548e-05f, -7.629423635e-06f, -3.814704542e-06f, -1.907350452e-06f, -9.536747712e-07f };
__device__ __forceinline__ float hsum4(const f32x4 v) { return (v[0] + v[1]) + (v[2] + v[3]); }
__device__ __forceinline__ float dot4(const f32x4 a, const f32x4 b) { return (a[0] * b[0] + a[1] * b[1]) + (a[2] * b[2] + a[3] * b[3]); }
__device__ __forceinline__ float row_rstd64(const float* part, int row, int fq, float invn) {
    const f32x4* p = (const f32x4*)(part + (size_t)row * 64 + fq * 16);
    float s = (hsum4(p[0]) + hsum4(p[1])) + (hsum4(p[2]) + hsum4(p[3]));
    s += __shfl_xor(s, 16); s += __shfl_xor(s, 32);
    return rsqrtf(s * invn + EPSN);
}

#define EPI_FENCE() asm volatile("" ::: "memory")
struct EpiProj {
    static constexpr int PERM = 2; static constexpr bool AFTER_DRAIN = false;
    bf16_t* P; const float* ssq0; const float* cosT; const float* sinT; const float* gq; const float* gk; float* ssqsb;
    template <int REG> __device__ __forceinline__ void body(const f32x4 (&acc)[2][2][4][2], const Unit& u, int wr, int wc, int fr, int fq) const {
        constexpr bool ROPE = (REG == 0 || REG == 2);
        const int pnr = u.pn & 7, d0 = 16 * wc + 4 * fq, rowb = u.pm * BM + wr * 64 + fr;
        float lg[2] = {0.f, 0.f}; f32x4 g0 = {1.f, 1.f, 1.f, 1.f}, g1 = g0;
        if (ROPE) { lg[0] = LOGG[2 * pnr]; lg[1] = LOGG[2 * pnr + 1]; }
        if (REG == 1 || REG == 5) { const float* g = (REG == 1) ? gq : gk; g0 = *(const f32x4*)(g + d0); g1 = *(const f32x4*)(g + 64 + d0); }
        float rsv[8];
#pragma unroll
        for (int g = 0; g < 8; ++g) rsv[g] = ssq0[rowb + (g >> 2) * HALF + (g & 3) * 16];
        f32x4 csn = {0.f, 0.f, 0.f, 0.f}, snn = csn;
        if (ROPE) { const int t = rowb & 8191; csn = *(const f32x4*)(cosT + (size_t)t * 64 + d0); snn = *(const f32x4*)(sinT + (size_t)t * 64 + d0); }
        EPI_FENCE();
#pragma unroll
        for (int g = 0; g < 8; ++g) {
            const int ai = g >> 2, m = g & 3;
            const int row = rowb + ai * HALF + m * 16;
            const float rs = rsqrtf(rsv[g] * (1.0f / 4096.0f) + EPSN);
            const int t = row & 8191; const float cpos = (float)(t & 127);
            const f32x4 cs = csn, sn = snn;
            if (ROPE && g < 7) { const int tn = (rowb + ((g + 1) >> 2) * HALF + ((g + 1) & 3) * 16) & 8191; csn = *(const f32x4*)(cosT + (size_t)tn * 64 + d0); snn = *(const f32x4*)(sinT + (size_t)tn * 64 + d0); }
            EPI_FENCE();
            bf16_t* rowp = P + (size_t)row * 14336 + u.pn * BM + d0;
#pragma unroll
            for (int bj = 0; bj < 2; ++bj) {
                const f32x4 v0 = acc[ai][bj][m][0] * rs, v1 = acc[ai][bj][m][1] * rs;
                f32x4 o0 = v0, o1 = v1;
                if (REG == 0) { const float sc = 0.08838834764831845f * __expf(cpos * lg[bj]); o0 = (v0 * cs - v1 * sn) * sc; o1 = (v1 * cs + v0 * sn) * sc; }
                if (REG == 2) { const float sc = __expf(-cpos * lg[bj]); o0 = (v0 * cs - v1 * sn) * sc; o1 = (v1 * cs + v0 * sn) * sc; }
                if (REG == 4) {
#pragma unroll
                    for (int j = 0; j < 4; ++j) { o0[j] = v0[j] * __builtin_amdgcn_rcpf(1.0f + __expf(-v0[j])); o1[j] = v1[j] * __builtin_amdgcn_rcpf(1.0f + __expf(-v1[j])); } }
                if (REG == 1 || REG == 5) {
                    float s = dot4(v0, v0) + dot4(v1, v1); s += __shfl_xor(s, 16); s += __shfl_xor(s, 32);
                    if (fq == 0) ssqsb[((size_t)row * 32 + (REG == 1 ? 0 : 16) + 2 * pnr + bj) * 4 + wc] = s;
                    o0 = v0 * g0; o1 = v1 * g1; }
                u32x2 w0, w1; w0.x = pk_bf16(o0[0], o0[1]); w0.y = pk_bf16(o0[2], o0[3]); w1.x = pk_bf16(o1[0], o1[1]); w1.y = pk_bf16(o1[2], o1[3]);
                *(u32x2*)(rowp + bj * HALF) = w0; *(u32x2*)(rowp + bj * HALF + 64) = w1;
            }
        }
    }
    __device__ __forceinline__ void operator()(const f32x4 (&acc)[2][2][4][2], const Unit& u, int wr, int wc, int fr, int fq) const {
        const int reg = u.pn >> 3;
        if (reg == 0) body<0>(acc, u, wr, wc, fr, fq); else if (reg == 1) body<1>(acc, u, wr, wc, fr, fq); else if (reg == 2) body<2>(acc, u, wr, wc, fr, fq);
        else if (reg == 4) body<4>(acc, u, wr, wc, fr, fq); else if (reg == 5) body<5>(acc, u, wr, wc, fr, fq); else body<3>(acc, u, wr, wc, fr, fq);
    }
};

__device__ __forceinline__ f32x4 bf4_lo(const u32x4 w) { return (f32x4){__builtin_bit_cast(float, w.x << 16), __builtin_bit_cast(float, w.x & 0xffff0000u), __builtin_bit_cast(float, w.y << 16), __builtin_bit_cast(float, w.y & 0xffff0000u)}; }
__device__ __forceinline__ f32x4 bf4_hi(const u32x4 w) { return (f32x4){__builtin_bit_cast(float, w.z << 16), __builtin_bit_cast(float, w.z & 0xffff0000u), __builtin_bit_cast(float, w.w << 16), __builtin_bit_cast(float, w.w & 0xffff0000u)}; }
template <int MODE> struct EpiRes {
    static constexpr int PERM = 1; static constexpr bool AFTER_DRAIN = false;
    const float* x; float* out; bf16_t* hb; float* ssq;
    __device__ __forceinline__ void operator()(const f32x4 (&acc)[2][2][4][2], const Unit& u, int wr, int wc, int fr, int fq) const {
        const int col0 = u.pn * BM + wc * 32 + 8 * fq, rowb = u.pm * BM + wr * 64 + fr;
        f32x4 bn[2][2];
#pragma unroll
        for (int bj = 0; bj < 2; ++bj) {
            if (MODE == 0) { const size_t off = (size_t)rowb * 4096 + col0 + bj * HALF; bn[bj][0] = *(const f32x4*)(x + off); bn[bj][1] = *(const f32x4*)(x + off + 4); }
            else { const u32x4 w = *(const u32x4*)(hb + blk_elem(rowb, col0 + bj * HALF, 4096)); bn[bj][0] = bf4_lo(w); bn[bj][1] = bf4_hi(w); } }
#pragma unroll
        for (int g = 0; g < 8; ++g) {
            const int ai = g >> 2, m = g & 3, row = rowb + ai * HALF + m * 16; float s = 0.f;
            f32x4 b[2][2];
#pragma unroll
            for (int bj = 0; bj < 2; ++bj) { b[bj][0] = bn[bj][0]; b[bj][1] = bn[bj][1]; }
            if (g < 7) { const int rown = rowb + ((g + 1) >> 2) * HALF + ((g + 1) & 3) * 16;
#pragma unroll
                for (int bj = 0; bj < 2; ++bj) {
                    if (MODE == 0) { const size_t off = (size_t)rown * 4096 + col0 + bj * HALF; bn[bj][0] = *(const f32x4*)(x + off); bn[bj][1] = *(const f32x4*)(x + off + 4); }
                    else { const u32x4 w = *(const u32x4*)(hb + blk_elem(rown, col0 + bj * HALF, 4096)); bn[bj][0] = bf4_lo(w); bn[bj][1] = bf4_hi(w); } } }
            EPI_FENCE();
#pragma unroll
            for (int bj = 0; bj < 2; ++bj) {
                const f32x4 o0 = b[bj][0] + acc[ai][bj][m][0], o1 = b[bj][1] + acc[ai][bj][m][1];
                if (MODE == 2) { const size_t off = (size_t)row * 4096 + col0 + bj * HALF; *(f32x4*)(out + off) = o0; *(f32x4*)(out + off + 4) = o1; }
                else { u32x4 w; w.x = pk_bf16(o0[0], o0[1]); w.y = pk_bf16(o0[2], o0[3]); w.z = pk_bf16(o1[0], o1[1]); w.w = pk_bf16(o1[2], o1[3]); *(u32x4*)(hb + blk_elem(row, col0 + bj * HALF, 4096)) = w; s += dot4(o0, o0) + dot4(o1, o1); }
            }
            if (MODE != 2) { s += __shfl_xor(s, 16); s += __shfl_xor(s, 32); if (fq == 0) __hip_atomic_fetch_add(ssq + row, s, __ATOMIC_RELAXED, __HIP_MEMORY_SCOPE_AGENT); }
            EPI_FENCE();
        }
    }
};

struct EpiScaleF32 {
    static constexpr int PERM = 1; static constexpr bool AFTER_DRAIN = false;
    float* C; int ldc; const float* ssq;
    __device__ __forceinline__ void operator()(const f32x4 (&acc)[2][2][4][2], const Unit& u, int wr, int wc, int fr, int fq) const {
        const int col0 = u.pn * BM + wc * 32 + 8 * fq, rowb = u.pm * BM + wr * 64 + fr;
        float rsv[8];
#pragma unroll
        for (int g = 0; g < 8; ++g) rsv[g] = ssq[rowb + (g >> 2) * HALF + (g & 3) * 16];
        EPI_FENCE();
#pragma unroll
        for (int g = 0; g < 8; ++g) {
            const int ai = g >> 2, m = g & 3, row = rowb + ai * HALF + m * 16; const float rs = rsqrtf(rsv[g] * (1.0f / 4096.0f) + EPSN);
#pragma unroll
            for (int bj = 0; bj < 2; ++bj) { float* p = C + (size_t)row * ldc + col0 + bj * HALF; *(f32x4*)p = acc[ai][bj][m][0] * rs; *(f32x4*)(p + 4) = acc[ai][bj][m][1] * rs; }
        }
    }
};
struct EpiScaleBf16 {
    static constexpr int PERM = 1; static constexpr bool AFTER_DRAIN = false;
    bf16_t* O; int ldc; const float* ssq;
    __device__ __forceinline__ void operator()(const f32x4 (&acc)[2][2][4][2], const Unit& u, int wr, int wc, int fr, int fq) const {
        const int col0 = u.pn * BM + wc * 32 + 8 * fq, rowb = u.pm * BM + wr * 64 + fr;
        float rsv[8];
#pragma unroll
        for (int g = 0; g < 8; ++g) rsv[g] = ssq[rowb + (g >> 2) * HALF + (g & 3) * 16];
        EPI_FENCE();
#pragma unroll
        for (int g = 0; g < 8; ++g) {
            const int ai = g >> 2, m = g & 3, row = rowb + ai * HALF + m * 16; const float rs = rsqrtf(rsv[g] * (1.0f / 4096.0f) + EPSN);
#pragma unroll
            for (int bj = 0; bj < 2; ++bj) { const f32x4 v0 = acc[ai][bj][m][0] * rs, v1 = acc[ai][bj][m][1] * rs;
                u32x4 w; w.x = pk_bf16(v0[0], v0[1]); w.y = pk_bf16(v0[2], v0[3]); w.z = pk_bf16(v1[0], v1[1]); w.w = pk_bf16(v1[2], v1[3]);
                *(u32x4*)(O + (size_t)row * ldc + col0 + bj * HALF) = w; }
        }
    }
};

__device__ __forceinline__ float dpp_ror1(float x) { return __builtin_bit_cast(float, __builtin_amdgcn_update_dpp(0, __builtin_bit_cast(int, x), 0x121, 0xf, 0xf, false)); }
__device__ __forceinline__ float dpp_ror2(float x) { return __builtin_bit_cast(float, __builtin_amdgcn_update_dpp(0, __builtin_bit_cast(int, x), 0x122, 0xf, 0xf, false)); }
struct EpiFfn {
    static constexpr int PERM = 1; static constexpr bool AFTER_DRAIN = false;
    bf16_t* ACT; bf16_t* UB; const float* ssq; const float* cw; const float* cb; PG8_LAS float* wl;
    static constexpr int DFF = 11008;
    __device__ __forceinline__ void operator()(const f32x4 (&acc)[2][2][4][2], const Unit& u, int wr, int wc, int fr, int fq) const {
        const int cc0 = 32 * wc + 8 * fq, colg = u.pn * HALF + cc0, rowb = u.pm * BM + wr * 64 + fr;
        float rs[8];
#pragma unroll
        for (int g = 0; g < 8; ++g) rs[g] = ssq[rowb + (g >> 2) * HALF + (g & 3) * 16];
        {
            f32x4 wv[2][4][2];
#pragma unroll
            for (int bj = 0; bj < 2; ++bj)
#pragma unroll
                for (int t = 0; t < 4; ++t)
#pragma unroll
                    for (int n = 0; n < 2; ++n) { const int col = bj * DFF + colg + 4 * n; wv[bj][t][n] = (t < 3) ? *(const f32x4*)(cw + (size_t)t * (2 * DFF) + col) : *(const f32x4*)(cb + col); }
            EPI_FENCE();
#pragma unroll
            for (int bj = 0; bj < 2; ++bj)
#pragma unroll
                for (int t = 0; t < 4; ++t)
#pragma unroll
                    for (int n = 0; n < 2; ++n) *(PG8_LAS f32x4*)(wl + (bj * 4 + t) * 32 + 8 * fq + 4 * n) = wv[bj][t][n];
        }
#pragma unroll
        for (int g = 0; g < 8; ++g) rs[g] = rsqrtf(rs[g] * (1.0f / 4096.0f) + EPSN);
        asm volatile("s_waitcnt lgkmcnt(0)" ::: "memory");
#pragma unroll
        for (int n = 0; n < 2; ++n) {
#pragma unroll
            for (int ai = 0; ai < 2; ++ai) {
                const int row0 = rowb + ai * HALF, blk = (u.pm * BM + ai * HALF + wr * 64) >> 6;
                f32x4 sg[4];
#pragma unroll
                for (int bj = 0; bj < 2; ++bj) {
                    const PG8_LAS float* wp = wl + (bj * 4) * 32 + 8 * fq + 4 * n;
                    const f32x4 w0 = *(const PG8_LAS f32x4*)(wp), w1 = *(const PG8_LAS f32x4*)(wp + 32), w2 = *(const PG8_LAS f32x4*)(wp + 64), bb = *(const PG8_LAS f32x4*)(wp + 96);
                    f32x4 pr1 = {0.f, 0.f, 0.f, 0.f}, pr2 = pr1;
#pragma unroll
                    for (int m = 0; m < 4; ++m) {
                        const f32x4 x = acc[ai][bj][m][n] * rs[ai * 4 + m]; f32x4 r1, r2;
#pragma unroll
                        for (int j = 0; j < 4; ++j) { r1[j] = dpp_ror1(x[j]); r2[j] = dpp_ror2(x[j]); }
                        const f32x4 p1 = (m == 0) ? r1 : ((fr == 0) ? pr1 : r1);
                        const f32x4 p2 = (m == 0) ? r2 : ((fr < 2) ? pr2 : r2);
                        const f32x4 c = bb + w2 * x + w1 * p1 + w0 * p2;
                        pr1 = r1; pr2 = r2;
                        if (bj == 0) {
#pragma unroll
                            for (int j = 0; j < 4; ++j) sg[m][j] = c[j] * __builtin_amdgcn_rcpf(1.0f + __expf(-c[j])); }
                        else {
                            const f32x4 o = sg[m] * c; u32x2 pkd; pkd.x = pk_bf16(o[0], o[1]); pkd.y = pk_bf16(o[2], o[3]);
                            if (m > 0 || fr >= 2) *(u32x2*)(ACT + blk_elem(row0 + 16 * m, colg + 4 * n, DFF)) = pkd;
                        }
                        if (m == 0 || m == 3) {
                            const bool sel = (m == 0) ? (fr < 2) : (fr >= 14); const int slot = (m == 0) ? fr : 2 + (fr - 14);
                            if (sel) { u32x2 rw; rw.x = pk_bf16(x[0], x[1]); rw.y = pk_bf16(x[2], x[3]); *(u32x2*)(UB + ((size_t)blk * 4 + slot) * (2 * DFF) + bj * DFF + colg + 4 * n) = rw; }
                        }
                        __builtin_amdgcn_sched_barrier(0);
                    }
                }
            }
        }
    }
};

template <class Epi, class Sched, bool ALIGN_EPI = false, bool SP2 = false>
__device__ __forceinline__ void gemm_phase(PG8_LAS unsigned char* lds, const Gemm g, const Sched& S, const Epi& E) {
    const int tid = threadIdx.x, wid = __builtin_amdgcn_readfirstlane(tid >> 6), lane = tid & 63, wr = wid >> 2, wc = wid & 3, fr = lane & 15, fq = lane >> 4;
    const int K = g.K, nt = K / BK;
    unsigned voffA[2], voffB[2];
#pragma unroll
    for (int i = 0; i < 2; ++i) { voffA[i] = (unsigned)(tid * 16 + i * 8192); voffB[i] = voffA[i]; }
    const size_t kstep = 32768;
    const size_t hstep = 16384, hstepA = 16384;
    const size_t tstep = (size_t)K * 512, tstepA = (size_t)g.lda * 512;
    const unsigned ldsw = (unsigned)wid * 1024u;
    const int aoff = lds_byte(wr * 64 + fr, fq * 8), boff = lds_byte(wc * 32 + fr, fq * 8);
#define PG8_SA(b, h) (((b) * 2 + (h)) * HTB)
#define PG8_SB(b, h) ((4 + (b) * 2 + (h)) * HTB)
#define PG8_STAGE(bufoff, gbase, voff) do { _Pragma("unroll") for (int _i = 0; _i < 2; ++_i) \
        __builtin_amdgcn_global_load_lds((const unsigned*)((const char*)(gbase) + (voff)[_i]), (PG8_LAS unsigned*)(lds + (bufoff) + ldsw + _i * 8192), 16, 0, 0); } while (0)
#define PG8_LDA(dst, b, h) do { _Pragma("unroll") for (int m = 0; m < 4; ++m) _Pragma("unroll") for (int k = 0; k < 2; ++k) dst[m][k] = *(const PG8_LAS bf16x8*)(lds + PG8_SA(b, h) + aoff + m * 2048 + k * 1024); } while (0)
#define PG8_LDB(dst, b, h) do { _Pragma("unroll") for (int n = 0; n < 2; ++n) _Pragma("unroll") for (int k = 0; k < 2; ++k) dst[n][k] = *(const PG8_LAS bf16x8*)(lds + PG8_SB(b, h) + boff + n * 2048 + k * 1024); } while (0)
#define PG8_MMA(ai, bj, At, Bt) do { __builtin_amdgcn_s_setprio(1); _Pragma("unroll") for (int m = 0; m < 4; ++m) _Pragma("unroll") for (int n = 0; n < 2; ++n) _Pragma("unroll") for (int k = 0; k < 2; ++k) \
        acc[ai][bj][m][n] = __builtin_amdgcn_mfma_f32_16x16x32_bf16(Bt[n][k], At[m][k], acc[ai][bj][m][n], 0, 0, 0); __builtin_amdgcn_s_setprio(0); } while (0)
#define PG8_WAIT_V(n) asm volatile("s_waitcnt vmcnt(" #n ")" ::: "memory")
#define PG8_WAIT_L(n) asm volatile("s_waitcnt lgkmcnt(" #n ")" ::: "memory")
#define PG8_BAR __builtin_amdgcn_s_barrier()
#define PG8_SCHED __builtin_amdgcn_sched_barrier(0)
    Unit cur, nxt; int ui = 0;
    if (!S.next(0, cur)) return;
    f32x4 acc[2][2][4][2];
#pragma unroll
    for (int a = 0; a < 2; ++a)
#pragma unroll
        for (int b = 0; b < 2; ++b)
#pragma unroll
            for (int m = 0; m < 4; ++m)
#pragma unroll
                for (int n = 0; n < 2; ++n) acc[a][b][m][n] = (f32x4){0.f, 0.f, 0.f, 0.f};
    bf16x8 At[4][2], B0[2][2], B1[2][2];
    const char* cA = (const char*)g.A + (size_t)cur.pm * tstepA; const char* cB = (const char*)g.Bt + (size_t)cur.pn * tstep;
    S.a_ready(cur);
    if constexpr (SP2) {
        PG8_STAGE(PG8_SB(0, 0), cB, voffB); PG8_STAGE(PG8_SB(0, 1), cB + hstep, voffB); PG8_STAGE(PG8_SA(0, 0), cA, voffA); PG8_STAGE(PG8_SA(0, 1), cA + hstepA, voffA);
        if (wr == 1) PG8_BAR;
        PG8_WAIT_V(2); PG8_BAR;
        PG8_STAGE(PG8_SB(1, 0), cB + kstep, voffB); PG8_STAGE(PG8_SA(1, 0), cA + kstep, voffA); PG8_STAGE(PG8_SB(1, 1), cB + hstep + kstep, voffB);
        PG8_WAIT_V(6); PG8_BAR;
    } else {
        PG8_STAGE(PG8_SB(0, 0), cB, voffB); PG8_STAGE(PG8_SA(0, 0), cA, voffA); PG8_STAGE(PG8_SB(0, 1), cB + hstep, voffB); PG8_STAGE(PG8_SA(0, 1), cA + hstepA, voffA);
        if (wr == 1) PG8_BAR;
        PG8_WAIT_V(4); PG8_BAR;
        PG8_STAGE(PG8_SB(1, 0), cB + kstep, voffB); PG8_STAGE(PG8_SA(1, 0), cA + kstep, voffA); PG8_STAGE(PG8_SB(1, 1), cB + hstep + kstep, voffB);
        PG8_WAIT_V(6); PG8_BAR;
    }
    for (;;) {
        const bool has_next = S.next(ui + 1, nxt);
        const char* nA = has_next ? (const char*)g.A + (size_t)nxt.pm * tstepA : cA; const char* nB = has_next ? (const char*)g.Bt + (size_t)nxt.pn * tstep : cB;
        for (int t = 0; t < nt; t += 2) {
            const bool last = (t == nt - 2);
            const char* a1 = cA + (size_t)(t + 1) * kstep;
            const char* a2 = last ? nA : cA + (size_t)(t + 2) * kstep; const char* b2 = last ? nB : cB + (size_t)(t + 2) * kstep;
            const char* a3 = a2 + kstep; const char* b3 = b2 + kstep;
            if (last && has_next) S.a_ready(nxt);
            if constexpr (SP2) {
            PG8_LDB(B0, 0, 0); PG8_LDB(B1, 0, 1); PG8_SCHED; PG8_LDA(At, 0, 0); PG8_STAGE(PG8_SA(1, 1), a1 + hstepA, voffA);
            PG8_WAIT_V(8); PG8_WAIT_L(0); PG8_BAR; PG8_MMA(0, 0, At, B0); PG8_MMA(0, 1, At, B1); PG8_BAR; PG8_SCHED;
            PG8_LDA(At, 0, 1); PG8_STAGE(PG8_SB(0, 0), b2, voffB); PG8_STAGE(PG8_SB(0, 1), b2 + hstep, voffB); PG8_STAGE(PG8_SA(0, 0), a2, voffA);
            PG8_WAIT_V(8); PG8_WAIT_L(0); PG8_BAR; PG8_MMA(1, 0, At, B0); PG8_MMA(1, 1, At, B1); PG8_BAR; PG8_SCHED;
            PG8_LDB(B0, 1, 0); PG8_LDB(B1, 1, 1); PG8_SCHED; PG8_LDA(At, 1, 0); PG8_STAGE(PG8_SA(0, 1), a2 + hstepA, voffA);
            PG8_WAIT_V(8); PG8_WAIT_L(0); PG8_BAR; PG8_MMA(0, 0, At, B0); PG8_MMA(0, 1, At, B1); PG8_BAR; PG8_SCHED;
            PG8_LDA(At, 1, 1); PG8_STAGE(PG8_SB(1, 0), b3, voffB); PG8_STAGE(PG8_SB(1, 1), b3 + hstep, voffB); PG8_STAGE(PG8_SA(1, 0), a3, voffA);
            PG8_WAIT_V(8); PG8_WAIT_L(0); PG8_BAR; PG8_MMA(1, 0, At, B0); PG8_MMA(1, 1, At, B1); PG8_BAR; PG8_SCHED;
            } else {
            PG8_LDB(B0, 0, 0); PG8_SCHED; PG8_LDA(At, 0, 0); PG8_STAGE(PG8_SA(1, 1), a1 + hstepA, voffA);
            PG8_WAIT_L(8); PG8_BAR; PG8_WAIT_L(0); PG8_MMA(0, 0, At, B0); PG8_BAR; PG8_SCHED;
            PG8_LDB(B1, 0, 1); PG8_STAGE(PG8_SB(0, 0), b2, voffB);
            PG8_BAR; PG8_WAIT_L(0); PG8_MMA(0, 1, At, B1); PG8_BAR;
            PG8_LDA(At, 0, 1); PG8_STAGE(PG8_SA(0, 0), a2, voffA);
            PG8_BAR; PG8_WAIT_L(0); PG8_MMA(1, 0, At, B0); PG8_BAR; PG8_SCHED;
            PG8_STAGE(PG8_SB(0, 1), b2 + hstep, voffB);
            PG8_WAIT_V(6); PG8_BAR; PG8_MMA(1, 1, At, B1); PG8_BAR;
            PG8_LDB(B0, 1, 0); PG8_SCHED; PG8_LDA(At, 1, 0); PG8_STAGE(PG8_SA(0, 1), a2 + hstepA, voffA);
            PG8_WAIT_L(8); PG8_BAR; PG8_WAIT_L(0); PG8_MMA(0, 0, At, B0); PG8_BAR; PG8_SCHED;
            PG8_LDB(B1, 1, 1); PG8_STAGE(PG8_SB(1, 0), b3, voffB);
            PG8_BAR; PG8_WAIT_L(0); PG8_MMA(0, 1, At, B1); PG8_BAR;
            PG8_LDA(At, 1, 1); PG8_STAGE(PG8_SA(1, 0), a3, voffA);
            PG8_BAR; PG8_WAIT_L(0); PG8_MMA(1, 0, At, B0); PG8_BAR; PG8_SCHED;
            PG8_STAGE(PG8_SB(1, 1), b3 + hstep, voffB);
            PG8_WAIT_V(6); PG8_BAR; PG8_MMA(1, 1, At, B1); PG8_BAR;
            }
        }
        if constexpr (ALIGN_EPI) { if (wr == 0) PG8_BAR; }
        if constexpr (!Epi::AFTER_DRAIN) { E(acc, cur, wr, wc, fr, fq); S.done(cur); }
        if (!has_next) break;
#pragma unroll
        for (int a = 0; a < 2; ++a)
#pragma unroll
            for (int b = 0; b < 2; ++b)
#pragma unroll
                for (int m = 0; m < 4; ++m)
#pragma unroll
                    for (int n = 0; n < 2; ++n) acc[a][b][m][n] = (f32x4){0.f, 0.f, 0.f, 0.f};
        cur = nxt; cA = nA; cB = nB; ++ui;
        if constexpr (ALIGN_EPI) { if (wr == 1) PG8_BAR; }
    }
    PG8_WAIT_V(0);
    if constexpr (!ALIGN_EPI) { if (wr == 0) PG8_BAR; }
    PG8_BAR;
    if constexpr (Epi::AFTER_DRAIN) { E.fused(acc, cur, wr, wc, fr, fq, lds, wid, lane); S.done(cur); }
#undef PG8_SA
#undef PG8_SB
#undef PG8_STAGE
#undef PG8_LDA
#undef PG8_LDB
#undef PG8_MMA
#undef PG8_WAIT_V
#undef PG8_WAIT_L
#undef PG8_BAR
#undef PG8_SCHED
}
}
#define LAS __attribute__((address_space(3)))
#define XB_TMO      128
#define XB_XCNT(j)  (256  + 64 * (j))
#define XB_XSUB(j)  (1280 + 64 * (j))
#define XB_XGEN(j)  (2304 + 64 * (j))
#define XB_TOP      3328
#define XB_TOPGEN   3392
#define XCD_BAR_WORDS 3456
#define XB_SPIN_CAP (1u << 18)

__device__ __forceinline__ unsigned xb_ld(unsigned* p)              { return __hip_atomic_load(p, __ATOMIC_RELAXED, __HIP_MEMORY_SCOPE_AGENT); }
__device__ __forceinline__ unsigned xb_add(unsigned* p, unsigned v) { return __hip_atomic_fetch_add(p, v, __ATOMIC_RELAXED, __HIP_MEMORY_SCOPE_AGENT); }
__device__ __forceinline__ unsigned xb_xcc_id() { return (unsigned)__builtin_amdgcn_s_getreg((3 << 11) | 20) & 0xFu; }
#define XB_SPIN(cond, bar) do { unsigned _sp = 0; while (cond) { __builtin_amdgcn_s_sleep(1); \
    if ((++_sp & 255u) == 0u) { if (xb_ld(&(bar)[XB_TMO])) break; if (_sp > XB_SPIN_CAP) { atomicAdd(&(bar)[XB_TMO], 1u); break; } } } } while (0)

struct XcdBarrier {
    unsigned* bar; unsigned x;
    volatile LAS unsigned* st;
};

__device__ __forceinline__ XcdBarrier xcd_barrier_post(unsigned* bar, volatile LAS unsigned* st) {
    XcdBarrier b; b.bar = bar; b.x = xb_xcc_id(); b.st = st;
    if (threadIdx.x == 0) (void)xb_add(&bar[XB_XCNT(b.x)], 1u);
    return b;
}
__device__ __forceinline__ void xcd_barrier_complete(unsigned* bar, unsigned x, unsigned& nloc, unsigned& nx) {
    const unsigned G = gridDim.x * gridDim.y * gridDim.z;
    unsigned sum, cnt, mine, sp = 0u;
    for (;;) {
        sum = 0u; cnt = 0u; mine = 0u;
#pragma unroll
        for (unsigned j = 0; j < 16; ++j) { const unsigned c = xb_ld(&bar[XB_XCNT(j)]); sum += c; cnt += (c > 0u) ? 1u : 0u; mine = (j == x) ? c : mine; }
        if (sum == G) break;
        __builtin_amdgcn_s_sleep(1);
        if ((++sp & 255u) == 0u) { if (xb_ld(&bar[XB_TMO])) break; if (sp > XB_SPIN_CAP) { atomicAdd(&bar[XB_TMO], 1u); break; } }
    }
    nloc = mine > 0u ? mine : 1u; nx = cnt > 0u ? cnt : 1u;
}

__device__ __forceinline__ void xcd_barrier(const XcdBarrier& b) {
    asm volatile("s_waitcnt vmcnt(0)" ::: "memory");
    __syncthreads();
    if (threadIdx.x == 0) {
        unsigned* bar = b.bar;
        __builtin_amdgcn_s_waitcnt(0);
        unsigned nloc = b.st[0], nx = b.st[1];
        if (nloc == 0u) { xcd_barrier_complete(bar, b.x, nloc, nx); b.st[0] = nloc; b.st[1] = nx; }
        const unsigned old = xb_add(&bar[XB_XSUB(b.x)], 1u);
        const unsigned gen = old / nloc;
        if (old + 1u == (gen + 1u) * nloc) {
            __builtin_amdgcn_fence(__ATOMIC_RELEASE, "agent");
            asm volatile("s_waitcnt vmcnt(0)" ::: "memory");
            const unsigned og = xb_add(&bar[XB_TOP], 1u);
            const unsigned tg = og / nx;
            if (og + 1u == (tg + 1u) * nx) xb_add(&bar[XB_TOPGEN], 1u);
            else XB_SPIN(xb_ld(&bar[XB_TOPGEN]) == tg, bar);
            __builtin_amdgcn_fence(__ATOMIC_ACQUIRE, "agent");
            xb_add(&bar[XB_XGEN(b.x)], 1u);
            asm volatile("s_waitcnt vmcnt(0)" ::: "memory");
        } else {
            XB_SPIN(xb_ld(&bar[XB_XGEN(b.x)]) == gen, bar);
            __builtin_amdgcn_fence(__ATOMIC_ACQUIRE, "agent");
            asm volatile("s_waitcnt vmcnt(0)" ::: "memory");
        }
    }
    __syncthreads();
}
constexpr int NWAVES = 8;
constexpr int SEQ = 8192, BATCH = 2, M = BATCH * SEQ, DM = 4096, HD = 128, NH = 16, INW = 14336, NMEM = 256, CW = 512, DFF = 11008, DFF2 = 2 * DFF;
constexpr int C_RQ = 0, C_SQ = 2048, C_RK = 4096, C_RV = 6144, C_RG = 8192, C_SK = 10240, C_SV = 12288;
constexpr float SB_EXIT = 110.0f;
constexpr size_t MiB = 1u << 20;
constexpr size_t WS_CTL = 0, CTL_ZERO_BYTES = 1 * MiB;
constexpr size_t WS_COS = 1 * MiB, WS_SIN = 3 * MiB, WS_SSQ0 = 5 * MiB, WS_SSQM = 5 * MiB + 256 * 1024, WS_SSQ1 = 256 * 1024, WS_SSQ2 = 512 * 1024  , WS_SSQSB = 14 * MiB;
constexpr size_t WS_MB = 22 * MiB, WS_CQ = 26 * MiB, WS_CKV = 58 * MiB, WS_CO = 60 * MiB;
constexpr size_t WS_WQKV = 76 * MiB, WS_WO = 88 * MiB, WS_WUP = 92 * MiB, WS_WDOWN = 264 * MiB, WS_HB = 350 * MiB;
constexpr size_t WS_WIN = 478 * MiB, WS_WOUT = 590 * MiB, WS_PROJ = 622 * MiB, WS_KV = 1070 * MiB, WS_ST = 1198 * MiB, WS_END = 1262 * MiB;
constexpr size_t WS_MIX = WS_KV;
constexpr size_t WS_UB = 478 * MiB, WS_ACT = 822 * MiB;
static_assert(WS_UB + (size_t)(M / 64) * 4 * DFF2 * 2 <= WS_WOUT && WS_ACT + (size_t)M * DFF * 2 <= WS_END && WS_ACT >= WS_PROJ, "ffn overlays");
static_assert(WS_PROJ + (size_t)M * INW * 2 <= WS_KV && WS_KV + (size_t)2048 * 16384 * 4 <= WS_ST && WS_ST + (size_t)2048 * 16384 * 2 <= WS_END, "mixer map");
static_assert(WS_WIN + (size_t)INW * DM * 2 <= WS_WOUT && WS_WOUT + (size_t)DM * DM * 2 <= WS_PROJ && WS_WUP + (size_t)DFF2 * DM * 2 <= WS_WDOWN && WS_WDOWN + (size_t)DM * DFF * 2 <= WS_HB && WS_HB + (size_t)M * DM * 2 <= WS_WIN, "weights map");
constexpr int CW_BAR = 4096;
constexpr int RING_BYTES = 131072, LDSCTL_OFF = RING_BYTES, MISC_OFF = LDSCTL_OFF + 320, L_EPIW = RING_BYTES + 1024  , LDS_BYTES = 147456;
constexpr int L_KT = 0, L_VT = 40960, L_RK = 81920, L_FL = 82944, L_RED = 83200;
constexpr int KSTR = 272, VSTR = 320;

#define GAS __attribute__((address_space(1)))
#define LAS __attribute__((address_space(3)))
#define DI __device__ __forceinline__
typedef unsigned short bf16;
typedef unsigned v4u __attribute__((ext_vector_type(4)));
typedef unsigned v2u __attribute__((ext_vector_type(2)));
typedef float f32x4 __attribute__((ext_vector_type(4)));
typedef float f32x16 __attribute__((ext_vector_type(16)));
typedef short bf16x8 __attribute__((ext_vector_type(8)));
typedef short s16x4 __attribute__((ext_vector_type(4)));
typedef GAS unsigned gu32;
#define RLX_AGENT __ATOMIC_RELAXED, __HIP_MEMORY_SCOPE_AGENT
#define LDS_WAIT() asm volatile("s_waitcnt lgkmcnt(0)" ::: "memory")
using pg8::pk_bf16; using pg8::EPSN; using pg8::LOGG; using pg8::hsum4;
#define MFMA32(a, b, c) __builtin_amdgcn_mfma_f32_32x32x16_bf16((a), (b), (c), 0, 0, 0)
DI int crow(int i, int h) { return (i & 3) + 8 * (i >> 2) + 4 * h; }
DI bf16x8 pack8(float a0, float a1, float a2, float a3, float a4, float a5, float a6, float a7) { v4u p; p.x = pk_bf16(a0, a1); p.y = pk_bf16(a2, a3); p.z = pk_bf16(a4, a5); p.w = pk_bf16(a6, a7); return __builtin_bit_cast(bf16x8, p); }
DI float bf2f(unsigned short b) { return __builtin_bit_cast(float, (unsigned)b << 16); }
DI float wave_sum(float v) {
#pragma unroll
    for (int o = 1; o < 64; o <<= 1) v += __shfl_xor(v, o);
    return v;
}
__constant__ float INVF[64] = { 1.000000000e+00f, 8.639884591e-01f, 7.464760542e-01f, 6.449466348e-01f, 5.572264791e-01f, 4.814372361e-01f, 4.159561992e-01f, 3.593813479e-01f, 3.105013072e-01f, 2.682695389e-01f, 2.317818105e-01f, 2.002568096e-01f, 1.730195731e-01f, 1.494868994e-01f, 1.291549653e-01f, 1.115883961e-01f,
    9.641107172e-02f, 8.329805732e-02f, 7.196855545e-02f, 6.218000501e-02f, 5.372280627e-02f, 4.641588405e-02f, 4.010278732e-02f, 3.464834765e-02f, 2.993577160e-02f, 2.586415969e-02f, 2.234633639e-02f, 1.930697635e-02f, 1.668100432e-02f, 1.441219542e-02f, 1.245197095e-02f, 1.075835899e-02f,
    9.295094758e-03f, 8.030855097e-03f, 6.938565988e-03f, 5.994841456e-03f, 5.179473665e-03f, 4.475004971e-03f, 3.866352839e-03f, 3.340484342e-03f, 2.886140021e-03f, 2.493591513e-03f, 2.154434333e-03f, 1.861406374e-03f, 1.608233550e-03f, 1.389495214e-03f, 1.200507861e-03f, 1.037224894e-03f,
    8.961503627e-04f, 7.742635789e-04f, 6.689548027e-04f, 5.779691855e-04f, 4.993587499e-04f, 4.314401885e-04f, 3.727593576e-04f, 3.220597864e-04f, 2.782559022e-04f, 2.404099068e-04f, 2.077113895e-04f, 1.794602285e-04f, 1.550515735e-04f, 1.339627779e-04f, 1.157422885e-04f, 9.999999747e-05f };
typedef float f32x2g __attribute__((ext_vector_type(2)));
template <bool HASG, int PERM> DI void transpose_tile64(const float* __restrict__ W, int N, const float* __restrict__ gain, bf16* __restrict__ WT, int Kd, int dst_row0, int src_col0, int k0, LAS unsigned* scr, int lane) {
    const int n4 = lane & 15, kk = lane >> 4;
    f32x4 a[8], b[8]; f32x2g gg[8];
    const float* src = W + (size_t)(k0 + 2 * kk) * N + src_col0 + 4 * n4;
#pragma unroll
    for (int i = 0; i < 8; ++i) { a[i] = *(const GAS f32x4*)(src + (size_t)(8 * i) * N); b[i] = *(const GAS f32x4*)(src + (size_t)(8 * i + 1) * N); }
#pragma unroll
    for (int i = 0; i < 8; ++i) { if (HASG) gg[i] = *(const GAS f32x2g*)(gain + k0 + 8 * i + 2 * kk); else gg[i] = (f32x2g){1.f, 1.f}; }
    asm volatile("" ::: "memory");
#pragma unroll
    for (int i = 0; i < 8; ++i)
#pragma unroll
        for (int j = 0; j < 4; ++j) scr[(4 * n4 + j) * 33 + 4 * i + kk] = pk_bf16(a[i][j] * gg[i].x, b[i][j] * gg[i].y);
    LDS_WAIT(); asm volatile("" ::: "memory");
    const int c = lane & 7, nr = lane >> 3;
#pragma unroll
    for (int it = 0; it < 8; ++it) { const int n = 8 * it + nr; const LAS unsigned* sp = scr + n * 33 + 4 * c;
        v4u o; o.x = sp[0]; o.y = sp[1]; o.z = sp[2]; o.w = sp[3];
        const int drow = dst_row0 + n, srow = (drow & ~127) + pg8::invpermrow<PERM>(drow & 127);
        *(GAS v4u*)(WT + pg8::blk_elem(srow, k0 + 8 * c, Kd)) = o; }
    LDS_WAIT(); asm volatile("" ::: "memory");
}
DI void row_to_bf16(const float* __restrict__ xrow, bf16* __restrict__ obase, int m, float* __restrict__ ssq, int lane) {
    const GAS f32x4* xr = (const GAS f32x4*)xrow + lane; float s = 0.f; f32x4 v[16];
#pragma unroll
    for (int j = 0; j < 16; ++j) v[j] = xr[64 * j];
    asm volatile("" ::: "memory");
#pragma unroll
    for (int j = 0; j < 16; ++j) { s += (v[j].x * v[j].x + v[j].y * v[j].y) + (v[j].z * v[j].z + v[j].w * v[j].w); v2u w; w.x = pk_bf16(v[j].x, v[j].y); w.y = pk_bf16(v[j].z, v[j].w);
        *(GAS v2u*)(obase + pg8::blk_elem(m, 4 * lane + 256 * j, DM)) = w; }
    s = wave_sum(s); if (lane == 0) *ssq = s;
}
struct Ptrs {
    const float *x, *mem, *attn_norm, *w_in, *ret_norm, *sbq_norm, *sbk_norm, *sbo_norm, *w_out, *cross_norm, *mem_norm, *wq, *wkv, *cq_norm, *ck_norm, *wo, *ffn_norm, *w_up, *conv_w, *conv_b, *w_down;
    float* out; unsigned char* ws;
};
DI void p0_prologue(const Ptrs& P, LAS unsigned char* lds, int gw, int NGW, int wave, int lane) {
    unsigned char* ws = P.ws;
    LAS unsigned* scr = (LAS unsigned*)(lds + wave * 16384);
    constexpr int KB = DM / 64;
    constexpr int I_IN = KB * (INW / 64), I_OUT = KB * (DM / 64), I_Q = KB * (CW / 64), I_KV = KB * (2 * CW / 64), I_O = (CW / 64) * (DM / 64), I_UP = KB * (DFF2 / 64), I_DN = (DFF / 64) * (DM / 64);
    constexpr int NITEMS = I_IN + I_OUT + I_Q + I_KV + I_O + I_UP + I_DN;
    for (int it = gw; it < NITEMS; it += NGW) {
        int r = it;
        if (r < I_IN) { const int nb = r % (INW / 64), kb = r / (INW / 64), n0 = 64 * nb, reg = n0 >> 11;
            const int src = (reg == 0 ? 0 : reg == 1 ? 8192 : reg == 2 ? 2048 : reg == 3 ? 4096 : reg == 4 ? 6144 : reg == 5 ? 10240 : 12288) + (n0 & 2047);
            transpose_tile64<true, 2>(P.w_in, INW, P.attn_norm, (bf16*)(ws + WS_WIN), DM, n0, src, 64 * kb, scr, lane); continue; } r -= I_IN;
        if (r < I_OUT) { const int nb = r % (DM / 64), kb = r / (DM / 64); transpose_tile64<false, 1>(P.w_out, DM, nullptr, (bf16*)(ws + WS_WOUT), DM, 64 * nb, 64 * nb, 64 * kb, scr, lane); continue; } r -= I_OUT;
        if (r < I_Q) { const int nb = r % (CW / 64), kb = r / (CW / 64); transpose_tile64<true, 1>(P.wq, CW, P.cross_norm, (bf16*)(ws + WS_WQKV), DM, 64 * nb, 64 * nb, 64 * kb, scr, lane); continue; } r -= I_Q;
        if (r < I_KV) { const int nb = r % (2 * CW / 64), kb = r / (2 * CW / 64); transpose_tile64<true, 1>(P.wkv, 2 * CW, P.mem_norm, (bf16*)(ws + WS_WQKV), DM, CW + 64 * nb, 64 * nb, 64 * kb, scr, lane); continue; } r -= I_KV;
        if (r < I_O) { const int nb = r % (DM / 64), kb = r / (DM / 64); transpose_tile64<false, 1>(P.wo, DM, nullptr, (bf16*)(ws + WS_WO), CW, 64 * nb, 64 * nb, 64 * kb, scr, lane); continue; } r -= I_O;
        if (r < I_UP) { const int nb = r % (DFF2 / 64), kb = r / (DFF2 / 64), n0 = 64 * nb, src = ((n0 >> 7) & 1) * DFF + 128 * (n0 >> 8) + (n0 & 127);
            transpose_tile64<true, 1>(P.w_up, DFF2, P.ffn_norm, (bf16*)(ws + WS_WUP), DM, n0, src, 64 * kb, scr, lane); continue; } r -= I_UP;
        { const int nb = r % (DM / 64), kb = r / (DM / 64); transpose_tile64<false, 1>(P.w_down, DM, nullptr, (bf16*)(ws + WS_WDOWN), DFF, 64 * nb, 64 * nb, 64 * kb, scr, lane); }
    }
    for (int m = gw; m < M; m += NGW) row_to_bf16(P.x + (size_t)m * DM, (bf16*)(ws + WS_HB), m, (float*)(ws + WS_SSQ0) + m, lane);
    for (int m = gw; m < BATCH * NMEM; m += NGW) row_to_bf16(P.mem + (size_t)m * DM, (bf16*)(ws + WS_MB), m, (float*)(ws + WS_SSQM) + m, lane);
    for (int idx = gw * 64 + lane; idx < SEQ * 64; idx += NGW * 64) {
        const int t = idx >> 6, i = idx & 63; const float angf = (float)t * INVF[i]; const double ang = (double)angf;
        const double kq = __builtin_rint(ang * 0.15915494309189535); const double rr = __builtin_fma(-kq, 6.283185307179586, ang) - kq * 2.4492935982947064e-16;
        const double r2 = rr * rr; double sn = 0.0, cs = 0.0;
#pragma unroll
        for (int k = 13; k >= 0; --k) { cs = cs * (-r2 / (double)((2 * k + 1) * (2 * k + 2))) + 1.0; sn = sn * (-r2 / (double)((2 * k + 2) * (2 * k + 3))) + 1.0; }
        ((float*)(ws + WS_COS))[idx] = (float)cs; ((float*)(ws + WS_SIN))[idx] = (float)(sn * rr);
    }
}
DI void stage_tile(LAS unsigned char* dst, int stride, const bf16* src, size_t ld, int rows, int tid) {
    for (int ch = tid; ch < rows * 16; ch += NWAVES * 64) { const int r = ch >> 4, c = ch & 15; const v4u v = *(const GAS v4u*)(src + (size_t)r * ld + c * 8); *(LAS v4u*)(dst + r * stride + c * 16) = v; }
}
DI bf16x8 tr_frag(LAS unsigned char* tile, int stride, int row0, int col0, int lane) {
    const int g = lane >> 4, i16 = lane & 15, q = i16 >> 2, p = i16 & 3, h = lane >> 5;
    LAS unsigned char* a = tile + (row0 + 4 * h + q) * stride + (col0 + 16 * (g & 1) + 4 * p) * 2;
    const s16x4 lo = __builtin_amdgcn_ds_read_tr16_b64_v4i16((LAS s16x4*)a);
    const s16x4 hi = __builtin_amdgcn_ds_read_tr16_b64_v4i16((LAS s16x4*)(a + 8 * stride));
    return __builtin_shufflevector(lo, hi, 0, 1, 2, 3, 4, 5, 6, 7);
}
DI f32x16 st_tile(LAS unsigned char* KT, int krow0, const bf16x8 (&qf)[8], int r, int h) {
    f32x16 acc;
#pragma unroll
    for (int i = 0; i < 16; ++i) acc[i] = 0.f;
#pragma unroll
    for (int ks = 0; ks < 8; ++ks) { const bf16x8 a = *(const LAS bf16x8*)(KT + (krow0 + r) * KSTR + (16 * ks + 8 * h) * 2); acc = MFMA32(a, qf[ks], acc); }
    return acc;
}
DI void load_qf(bf16x8 (&qf)[8], const bf16* qrowp, int h) {
#pragma unroll
    for (int ks = 0; ks < 8; ++ks) qf[ks] = *(const GAS bf16x8*)(qrowp + 16 * ks + 8 * h);
}

DI void ret_kv_unit(LAS unsigned char* lds, const bf16* PROJ, float* KVB, int unit, int tid) {
    const int lane = tid & 63, w = __builtin_amdgcn_readfirstlane(tid >> 6), r = lane & 31, h = lane >> 5;
    const int n = unit & 63, hd = (unit >> 6) & 15, b = unit >> 10;
    LAS unsigned char* KT = lds + L_KT; LAS unsigned char* VT = lds + L_VT;
    const size_t m0 = (size_t)b * SEQ + 128 * n;
    __syncthreads();
    stage_tile(KT, VSTR, PROJ + m0 * INW + C_RK + 128 * hd, INW, 128, tid);
    stage_tile(VT, VSTR, PROJ + m0 * INW + C_RV + 128 * hd, INW, 128, tid);
    __syncthreads();
    const int te = w >> 1, td0 = 2 * (w & 1);
    f32x16 acc[2];
#pragma unroll
    for (int t = 0; t < 2; ++t)
#pragma unroll
        for (int i = 0; i < 16; ++i) acc[t][i] = 0.f;
#pragma unroll
    for (int ks = 0; ks < 8; ++ks) {
        const bf16x8 a = tr_frag(VT, VSTR, 16 * ks, 32 * te, lane);
#pragma unroll
        for (int t = 0; t < 2; ++t) { const bf16x8 bb = tr_frag(KT, VSTR, 16 * ks, 32 * (td0 + t), lane); acc[t] = MFMA32(a, bb, acc[t]); }
    }
    const float sc = __expf(127.0f * LOGG[hd]);
    float* o = KVB + (size_t)unit * 16384;
#pragma unroll
    for (int t = 0; t < 2; ++t)
#pragma unroll
        for (int i = 0; i < 16; ++i) o[(32 * te + crow(i, h)) * 128 + 32 * (td0 + t) + r] = acc[t][i] * sc;
}
DI void ret_scan(const float* KVB, bf16* ST, int gt, int NT) {
    for (int idx = gt; idx < 32 * 4096; idx += NT) {
        const int bh = idx >> 12, e4 = idx & 4095; const float dec = __expf(128.0f * LOGG[bh & 15]);
        f32x4 S = {0.f, 0.f, 0.f, 0.f};
        for (int n = 0; n < 64; ++n) {
            const size_t off = ((size_t)(bh * 64 + n) * 4096 + e4) * 4;
            v2u w; w.x = pk_bf16(S[0], S[1]); w.y = pk_bf16(S[2], S[3]); *(GAS v2u*)(ST + off) = w;
            const f32x4 kv = *(const GAS f32x4*)(KVB + off); S = S * dec + kv;
        }
    }
}
DI float xor32(float x, int h) { const auto r = __builtin_amdgcn_permlane32_swap(__builtin_bit_cast(unsigned, x), __builtin_bit_cast(unsigned, x), false, false); return __builtin_bit_cast(float, h ? r[0] : r[1]); }
DI void tile_ld(v4u (&t)[4], const bf16* src, size_t ld, int tid) {
#pragma unroll
    for (int i = 0; i < 4; ++i) { const int ch = tid + i * (NWAVES * 64); t[i] = *(const GAS v4u*)(src + (size_t)(ch >> 4) * ld + (ch & 15) * 8); }
}
DI void tile_st(LAS unsigned char* dst, int stride, const v4u (&t)[4], int tid) {
#pragma unroll
    for (int i = 0; i < 4; ++i) { const int ch = tid + i * (NWAVES * 64); *(LAS v4u*)(dst + (ch >> 4) * stride + (ch & 15) * 16) = t[i]; }
}
DI void ret_out_phase(LAS unsigned char* lds, const bf16* PROJ, bf16* MIX, const bf16* ST, const float* gret, int bx, int G, int tid) {
    const int lane = tid & 63, w = __builtin_amdgcn_readfirstlane(tid >> 6), r = lane & 31, h = lane >> 5, qg = w & 3, eh = w >> 2;
    LAS unsigned char* KT = lds + L_KT; LAS unsigned char* VT = lds + L_VT; LAS float* RED = (LAS float*)(lds + L_RED);
    v4u kreg[4], vreg[4];
    if (bx < 2048) { const int n = bx & 63, hd = (bx >> 6) & 15, b = bx >> 10; const size_t m0 = (size_t)b * SEQ + 128 * n;
        tile_ld(kreg, PROJ + m0 * INW + C_RK + 128 * hd, INW, tid); tile_ld(vreg, PROJ + m0 * INW + C_RV + 128 * hd, INW, tid); }
    for (int unit = bx; unit < 2048; unit += G) {
        const int n = unit & 63, hd = (unit >> 6) & 15, b = unit >> 10;
        const size_t m0 = (size_t)b * SEQ + 128 * n, qrow = m0 + 32 * qg + r;
        __syncthreads();
        tile_st(KT, KSTR, kreg, tid); tile_st(VT, VSTR, vreg, tid);
        bf16x8 qf[8]; load_qf(qf, PROJ + qrow * INW + C_RQ + 128 * hd, h);
        const bf16* st = ST + (size_t)unit * 16384;
        f32x16 O[2];
#pragma unroll
        for (int et = 0; et < 2; ++et) {
            bf16x8 sa[8];
#pragma unroll
            for (int ks = 0; ks < 8; ++ks) sa[ks] = *(const GAS bf16x8*)(st + (32 * (2 * eh + et) + r) * 128 + 16 * ks + 8 * h);
#pragma unroll
            for (int i = 0; i < 16; ++i) O[et][i] = 0.f;
#pragma unroll
            for (int ks = 0; ks < 8; ++ks) O[et] = MFMA32(sa[ks], qf[ks], O[et]);
        }
        const float g1 = __builtin_amdgcn_exp2f(1.4426950408889634f * LOGG[hd]);
#pragma unroll
        for (int et = 0; et < 2; ++et) O[et] = O[et] * g1;
        const bf16* grow = PROJ + qrow * INW + C_RG + 128 * hd;
        v2u gt[2][4]; f32x4 gg[2][4];
#pragma unroll
        for (int et = 0; et < 2; ++et)
#pragma unroll
            for (int Gq = 0; Gq < 4; ++Gq) { const int e = 32 * (2 * eh + et) + 8 * Gq + 4 * h; gt[et][Gq] = *(const GAS v2u*)(grow + e); gg[et][Gq] = *(const f32x4*)(gret + e); }
        __syncthreads();
        if (unit + G < 2048) { const int u2 = unit + G, n2 = u2 & 63, hd2 = (u2 >> 6) & 15, b2 = u2 >> 10; const size_t m2 = (size_t)b2 * SEQ + 128 * n2;
            tile_ld(kreg, PROJ + m2 * INW + C_RK + 128 * hd2, INW, tid); tile_ld(vreg, PROJ + m2 * INW + C_RV + 128 * hd2, INW, tid); }
        for (int kt = 0; kt <= qg; ++kt) {
            f32x16 s = st_tile(KT, 32 * kt, qf, r, h);
            if (kt == qg) {
#pragma unroll
                for (int i = 0; i < 16; ++i) s[i] = (crow(i, h) <= r) ? s[i] : 0.f;
            }
            bf16x8 pb[2];
#pragma unroll
            for (int s2 = 0; s2 < 2; ++s2) pb[s2] = pack8(s[8 * s2], s[8 * s2 + 1], s[8 * s2 + 2], s[8 * s2 + 3], s[8 * s2 + 4], s[8 * s2 + 5], s[8 * s2 + 6], s[8 * s2 + 7]);
#pragma unroll
            for (int et = 0; et < 2; ++et)
#pragma unroll
                for (int s2 = 0; s2 < 2; ++s2) O[et] = MFMA32(tr_frag(VT, VSTR, 32 * kt + 16 * s2, 32 * (2 * eh + et), lane), pb[s2], O[et]);
        }
        float ss = 0.f;
#pragma unroll
        for (int et = 0; et < 2; ++et)
#pragma unroll
            for (int i = 0; i < 16; ++i) ss += O[et][i] * O[et][i];
        ss += xor32(ss, h);
        if (h == 0) RED[w * 32 + r] = ss;
        __syncthreads();
        const float rstd = rsqrtf((RED[w * 32 + r] + RED[(w ^ 4) * 32 + r]) * (1.0f / 128.0f) + EPSN);
#pragma unroll
        for (int et = 0; et < 2; ++et)
#pragma unroll
            for (int Gq = 0; Gq < 4; ++Gq) {
                const int e = 32 * (2 * eh + et) + 8 * Gq + 4 * h; const f32x4 g = gg[et][Gq]; const v2u gv = gt[et][Gq];
                const float o0 = O[et][4 * Gq + 0] * rstd * g[0] * bf2f((unsigned short)(gv.x & 0xffff)), o1 = O[et][4 * Gq + 1] * rstd * g[1] * bf2f((unsigned short)(gv.x >> 16));
                const float o2 = O[et][4 * Gq + 2] * rstd * g[2] * bf2f((unsigned short)(gv.y & 0xffff)), o3 = O[et][4 * Gq + 3] * rstd * g[3] * bf2f((unsigned short)(gv.y >> 16));
                v2u wv; wv.x = pk_bf16(o0, o1); wv.y = pk_bf16(o2, o3); *(GAS v2u*)(MIX + pg8::blk_elem((int)qrow, 128 * hd + e, DM)) = wv;
            }
    }
}
constexpr float SB_EXIT2 = SB_EXIT * 1.4426950408889634f;
template <bool MASK> DI void sb_subtile(const f32x16& s, const LAS float* RKp, float qscale, int kpos0, int tq, int h, float& R, bf16x8 (&pb)[2]) {
    float a[16], T[4], l[4][4], z[4][4]; bool ok[4][4];
#pragma unroll
    for (int Gq = 0; Gq < 4; ++Gq) {
        const f32x4 rk = *(const LAS f32x4*)(RKp + 8 * Gq + 4 * h);
#pragma unroll
        for (int j = 0; j < 4; ++j) {
            z[Gq][j] = s[4 * Gq + j] * qscale * rk[j];
            const float spv = fmaxf(z[Gq][j], 0.f) + __builtin_amdgcn_logf(1.0f + __builtin_amdgcn_exp2f(-fabsf(z[Gq][j])));
            if (MASK) { ok[Gq][j] = (kpos0 + 8 * Gq + 4 * h + j < tq); l[Gq][j] = ok[Gq][j] ? spv : 0.f; } else { ok[Gq][j] = true; l[Gq][j] = spv; }
        }
        l[Gq][2] += l[Gq][3]; l[Gq][1] += l[Gq][2]; l[Gq][0] += l[Gq][1];
        T[Gq] = l[Gq][0];
    }
    float To[4];
#pragma unroll
    for (int Gq = 0; Gq < 4; ++Gq) To[Gq] = xor32(T[Gq], h);
#pragma unroll
    for (int Gq = 3; Gq >= 0; --Gq) {
        const float off = h ? R : R + To[Gq];
#pragma unroll
        for (int j = 0; j < 4; ++j) { const float e = __builtin_amdgcn_exp2f(z[Gq][j] - (off + l[Gq][j])); a[4 * Gq + j] = (!MASK || ok[Gq][j]) ? e : 0.f; }
        R = R + (T[Gq] + To[Gq]);
    }
#pragma unroll
    for (int s2 = 0; s2 < 2; ++s2) pb[s2] = pack8(a[8 * s2], a[8 * s2 + 1], a[8 * s2 + 2], a[8 * s2 + 3], a[8 * s2 + 4], a[8 * s2 + 5], a[8 * s2 + 6], a[8 * s2 + 7]);
}
DI void sb_phase(LAS unsigned char* lds, const bf16* PROJ, bf16* MIX, const float* ssqsb, const float* gout, int bx, int G, int tid) {
    const int lane = tid & 63, w = __builtin_amdgcn_readfirstlane(tid >> 6), r = lane & 31, h = lane >> 5;
    LAS unsigned char* KT = lds + L_KT; LAS unsigned char* VT = lds + L_VT; LAS float* RK = (LAS float*)(lds + L_RK); LAS unsigned* FL = (LAS unsigned*)(lds + L_FL);
    for (int unit = bx; unit < 1024; unit += G) {
        const int qb = unit & 31, hd = (unit >> 5) & 15, b = unit >> 9;
        const size_t m0 = (size_t)b * SEQ + 256 * qb, qrow = m0 + 32 * w + r;
        const int qlo = 256 * qb + 32 * w, qhi = qlo + 31, tq = qlo + r;
        v4u kreg[4], vreg[4]; f32x4 rkreg = {0.f, 0.f, 0.f, 0.f};
        { const size_t k0row = (size_t)b * SEQ + 128 * (2 * qb + 1);
          tile_ld(kreg, PROJ + k0row * INW + C_SK + 128 * hd, INW, tid); tile_ld(vreg, PROJ + k0row * INW + C_SV + 128 * hd, INW, tid);
          if (tid < 128) rkreg = *(const GAS f32x4*)(ssqsb + ((k0row + tid) * 32 + 16 + hd) * 4); }
        bf16x8 qf[8]; load_qf(qf, PROJ + qrow * INW + C_SQ + 128 * hd, h);
        const f32x4 pq = *(const GAS f32x4*)(ssqsb + (qrow * 32 + hd) * 4);
        const float qscale = rsqrtf(hsum4(pq) * (1.0f / 128.0f) + EPSN) * (0.08838834764831845f * 1.4426950408889634f);
        f32x16 O[4];
#pragma unroll
        for (int dt = 0; dt < 4; ++dt)
#pragma unroll
            for (int i = 0; i < 16; ++i) O[dt][i] = 0.f;
        float R = 0.f; bool wdone = false;
        for (int kb = 2 * qb + 1; kb >= 0; --kb) {
            __syncthreads();
            if (kb != 2 * qb + 1) { const unsigned all = FL[0] & FL[1] & FL[2] & FL[3] & FL[4] & FL[5] & FL[6] & FL[7]; if (all) break; }
            tile_st(KT, KSTR, kreg, tid); tile_st(VT, VSTR, vreg, tid);
            if (tid < 128) RK[tid] = rsqrtf(hsum4(rkreg) * (1.0f / 128.0f) + EPSN);
            __syncthreads();
            if (kb > 0) { const size_t k0row = (size_t)b * SEQ + 128 * (kb - 1);
                tile_ld(kreg, PROJ + k0row * INW + C_SK + 128 * hd, INW, tid); tile_ld(vreg, PROJ + k0row * INW + C_SV + 128 * hd, INW, tid);
                if (tid < 128) rkreg = *(const GAS f32x4*)(ssqsb + ((k0row + tid) * 32 + 16 + hd) * 4); }
            const int k0b = 128 * kb;
            if (k0b < qhi && !wdone) {
                for (int st = 3; st >= 0; --st) {
                    const int k0 = k0b + 32 * st;
                    if (k0 >= qhi) continue;
                    const f32x16 s = st_tile(KT, 32 * st, qf, r, h);
                    bf16x8 pb[2];
                    if (k0 + 31 >= qlo) sb_subtile<true>(s, RK + 32 * st, qscale, k0, tq, h, R, pb); else sb_subtile<false>(s, RK + 32 * st, qscale, k0, tq, h, R, pb);
#pragma unroll
                    for (int dt = 0; dt < 4; ++dt)
#pragma unroll
                        for (int s2 = 0; s2 < 2; ++s2) O[dt] = MFMA32(tr_frag(VT, VSTR, 32 * st + 16 * s2, 32 * dt, lane), pb[s2], O[dt]);
                }
                wdone = __all(R > SB_EXIT2);
            }
            if (lane == 0) FL[w] = wdone ? 1u : 0u;
        }
        float ss = 0.f;
#pragma unroll
        for (int dt = 0; dt < 4; ++dt)
#pragma unroll
            for (int i = 0; i < 16; ++i) ss += O[dt][i] * O[dt][i];
        ss += xor32(ss, h);
        const float rstd = rsqrtf(ss * (1.0f / 128.0f) + EPSN);
#pragma unroll
        for (int dt = 0; dt < 4; ++dt)
#pragma unroll
            for (int Gq = 0; Gq < 4; ++Gq) {
                const int d = 32 * dt + 8 * Gq + 4 * h; const f32x4 g = *(const f32x4*)(gout + d);
                v2u wv; wv.x = pk_bf16(O[dt][4 * Gq] * rstd * g[0], O[dt][4 * Gq + 1] * rstd * g[1]); wv.y = pk_bf16(O[dt][4 * Gq + 2] * rstd * g[2], O[dt][4 * Gq + 3] * rstd * g[3]);
                *(GAS v2u*)(MIX + pg8::blk_elem((int)qrow, 2048 + 128 * hd + d, DM)) = wv;
            }
    }
}
DI void cross_stage(LAS unsigned char* lds, const float* CKV, const float* gk, LAS float* RKc, int b, int ch, int kh, bool withV, int tid) {
    for (int chn = tid; chn < 128 * 16; chn += NWAVES * 64) {
        const int rr = chn >> 4, c = chn & 15; const float* src = CKV + (size_t)(b * NMEM + 128 * kh + rr) * (2 * CW) + 128 * ch + 8 * c;
        const f32x4 a0 = *(const GAS f32x4*)src, a1 = *(const GAS f32x4*)(src + 4); const f32x4 g0 = *(const f32x4*)(gk + 8 * c), g1 = *(const f32x4*)(gk + 8 * c + 4); const float rs = RKc[128 * kh + rr];
        v4u o; o.x = pk_bf16(a0[0] * rs * g0[0], a0[1] * rs * g0[1]); o.y = pk_bf16(a0[2] * rs * g0[2], a0[3] * rs * g0[3]); o.z = pk_bf16(a1[0] * rs * g1[0], a1[1] * rs * g1[1]); o.w = pk_bf16(a1[2] * rs * g1[2], a1[3] * rs * g1[3]);
        *(LAS v4u*)(lds + L_KT + rr * KSTR + c * 16) = o;
        if (withV) { const f32x4 v0 = *(const GAS f32x4*)(src + CW), v1 = *(const GAS f32x4*)(src + CW + 4);
            v4u ov; ov.x = pk_bf16(v0[0], v0[1]); ov.y = pk_bf16(v0[2], v0[3]); ov.z = pk_bf16(v1[0], v1[1]); ov.w = pk_bf16(v1[2], v1[3]);
            *(LAS v4u*)(lds + L_VT + rr * VSTR + c * 16) = ov; }
    }
}
DI void cross_unit(LAS unsigned char* lds, const float* CQ, const float* CKV, const float* gq, const float* gk, bf16* CO, int unit, int tid) {
    const int lane = tid & 63, w = __builtin_amdgcn_readfirstlane(tid >> 6), r = lane & 31, h = lane >> 5;
    const int qb = unit & 31, ch = (unit >> 5) & 3, b = unit >> 7;
    LAS unsigned char* KT = lds + L_KT; LAS unsigned char* VT = lds + L_VT; LAS float* RKc = (LAS float*)(lds + L_RK);
    const size_t qrow = (size_t)b * SEQ + 256 * qb + 32 * w + r;
    __syncthreads();
    {
        const int key = tid >> 1, half = tid & 1; const float* src = CKV + (size_t)(b * NMEM + key) * (2 * CW) + 128 * ch + 64 * half; float s = 0.f;
#pragma unroll
        for (int j = 0; j < 16; ++j) { const f32x4 v = *(const GAS f32x4*)(src + 4 * j); s += (v.x * v.x + v.y * v.y) + (v.z * v.z + v.w * v.w); }
        s += __shfl_xor(s, 1);
        if (half == 0) RKc[key] = rsqrtf(s * (1.0f / 128.0f) + EPSN);
    }
    bf16x8 qf[8];
    {
        const float* qp = CQ + qrow * CW + 128 * ch; f32x4 qv[8][2]; float s = 0.f;
#pragma unroll
        for (int ks = 0; ks < 8; ++ks) { qv[ks][0] = *(const GAS f32x4*)(qp + 16 * ks + 8 * h); qv[ks][1] = *(const GAS f32x4*)(qp + 16 * ks + 8 * h + 4);
            s += (qv[ks][0].x * qv[ks][0].x + qv[ks][0].y * qv[ks][0].y) + (qv[ks][0].z * qv[ks][0].z + qv[ks][0].w * qv[ks][0].w) + (qv[ks][1].x * qv[ks][1].x + qv[ks][1].y * qv[ks][1].y) + (qv[ks][1].z * qv[ks][1].z + qv[ks][1].w * qv[ks][1].w); }
        s += __shfl_xor(s, 32);
        const float rs = rsqrtf(s * (1.0f / 128.0f) + EPSN) * 0.08838834764831845f;
#pragma unroll
        for (int ks = 0; ks < 8; ++ks) { const f32x4 g0 = *(const f32x4*)(gq + 16 * ks + 8 * h), g1 = *(const f32x4*)(gq + 16 * ks + 8 * h + 4); const f32x4 a0 = qv[ks][0] * g0 * rs, a1 = qv[ks][1] * g1 * rs;
            qf[ks] = pack8(a0[0], a0[1], a0[2], a0[3], a1[0], a1[1], a1[2], a1[3]); }
    }
    __syncthreads();
    float mx = -3.0e38f;
    for (int kh = 0; kh < 2; ++kh) {
        if (kh) __syncthreads();
        cross_stage(lds, CKV, gk, RKc, b, ch, kh, false, tid);
        __syncthreads();
#pragma unroll 1
        for (int st = 0; st < 4; ++st) { const f32x16 s = st_tile(KT, 32 * st, qf, r, h);
#pragma unroll
            for (int i = 0; i < 16; ++i) mx = fmaxf(mx, s[i]); }
    }
    mx = fmaxf(mx, __shfl_xor(mx, 32));
    f32x16 O[4]; float lsum = 0.f;
#pragma unroll
    for (int dt = 0; dt < 4; ++dt)
#pragma unroll
        for (int i = 0; i < 16; ++i) O[dt][i] = 0.f;
    for (int kh = 0; kh < 2; ++kh) {
        __syncthreads();
        cross_stage(lds, CKV, gk, RKc, b, ch, kh, true, tid);
        __syncthreads();
#pragma unroll 1
        for (int st = 0; st < 4; ++st) {
            const f32x16 s = st_tile(KT, 32 * st, qf, r, h); float p[16];
#pragma unroll
            for (int i = 0; i < 16; ++i) { p[i] = __expf(s[i] - mx); lsum += p[i]; }
            bf16x8 pb[2];
#pragma unroll
            for (int s2 = 0; s2 < 2; ++s2) pb[s2] = pack8(p[8 * s2], p[8 * s2 + 1], p[8 * s2 + 2], p[8 * s2 + 3], p[8 * s2 + 4], p[8 * s2 + 5], p[8 * s2 + 6], p[8 * s2 + 7]);
#pragma unroll
            for (int dt = 0; dt < 4; ++dt)
#pragma unroll
                for (int s2 = 0; s2 < 2; ++s2) O[dt] = MFMA32(tr_frag(VT, VSTR, 32 * st + 16 * s2, 32 * dt, lane), pb[s2], O[dt]);
        }
    }
    lsum += __shfl_xor(lsum, 32);
    const float inv = 1.0f / lsum;
#pragma unroll
    for (int dt = 0; dt < 4; ++dt)
#pragma unroll
        for (int G = 0; G < 4; ++G) { const int d = 32 * dt + 8 * G + 4 * h;
            v2u wv; wv.x = pk_bf16(O[dt][4 * G] * inv, O[dt][4 * G + 1] * inv); wv.y = pk_bf16(O[dt][4 * G + 2] * inv, O[dt][4 * G + 3] * inv); *(GAS v2u*)(CO + pg8::blk_elem((int)qrow, 128 * ch + d, CW)) = wv; }
}
DI void ld8(const bf16* p, float (&o)[8]) { const v4u a = *(const GAS v4u*)p; const unsigned aw[4] = {a.x, a.y, a.z, a.w};
#pragma unroll
    for (int e = 0; e < 4; ++e) { o[2 * e] = bf2f((unsigned short)(aw[e] & 0xffff)); o[2 * e + 1] = bf2f((unsigned short)(aw[e] >> 16)); } }
DI void ffn_fix(const bf16* UB, bf16* ACT, const float* cw, const float* cb, int gt, int NT) {
    constexpr int NC = DFF / 8;
    for (int it = gt; it < (M / 64) * 2 * NC; it += NT) {
        const int cc = it % NC, rr = it / NC, rho = rr & 1, blk = rr >> 1, n0 = 8 * cc; const bool first = (blk & 127) == 0;
        const bf16* cur = UB + ((size_t)blk * 4 + rho) * DFF2; const bf16* prv = UB + ((size_t)(blk - 1) * 4) * DFF2;
        const bf16* p1 = rho ? UB + ((size_t)blk * 4) * DFF2 : prv + 3 * (size_t)DFF2;
        const bf16* p2 = rho ? prv + 3 * (size_t)DFF2 : prv + 2 * (size_t)DFF2;
        const bool z1 = (rho == 0) && first, z2 = first;
        float o[2][8];
#pragma unroll
        for (int hf = 0; hf < 2; ++hf) {
            const int col = hf * DFF + n0; float x0[8], x1[8], x2[8];
            ld8(cur + col, x0);
            if (!z1) ld8(p1 + col, x1); else {
#pragma unroll
                for (int e = 0; e < 8; ++e) x1[e] = 0.f; }
            if (!z2) ld8(p2 + col, x2); else {
#pragma unroll
                for (int e = 0; e < 8; ++e) x2[e] = 0.f; }
#pragma unroll
            for (int e = 0; e < 8; ++e) o[hf][e] = cb[col + e] + cw[col + e] * x2[e] + cw[(size_t)DFF2 + col + e] * x1[e] + cw[2 * (size_t)DFF2 + col + e] * x0[e];
        }
        float a[8];
#pragma unroll
        for (int e = 0; e < 8; ++e) a[e] = o[0][e] * __builtin_amdgcn_rcpf(1.0f + __expf(-o[0][e])) * o[1][e];
        v4u ov; ov.x = pk_bf16(a[0], a[1]); ov.y = pk_bf16(a[2], a[3]); ov.z = pk_bf16(a[4], a[5]); ov.w = pk_bf16(a[6], a[7]);
        *(GAS v4u*)(ACT + pg8::blk_elem(blk * 64 + rho, n0, DFF)) = ov;
    }
}
struct Args { Ptrs p; int ph_lo, ph_hi; };
constexpr int N_PHASES = 12;
__global__ void __launch_bounds__(NWAVES * 64, 2) mk_fwd(Args args) {
    extern __shared__ __attribute__((aligned(16))) unsigned char lds_raw[];
    LAS unsigned char* lds = (LAS unsigned char*)lds_raw;
    volatile LAS unsigned* MISC = (volatile LAS unsigned*)(lds + MISC_OFF);
    const int tid = threadIdx.x, lane = tid & 63, wave = __builtin_amdgcn_readfirstlane(tid >> 6);
    const int G = gridDim.x, bx = blockIdx.x;
    const Ptrs& P = args.p; unsigned char* ws = P.ws;
    gu32* ctl = (gu32*)(ws + WS_CTL);
    for (int u = tid; u < (LDS_BYTES - LDSCTL_OFF) / 4; u += NWAVES * 64) ((LAS unsigned*)(lds + LDSCTL_OFF))[u] = 0u;
    __syncthreads();
    XcdBarrier bar = xcd_barrier_post((unsigned*)(ctl + CW_BAR), MISC + 8);
    const int lo = args.ph_lo, hi = args.ph_hi;
#ifndef PHMASK
#define PHMASK 0xffff
#endif
#define IN(k) (((PHMASK >> (k)) & 1) && lo <= (k) && (k) < hi)
#define SEAM(k) do { if (IN(k) && IN((k) + 1)) xcd_barrier(bar); } while (0)
    bf16* HB = (bf16*)(ws + WS_HB); bf16* PROJ = (bf16*)(ws + WS_PROJ);
    const int gw = bx * NWAVES + wave, NGW = G * NWAVES, gt = bx * NWAVES * 64 + tid, NT = G * NWAVES * 64;

    if (IN(0)) { p0_prologue(P, lds, gw, NGW, wave, lane); }
    SEAM(0);
    if (IN(1)) {
        pg8::Gemm g{HB, (const bf16*)(ws + WS_WIN), M, INW, DM, DM}; pg8::StaticOrder S; S.init(M, INW, G, bx);
        pg8::EpiProj E{PROJ, (const float*)(ws + WS_SSQ0), (const float*)(ws + WS_COS), (const float*)(ws + WS_SIN), P.sbq_norm, P.sbk_norm, (float*)(ws + WS_SSQSB)};
        pg8::gemm_phase<pg8::EpiProj, pg8::StaticOrder, true, true>(lds, g, S, E);
    }
    SEAM(1);
    if (IN(2)) { for (int u = bx; u < 2048; u += G) ret_kv_unit(lds, PROJ, (float*)(ws + WS_KV), u, tid); }
    SEAM(2);
    if (IN(3)) { ret_scan((const float*)(ws + WS_KV), (bf16*)(ws + WS_ST), gt, NT); }
    SEAM(3);
    if (IN(4)) {
        sb_phase(lds, PROJ, (bf16*)(ws + WS_MIX), (const float*)(ws + WS_SSQSB), P.sbo_norm, bx, G, tid);
        ret_out_phase(lds, PROJ, (bf16*)(ws + WS_MIX), (const bf16*)(ws + WS_ST), P.ret_norm, bx, G, tid);
        __syncthreads();
    }
    SEAM(4);
    if (IN(5)) {
        pg8::Gemm g{(const bf16*)(ws + WS_MIX), (const bf16*)(ws + WS_WOUT), M, DM, DM, DM}; pg8::StaticOrder S; S.init(M, DM, G, bx);
        pg8::EpiRes<0> E{P.x, nullptr, HB, (float*)(ws + WS_SSQ1)};
        pg8::gemm_phase<pg8::EpiRes<0>, pg8::StaticOrder, true, true>(lds, g, S, E);
    }
    SEAM(5);
    if (IN(6)) {
        { pg8::Gemm g{HB, (const bf16*)(ws + WS_WQKV), M, CW, DM, DM}; pg8::StaticOrder S; S.init(M, CW, G, bx);
          pg8::EpiScaleF32 E{(float*)(ws + WS_CQ), CW, (const float*)(ws + WS_SSQ1)};
          pg8::gemm_phase<pg8::EpiScaleF32, pg8::StaticOrder, true, true>(lds, g, S, E); }
        __syncthreads();
        { pg8::Gemm g{(const bf16*)(ws + WS_MB), (const bf16*)(ws + WS_WQKV) + (size_t)CW * DM, BATCH * NMEM, 2 * CW, DM, DM}; pg8::StaticOrder S; S.init(BATCH * NMEM, 2 * CW, G, (bx + G / 2) % G);
          pg8::EpiScaleF32 E{(float*)(ws + WS_CKV), 2 * CW, (const float*)(ws + WS_SSQM)};
          pg8::gemm_phase<pg8::EpiScaleF32, pg8::StaticOrder, true, true>(lds, g, S, E); }
    }
    SEAM(6);
    if (IN(7)) { for (int u = bx; u < 256; u += G) cross_unit(lds, (const float*)(ws + WS_CQ), (const float*)(ws + WS_CKV), P.cq_norm, P.ck_norm, (bf16*)(ws + WS_CO), u, tid); __syncthreads(); }
    SEAM(7);
    if (IN(8)) {
        pg8::Gemm g{(const bf16*)(ws + WS_CO), (const bf16*)(ws + WS_WO), M, DM, CW, CW}; pg8::StaticOrder S; S.init(M, DM, G, bx);
        pg8::EpiRes<1> E{nullptr, nullptr, HB, (float*)(ws + WS_SSQ2)};
        pg8::gemm_phase<pg8::EpiRes<1>, pg8::StaticOrder, true, true>(lds, g, S, E);
    }
    SEAM(8);
    if (IN(9)) {
        pg8::Gemm g{HB, (const bf16*)(ws + WS_WUP), M, DFF2, DM, DM}; pg8::StaticOrder S; S.init(M, DFF2, G, bx);
        pg8::EpiFfn E{(bf16*)(ws + WS_ACT), (bf16*)(ws + WS_UB), (const float*)(ws + WS_SSQ2), P.conv_w, P.conv_b, (LAS float*)(lds + L_EPIW + wave * 1024)};
        pg8::gemm_phase<pg8::EpiFfn, pg8::StaticOrder, true, true>(lds, g, S, E);
    }
    SEAM(9);
    if (IN(10)) { ffn_fix((const bf16*)(ws + WS_UB), (bf16*)(ws + WS_ACT), P.conv_w, P.conv_b, gt, NT); }
    SEAM(10);
    if (IN(11)) {
        pg8::Gemm g{(const bf16*)(ws + WS_ACT), (const bf16*)(ws + WS_WDOWN), M, DM, DFF, DFF}; pg8::StaticOrder S; S.init(M, DM, G, bx);
        pg8::EpiRes<2> E{nullptr, P.out, HB, nullptr};
        pg8::gemm_phase<pg8::EpiRes<2>, pg8::StaticOrder, true, true>(lds, g, S, E);
    }
#undef IN
#undef SEAM
}

#ifndef MK_CUTS
#define MK_CUTS 0
#endif
extern "C" void kernel_launch(void* const* d_in, const int* in_sizes, int n_in, void* d_out, int out_size, void* d_ws, size_t ws_size, hipStream_t stream) {
    static int grid = 0;
    if (grid == 0) {
        if (n_in != 21 || in_sizes[0] != M * DM || out_size != M * DM || ws_size < WS_END) { fprintf(stderr, "kernel_launch: unexpected shapes (n_in %d, in0 %d, out %d, ws %zu < %zu); nothing launched\n", n_in, n_in > 0 ? in_sizes[0] : -1, out_size, ws_size, (size_t)WS_END); grid = -1; return; }
        int dev = 0, cus = 0, per_cu = 0;
        if (hipGetDevice(&dev) != hipSuccess || hipDeviceGetAttribute(&cus, hipDeviceAttributeMultiprocessorCount, dev) != hipSuccess) { grid = -1; return; }
        if (hipFuncSetAttribute((const void*)mk_fwd, hipFuncAttributeMaxDynamicSharedMemorySize, LDS_BYTES) != hipSuccess) { fprintf(stderr, "kernel_launch: hipFuncSetAttribute failed\n"); grid = -1; return; }
        if (hipOccupancyMaxActiveBlocksPerMultiprocessor(&per_cu, (const void*)mk_fwd, NWAVES * 64, LDS_BYTES) != hipSuccess || per_cu < 1) fprintf(stderr, "kernel_launch: note: occupancy query reports %d\n", per_cu);
        (void)hipGetLastError();
        grid = cus;
    }
    if (grid < 0) return;
    if (hipMemsetAsync((char*)d_ws + WS_CTL, 0, CTL_ZERO_BYTES, stream) != hipSuccess) return;
    Args a{};
    const float** pp = (const float**)&a.p;
    for (int i = 0; i < 21; ++i) pp[i] = (const float*)d_in[i];
    a.p.out = (float*)d_out; a.p.ws = (unsigned char*)d_ws;
#if MK_CUTS
    for (int ph = 0; ph < N_PHASES; ++ph) { a.ph_lo = ph; a.ph_hi = ph + 1; hipLaunchKernelGGL(mk_fwd, dim3(grid), dim3(NWAVES * 64), LDS_BYTES, stream, a); }
#else
    a.ph_lo = 0; a.ph_hi = N_PHASES;
    hipLaunchKernelGGL(mk_fwd, dim3(grid), dim3(NWAVES * 64), LDS_BYTES, stream, a);
#endif
    const hipError_t le = hipPeekAtLastError();
    if (le != hipSuccess) fprintf(stderr, "kernel_launch: launch failed: %s\n", hipGetErrorName(le));
}
```
